# Optimizing an MI355X kernel written in HIP

```python
import math
import jax, jax.numpy as jnp
from jax import lax
import numpy as np


D_MODEL = 2048
BATCH = 2
SEQ = 4096
DEPTH = 4
DEC_BATCH = 8
DEC_SEQ = 4096
PAST_LEN = 128

N_MIXERS = 3
N_LAYERS_A = len(range(0, DEPTH, N_MIXERS))
N_LAYERS_B = len(range(1, DEPTH, N_MIXERS))
N_LAYERS_C = len(range(2, DEPTH, N_MIXERS))
S5_GROUP_CH = 16
S5_GROUPS = D_MODEL // S5_GROUP_CH
S5_STATE = 64
S5_DT_MIN = 1e-3
S5_DT_MAX = 1e-1
POOL_WINDOWS = (2, 4, 8, 16)
POOL_GROUPS = len(POOL_WINDOWS)
POOL_GROUP_CH = D_MODEL // POOL_GROUPS
HEAD_DIM = 128
N_HEADS = D_MODEL // HEAD_DIM
N_KV_HEADS = 4
GQA_GROUP = N_HEADS // N_KV_HEADS
QKV_DIM = (N_HEADS + 2 * N_KV_HEADS) * HEAD_DIM
Q_BLOCK = 128
GRID_W = 64
ROPE_THETA = 10000.0
ROPE_FREQS = HEAD_DIM // 4
D_FF = 4 * D_MODEL
DEEPNORM_ALPHA = (2 * DEPTH) ** 0.25
DEEPNORM_BETA = (8 * DEPTH) ** -0.25
LN_EPS = 1e-5
RMS_EPS = 1e-6

kernel_name = 'hybrid_s5_pool_axialgqa_deepnorm_encoder'


def _layer_norm(x, g, b):
    xf = x.astype(jnp.float32)
    mu = jnp.mean(xf, axis=-1, keepdims=True)
    xc = xf - mu
    var = jnp.mean(xc * xc, axis=-1, keepdims=True)
    y = xc * lax.rsqrt(var + LN_EPS) * g.astype(jnp.float32) + b.astype(jnp.float32)
    return y.astype(x.dtype)


def _rms_norm(x, g):
    xf = x.astype(jnp.float32)
    y = xf * lax.rsqrt(jnp.mean(xf * xf, axis=-1, keepdims=True) + RMS_EPS) * g.astype(jnp.float32)
    return y.astype(x.dtype)


def _axial_rope_tables(seq_len):
    rows = seq_len // GRID_W
    row = jnp.repeat(jnp.arange(rows, dtype=jnp.float32), GRID_W)
    col = jnp.broadcast_to(jnp.arange(GRID_W, dtype=jnp.float32), (rows, GRID_W)).reshape(-1)
    inv_freq = jnp.power(ROPE_THETA, -jnp.arange(ROPE_FREQS, dtype=jnp.float32) / ROPE_FREQS)
    ang = jnp.stack([row[:, None] * inv_freq, col[:, None] * inv_freq], axis=1)
    return jnp.cos(ang)[:, None], jnp.sin(ang)[:, None]


def _apply_axial_rope(x, cos, sin):
    b, l, h, _ = x.shape
    xr = x.astype(jnp.float32).reshape(b, l, h, 2, 2, ROPE_FREQS)
    x1 = xr[..., 0, :]
    x2 = xr[..., 1, :]
    out = jnp.stack([x1 * cos - x2 * sin, x2 * cos + x1 * sin], axis=-2)
    return out.reshape(x.shape).astype(x.dtype)


def _ssm_combine(left, right):
    a1, b1 = left
    a2, b2 = right
    return a1 * a2, a2 * b1 + b2


def _s5_mixer(x, a_re, a_im, log_step, b_re, b_im, c_re, c_im, d_skip, w_out, w_gate):
    bsz, seq_len, _ = x.shape
    f32 = jnp.float32
    u = x.astype(f32)
    ug = u.reshape(bsz, seq_len, S5_GROUPS, S5_GROUP_CH)
    y = d_skip.astype(f32) * u
    for direction in range(2):
        lam = lax.complex(jnp.minimum(a_re[direction].astype(f32), -1e-4), a_im[direction].astype(f32))
        dt = jnp.exp(log_step[direction].astype(f32))[:, None]
        lam_bar = jnp.exp(lam * dt)
        b = lax.complex(b_re[direction].astype(f32), b_im[direction].astype(f32))
        b_bar = ((lam_bar - 1.0) / lam)[..., None] * b
        bu = lax.complex(jnp.einsum('blgp,gnp->blgn', ug, jnp.real(b_bar)),
                         jnp.einsum('blgp,gnp->blgn', ug, jnp.imag(b_bar)))
        a_seq = jnp.broadcast_to(lam_bar, (1, seq_len) + lam_bar.shape)
        _, h = lax.associative_scan(_ssm_combine, (a_seq, bu), reverse=(direction == 1), axis=1)
        yc = (jnp.einsum('blgn,gpn->blgp', jnp.real(h), c_re[direction].astype(f32))
              - jnp.einsum('blgn,gpn->blgp', jnp.imag(h), c_im[direction].astype(f32)))
        y = y + yc.reshape(bsz, seq_len, D_MODEL)
    g = jax.nn.gelu(y)
    out = (g @ w_out.astype(f32)) * jax.nn.sigmoid(g @ w_gate.astype(f32))
    return out.astype(x.dtype)


def _pool_mixer(x, pool_w, pool_scale):
    bsz, seq_len, _ = x.shape
    xf = x.astype(jnp.float32)
    cs = jnp.concatenate([jnp.zeros((bsz, 1, D_MODEL), jnp.float32), jnp.cumsum(xf, axis=1)], axis=1)
    t = jnp.arange(seq_len)
    pooled = []
    for gi, w in enumerate(POOL_WINDOWS):
        lo = jnp.clip(t - w // 2, 0, seq_len)
        hi = jnp.clip(t + w // 2, 0, seq_len)
        csg = cs[..., gi * POOL_GROUP_CH:(gi + 1) * POOL_GROUP_CH]
        cnt = (hi - lo).astype(jnp.float32)[None, :, None]
        pooled.append((csg[:, hi] - csg[:, lo]) / cnt)
    p = jnp.stack(pooled, axis=2) - xf.reshape(bsz, seq_len, POOL_GROUPS, POOL_GROUP_CH)
    out = jnp.einsum('blgc,gcd->blgd', p, pool_w.astype(jnp.float32)).reshape(bsz, seq_len, D_MODEL)
    out = out * pool_scale.astype(jnp.float32)
    return out.astype(x.dtype)


def _attention_mixer(x, cos, sin, w_qkv, q_norm, k_norm, w_o):
    bsz, seq_len, _ = x.shape
    qkv = x @ w_qkv
    q, k, v = jnp.split(qkv, [N_HEADS * HEAD_DIM, (N_HEADS + N_KV_HEADS) * HEAD_DIM], axis=-1)
    q = q.reshape(bsz, seq_len, N_HEADS, HEAD_DIM)
    k = k.reshape(bsz, seq_len, N_KV_HEADS, HEAD_DIM)
    v = v.reshape(bsz, seq_len, N_KV_HEADS, HEAD_DIM)
    q = _apply_axial_rope(_rms_norm(q, q_norm), cos, sin)
    k = _apply_axial_rope(_rms_norm(k, k_norm), cos, sin)
    n_blk = seq_len // Q_BLOCK
    qb = q.reshape(bsz, n_blk, Q_BLOCK, N_KV_HEADS, GQA_GROUP, HEAD_DIM).transpose(1, 0, 3, 4, 2, 5)
    scale = HEAD_DIM ** -0.5

    def attend(q_blk):
        s = jnp.einsum('bkgqd,bskd->bkgqs', q_blk, k).astype(jnp.float32) * scale
        p = jax.nn.softmax(s, axis=-1).astype(v.dtype)
        return jnp.einsum('bkgqs,bskd->bkgqd', p, v)

    o = lax.map(attend, qb)
    o = o.transpose(1, 0, 4, 2, 3, 5).reshape(bsz, seq_len, D_MODEL)
    return o @ w_o


def _sq_relu_mlp(x, w1, w2):
    h = jax.nn.relu(x @ w1)
    return (h * h) @ w2


def _encoder(x, s5_a_re, s5_a_im, s5_log_step, s5_b_re, s5_b_im, s5_c_re, s5_c_im, s5_d,
             s5_w_out, s5_w_gate, pool_w, pool_scale, attn_w_qkv, attn_q_norm, attn_k_norm,
             attn_w_o, ln1_g, ln1_b, ln2_g, ln2_b, mlp_w1, mlp_w2):
    cos, sin = _axial_rope_tables(x.shape[1])
    for i in range(DEPTH):
        kind = i % N_MIXERS
        j = i // N_MIXERS
        if kind == 0:
            h = _s5_mixer(x, s5_a_re[j], s5_a_im[j], s5_log_step[j], s5_b_re[j], s5_b_im[j],
                          s5_c_re[j], s5_c_im[j], s5_d[j], s5_w_out[j], s5_w_gate[j])
        elif kind == 1:
            h = _pool_mixer(x, pool_w[j], pool_scale[j])
        else:
            h = _attention_mixer(x, cos, sin, attn_w_qkv[j], attn_q_norm[j], attn_k_norm[j], attn_w_o[j])
        x = _layer_norm(DEEPNORM_ALPHA * x + h, ln1_g[i], ln1_b[i])
        x = _layer_norm(DEEPNORM_ALPHA * x + _sq_relu_mlp(x, mlp_w1[i], mlp_w2[i]), ln2_g[i], ln2_b[i])
    return x


def setup_inputs(seed: int = 0) -> dict:
    key = jax.random.key(seed)
    ks = jax.random.split(key, 32)
    f32 = jnp.float32

    def nrm(k, shape, std):
        return std * jax.random.normal(k, shape, f32)

    n_idx = jnp.arange(S5_STATE, dtype=f32)
    a_shape = (N_LAYERS_A, 2, S5_GROUPS, S5_STATE)
    return {
        'x_prompt': nrm(ks[0], (BATCH, SEQ, D_MODEL), 1.0),
        'x_sample': nrm(ks[1], (DEC_BATCH, DEC_SEQ, D_MODEL), 1.0),
        's5_a_re': -0.5 + nrm(ks[2], a_shape, 0.01),
        's5_a_im': math.pi * n_idx + nrm(ks[3], a_shape, 0.01),
        's5_log_step': jax.random.uniform(ks[4], (N_LAYERS_A, 2, S5_GROUPS), f32,
                                          math.log(S5_DT_MIN), math.log(S5_DT_MAX)),
        's5_b_re': nrm(ks[5], (N_LAYERS_A, 2, S5_GROUPS, S5_STATE, S5_GROUP_CH), (2 * S5_GROUP_CH) ** -0.5),
        's5_b_im': nrm(ks[6], (N_LAYERS_A, 2, S5_GROUPS, S5_STATE, S5_GROUP_CH), (2 * S5_GROUP_CH) ** -0.5),
        's5_c_re': nrm(ks[7], (N_LAYERS_A, 2, S5_GROUPS, S5_GROUP_CH, S5_STATE), 0.5 ** 0.5),
        's5_c_im': nrm(ks[8], (N_LAYERS_A, 2, S5_GROUPS, S5_GROUP_CH, S5_STATE), 0.5 ** 0.5),
        's5_d': nrm(ks[9], (N_LAYERS_A, D_MODEL), 1.0),
        's5_w_out': nrm(ks[10], (N_LAYERS_A, D_MODEL, D_MODEL), D_MODEL ** -0.5 * DEEPNORM_BETA),
        's5_w_gate': nrm(ks[11], (N_LAYERS_A, D_MODEL, D_MODEL), D_MODEL ** -0.5),
        'pool_w': nrm(ks[12], (N_LAYERS_B, POOL_GROUPS, POOL_GROUP_CH, POOL_GROUP_CH),
                      POOL_GROUP_CH ** -0.5 * DEEPNORM_BETA),
        'pool_scale': 1.0 + nrm(ks[13], (N_LAYERS_B, D_MODEL), 0.02),
        'attn_w_qkv': nrm(ks[14], (N_LAYERS_C, D_MODEL, QKV_DIM), D_MODEL ** -0.5),
        'attn_q_norm': 1.0 + nrm(ks[15], (N_LAYERS_C, HEAD_DIM), 0.02),
        'attn_k_norm': 1.0 + nrm(ks[16], (N_LAYERS_C, HEAD_DIM), 0.02),
        'attn_w_o': nrm(ks[17], (N_LAYERS_C, D_MODEL, D_MODEL), D_MODEL ** -0.5 * DEEPNORM_BETA),
        'ln1_g': 1.0 + nrm(ks[18], (DEPTH, D_MODEL), 0.02),
        'ln1_b': nrm(ks[19], (DEPTH, D_MODEL), 0.02),
        'ln2_g': 1.0 + nrm(ks[20], (DEPTH, D_MODEL), 0.02),
        'ln2_b': nrm(ks[21], (DEPTH, D_MODEL), 0.02),
        'mlp_w1': nrm(ks[22], (DEPTH, D_MODEL, D_FF), D_MODEL ** -0.5),
        'mlp_w2': nrm(ks[23], (DEPTH, D_FF, D_MODEL), D_FF ** -0.5 * DEEPNORM_BETA),
    }


def reference(x_prompt, x_sample, s5_a_re, s5_a_im, s5_log_step, s5_b_re, s5_b_im, s5_c_re,
              s5_c_im, s5_d, s5_w_out, s5_w_gate, pool_w, pool_scale, attn_w_qkv, attn_q_norm,
              attn_k_norm, attn_w_o, ln1_g, ln1_b, ln2_g, ln2_b, mlp_w1, mlp_w2):
    y_prompt = _encoder(x_prompt, s5_a_re, s5_a_im, s5_log_step, s5_b_re, s5_b_im, s5_c_re,
                        s5_c_im, s5_d, s5_w_out, s5_w_gate, pool_w, pool_scale, attn_w_qkv,
                        attn_q_norm, attn_k_norm, attn_w_o, ln1_g, ln1_b, ln2_g, ln2_b,
                        mlp_w1, mlp_w2)
    y_sample = _encoder(x_sample, s5_a_re, s5_a_im, s5_log_step, s5_b_re, s5_b_im, s5_c_re,
                        s5_c_im, s5_d, s5_w_out, s5_w_gate, pool_w, pool_scale, attn_w_qkv,
                        attn_q_norm, attn_k_norm, attn_w_o, ln1_g, ln1_b, ln2_g, ln2_b,
                        mlp_w1, mlp_w2)
    return (y_prompt, y_sample)
```

```cpp
#include <hip/hip_runtime.h>
#include <hip/hip_cooperative_groups.h>
#include <cstdio>
#include <cstdint>
namespace cg = cooperative_groups;
#ifndef WGM_DOWN
#define WGM_DOWN 4
#endif
#ifndef WGM_UP
#define WGM_UP 8
#endif
#ifndef WGM_OTHER
#define WGM_OTHER 4
#endif
#ifndef LAZY_SCHED
#define LAZY_SCHED 0
#endif
#ifndef EMIT_ON
#define EMIT_ON 0
#endif

#define LAS __attribute__((address_space(3)))
typedef unsigned short bf16_t;
typedef short bf16x8 __attribute__((ext_vector_type(8)));
typedef short s16x4 __attribute__((ext_vector_type(4)));
typedef float f32x2 __attribute__((ext_vector_type(2)));
typedef float f32x4 __attribute__((ext_vector_type(4)));
typedef float f32x16 __attribute__((ext_vector_type(16)));
typedef unsigned u32x2 __attribute__((ext_vector_type(2)));
typedef unsigned u32x4 __attribute__((ext_vector_type(4)));

constexpr int DM = 2048, NBATCH = 10, SEQ = 4096, MTOK = NBATCH * SEQ, DFF = 8192, QKVD = 3072;
constexpr float ALPHA = 1.681792830507429f;
constexpr float LN_EPS = 1e-5f, RMS_EPS = 1e-6f;
constexpr size_t MiB = 1024ull * 1024ull;
constexpr size_t WS_PW = 0;
constexpr size_t WS_ROPE = 8 * MiB;
constexpr size_t WS_BAR = 10 * MiB;
constexpr size_t WS_ACC = 11 * MiB;
constexpr size_t WS_CG = 12 * MiB;
constexpr size_t WS_ONE = 13 * MiB;
constexpr size_t WS_ST = 9 * MiB;
constexpr size_t WS_WB = 16 * MiB;
constexpr size_t WS_W1T = WS_WB, WS_W2T = WS_WB + 32 * MiB, WS_MIX = WS_WB + 64 * MiB;
constexpr size_t WS_XB = 144 * MiB;
constexpr size_t WS_R = 304 * MiB;
constexpr size_t WS_END = WS_R + 640 * MiB;
constexpr int LDS_BYTES = 129 * 1024;

struct Params {
  const float* xp; const float* xs;
  const float* a_re; const float* a_im; const float* log_step; const float* b_re; const float* b_im; const float* c_re; const float* c_im;
  const float* s5_d; const float* s5_wout; const float* s5_wgate; const float* pool_w; const float* pool_scale;
  const float* wqkv; const float* qnorm; const float* knorm; const float* wo;
  const float* ln1g; const float* ln1b; const float* ln2g; const float* ln2b; const float* w1; const float* w2;
  float* X; unsigned char* ws;
};

typedef __attribute__((address_space(4))) const Params* KargP;
struct Ctx { int wave0, bid, G;
  __device__ __forceinline__ int tid_() const { int l_; asm volatile("v_mbcnt_lo_u32_b32 %0, -1, 0\n\tv_mbcnt_hi_u32_b32 %0, -1, %0" : "=v"(l_)); return wave0 * 64 + l_; } };
__device__ __forceinline__ unsigned cvt_pk_bf16(float lo, float hi) { unsigned r; asm volatile("v_cvt_pk_bf16_f32 %0, %1, %2" : "=v"(r) : "v"(lo), "v"(hi)); return r; }
__device__ __forceinline__ float bf2f(bf16_t h) { return __uint_as_float(((unsigned)h) << 16); }
__device__ __forceinline__ float wave_sum(float v, int lane) {
#pragma unroll
  for (int o = 32; o >= 1; o >>= 1) v += __int_as_float(__builtin_amdgcn_ds_bpermute((lane ^ o) << 2, __float_as_int(v)));
  return v;
}
__device__ __forceinline__ float gelu_tanh(float x) {
  const float u = 0.7978845608028654f * (x + 0.044715f * x * x * x);
  return x * __builtin_amdgcn_rcpf(1.0f + __builtin_amdgcn_exp2f(-2.885390081777927f * u));
}
__device__ __forceinline__ float sigmoidf_(float x) { return __builtin_amdgcn_rcpf(1.0f + __builtin_amdgcn_exp2f(-1.4426950408889634f * x)); }

namespace pg8 {
constexpr int BM = 256, BK = 64, HALF = 128, HTB = HALF * BK * 2, STAGE_BYTES = 8 * HTB, NXCD = 8, WGM = 4;
__device__ __forceinline__ int lds_byte(int r, int c) { const int st = (r >> 4) * 2 + (c >> 5), rr = r & 15, cc = c & 31, ob = rr * 64 + cc * 2; return st * 1024 + (ob ^ (((ob >> 9) & 1) << 5)); }
__device__ __forceinline__ void stage_rc(int b, int& R, int& C) { const int st = b / 1024, sb = b % 1024, swz = sb ^ (((sb >> 9) & 1) << 5); R = (st >> 1) * 16 + swz / 64; C = (st & 1) * 32 + (swz % 64) / 2; }
__device__ __forceinline__ int perm32(int rho) { const int n = rho >> 4, i = rho & 15; return 8 * (i >> 2) + 4 * n + (i & 3); }

struct Unit { int pm, pn; };
struct GemmDesc {
  const char* A; const char* A2; const char* Bt;
  unsigned rowStrideA, ldbBytes, pnStrideA; int pnShift, chunked, ksplit, nt, nM, nN;
  int mode; void* out; int ldc;
  int wgm;
  int lnsel, flags, layer;
};
enum { F_LN_STATS = 1, F_LN_ACC = 2, F_EMIT = 4, F_XIN = 8, F_FOLD = 16, F_CSCALE = 32 };
struct StaticOrder {
  int nM, nN, nwg, G, c, wgm;
  __device__ void init(int nM_, int nN_, int G_, int c_, int wgm_) { nM = nM_; nN = nN_; nwg = nM * nN; G = G_; c = c_; wgm = wgm_; }
  __device__ bool next(int i, Unit& u) const {
    const long L = (long)i * G + c; if (L >= nwg) return false;
    int wgid = (int)L; { const int q = nwg / NXCD, r = nwg % NXCD, xcd = wgid % NXCD, off = wgid / NXCD; wgid = (xcd < r ? xcd * (q + 1) : r * (q + 1) + (xcd - r) * q) + off; }
    const int nig = wgm * nN, gid = wgid / nig, fm = gid * wgm, gsz = (nM - fm) < wgm ? (nM - fm) : wgm;
    u.pm = fm + ((wgid % nig) % gsz); u.pn = (wgid % nig) / gsz; return true;
  }
};

__device__ __forceinline__ f32x2 row_stats(const f32x2* stats, const float* accIn, int row) {
  if (accIn) { const f32x2 a = *(const f32x2*)(accIn + 2 * (size_t)row); const float mean = a.x * (1.0f / DM); return (f32x2){mean, rsqrtf(fmaxf(a.y * (1.0f / DM) - mean * mean, 0.f) + LN_EPS)}; }
  return stats ? stats[row] : (f32x2){0.f, 1.f};
}
__device__ __forceinline__ void row_emit(float* accOut, int row, float s, float q, int lane, int fq) {
  s += __int_as_float(__builtin_amdgcn_ds_bpermute((lane ^ 16) << 2, __float_as_int(s))); q += __int_as_float(__builtin_amdgcn_ds_bpermute((lane ^ 16) << 2, __float_as_int(q)));
  s += __int_as_float(__builtin_amdgcn_ds_bpermute((lane ^ 32) << 2, __float_as_int(s))); q += __int_as_float(__builtin_amdgcn_ds_bpermute((lane ^ 32) << 2, __float_as_int(q)));
  if (fq == 0) { __hip_atomic_fetch_add(accOut + 2 * (size_t)row, s, __ATOMIC_RELAXED, __HIP_MEMORY_SCOPE_AGENT); __hip_atomic_fetch_add(accOut + 2 * (size_t)row + 1, q, __ATOMIC_RELAXED, __HIP_MEMORY_SCOPE_AGENT); }
}
__device__ __forceinline__ void gemm_epilogue(const GemmDesc& g, const f32x4 (&acc)[2][2][4][2], const Unit& u, int wr, int wc, int fr, int fq, int lane) {
  const int row0 = u.pm * BM + wr * 64 + fr;
  KargP pp = (KargP)__builtin_amdgcn_kernarg_segment_ptr(); asm volatile("" : "+s"(pp));
  unsigned char* const ws_ = pp->ws;
  const float* e_lng = nullptr; const float* e_lnb = nullptr;
  if (g.lnsel == 1) { e_lng = pp->ln1g + g.layer * DM; e_lnb = pp->ln1b + g.layer * DM; } else if (g.lnsel == 2) { e_lng = pp->ln2g + (g.layer - 1) * DM; e_lnb = pp->ln2b + (g.layer - 1) * DM; }
  const f32x2* const e_stats = (g.flags & F_LN_STATS) ? (const f32x2*)(ws_ + WS_ST) : nullptr;
  const float* const e_accIn = (g.flags & F_LN_ACC) ? (const float*)(ws_ + WS_ACC) : nullptr;
  float* const e_accOut = (g.flags & F_EMIT) ? (float*)(ws_ + WS_ACC) : nullptr; bf16_t* const e_xbOut = (bf16_t*)(ws_ + WS_XB);
  const float* const e_cg = (g.flags & F_FOLD) ? (const float*)(ws_ + WS_CG) : nullptr; const float* const e_cb = (const float*)(ws_ + WS_CG) + DFF;
  const float* const e_cscale = (g.flags & F_CSCALE) ? pp->pool_scale : nullptr;
  const float* const e_xin0 = (g.flags & F_XIN) ? pp->xp : nullptr; const float* const e_xin1 = pp->xs;
  if (g.mode <= 2) {
    bf16_t* O = (bf16_t*)g.out; const int col0 = u.pn * BM + wc * 32 + 8 * fq;
    const bool fold = (g.mode == 1) && (e_cg != nullptr);
    f32x4 fg[2][2], fb[2][2]; f32x2 fst[8];
    if (fold) {
#pragma unroll
      for (int bj = 0; bj < 2; ++bj)
#pragma unroll
        for (int n = 0; n < 2; ++n) { fg[bj][n] = *(const f32x4*)(e_cg + col0 + bj * HALF + 4 * n); fb[bj][n] = *(const f32x4*)(e_cb + col0 + bj * HALF + 4 * n); }
#pragma unroll
      for (int gi = 0; gi < 8; ++gi) fst[gi] = *(const f32x2*)(e_accIn + 2 * (size_t)(row0 + (gi >> 2) * HALF + (gi & 3) * 16));
#pragma unroll
      for (int gi = 0; gi < 8; ++gi) { const float mean = fst[gi].x * (1.0f / DM); fst[gi] = (f32x2){mean, rsqrtf(fmaxf(fst[gi].y * (1.0f / DM) - mean * mean, 0.f) + LN_EPS)}; }
    }
#pragma unroll
    for (int ai = 0; ai < 2; ++ai)
#pragma unroll
      for (int m = 0; m < 4; ++m) { bf16_t* rowp = O + (size_t)(row0 + ai * HALF + m * 16) * g.ldc + col0;
#pragma unroll
        for (int bj = 0; bj < 2; ++bj) { f32x4 v0 = acc[ai][bj][m][0], v1 = acc[ai][bj][m][1];
          if (g.mode == 1) {
            if (fold) { const f32x2 st = fst[ai * 4 + m]; v0 = (v0 - fg[bj][0] * st.x) * st.y + fb[bj][0]; v1 = (v1 - fg[bj][1] * st.x) * st.y + fb[bj][1]; }
#pragma unroll
            for (int j = 0; j < 4; ++j) { const float a = fmaxf(v0[j], 0.f), b = fmaxf(v1[j], 0.f); v0[j] = a * a; v1[j] = b * b; } }
          if (g.mode == 2) {
#pragma unroll
            for (int j = 0; j < 4; ++j) { v0[j] = gelu_tanh(v0[j]); v1[j] = gelu_tanh(v1[j]); } }
          u32x4 w; w.x = cvt_pk_bf16(v0[0], v0[1]); w.y = cvt_pk_bf16(v0[2], v0[3]); w.z = cvt_pk_bf16(v1[0], v1[1]); w.w = cvt_pk_bf16(v1[2], v1[3]);
          *(u32x4*)(rowp + bj * HALF) = w; } }
  } else if (g.mode == 3 || g.mode == 4) {
    float* X = (float*)g.out; const int col0 = u.pn * BM + wc * 32 + 4 * fq; const bool ln = e_stats != nullptr || e_accIn != nullptr;
    f32x4 cs[2][2], lg[2][2], lb[2][2];
#pragma unroll
    for (int bj = 0; bj < 2; ++bj)
#pragma unroll
      for (int n = 0; n < 2; ++n) { cs[bj][n] = (g.mode == 4) ? *(const f32x4*)(e_cscale + col0 + bj * HALF + n * 16) : (f32x4){1.f, 1.f, 1.f, 1.f};
        lg[bj][n] = ln ? *(const f32x4*)(e_lng + col0 + bj * HALF + n * 16) : (f32x4){1.f, 1.f, 1.f, 1.f}; lb[bj][n] = ln ? *(const f32x4*)(e_lnb + col0 + bj * HALF + n * 16) : (f32x4){0.f, 0.f, 0.f, 0.f}; }
    f32x2 st[2]; f32x4 xv[2][4];
    const f32x2* const e_sp = e_accIn ? (const f32x2*)e_accIn : (e_stats ? e_stats : (const f32x2*)(ws_ + WS_ONE));
#define RES_LOAD(GI, BUF) do { const int r_ = row0 + ((GI) >> 2) * HALF + ((GI) & 3) * 16; const float* rp_ = X + (size_t)r_ * DM + col0; \
      st[BUF] = e_sp[r_]; \
      _Pragma("unroll") for (int q_ = 0; q_ < 4; ++q_) xv[BUF][q_] = *(const f32x4*)(rp_ + (q_ >> 1) * HALF + (q_ & 1) * 16); } while (0)
    RES_LOAD(0, 0);
#pragma unroll
    for (int gi = 0; gi < 8; ++gi) { const int ai = gi >> 2, m = gi & 3; const int row = row0 + ai * HALF + m * 16; float* rowp = X + (size_t)row * DM + col0;
      if (gi + 1 < 8) RES_LOAD(gi + 1, (gi + 1) & 1);
      float ssum = 0.f, ssq = 0.f; f32x2 sm = st[gi & 1];
      if (e_accIn) { const float mean = sm.x * (1.0f / DM); sm = (f32x2){mean, rsqrtf(fmaxf(sm.y * (1.0f / DM) - mean * mean, 0.f) + LN_EPS)}; }
#pragma unroll
      for (int bj = 0; bj < 2; ++bj)
#pragma unroll
        for (int n = 0; n < 2; ++n) { f32x4* p = (f32x4*)(rowp + bj * HALF + n * 16); const f32x4 x = ((xv[gi & 1][bj * 2 + n] - sm.x) * sm.y) * lg[bj][n] + lb[bj][n]; const f32x4 o = x * ALPHA + acc[ai][bj][m][n] * cs[bj][n]; *p = o;
          if (e_accOut) { ssum += (o[0] + o[1]) + (o[2] + o[3]); ssq += (o[0] * o[0] + o[1] * o[1]) + (o[2] * o[2] + o[3] * o[3]);
            u32x2 w; w.x = cvt_pk_bf16(o[0], o[1]); w.y = cvt_pk_bf16(o[2], o[3]); *(u32x2*)(e_xbOut + (size_t)row * DM + col0 + bj * HALF + n * 16) = w; } }
      if (e_accOut) row_emit(e_accOut, row, ssum, ssq, lane, fq); }
#undef RES_LOAD
  } else if (g.mode == 5) {
    float* X = (float*)g.out; const int col0 = u.pn * HALF + wc * 32 + 4 * fq; const bool ln = e_stats != nullptr;
    f32x4 lg[2], lb[2];
#pragma unroll
    for (int n = 0; n < 2; ++n) { lg[n] = ln ? *(const f32x4*)(e_lng + col0 + n * 16) : (f32x4){1.f, 1.f, 1.f, 1.f}; lb[n] = ln ? *(const f32x4*)(e_lnb + col0 + n * 16) : (f32x4){0.f, 0.f, 0.f, 0.f}; }
    f32x2 st[2][2]; f32x4 xv[2][4];
    const f32x2* const e_sp = e_stats ? e_stats : (const f32x2*)(ws_ + WS_ONE);
#define GLU_SRC(ROW) (e_xin0 ? (((ROW) < 2 * SEQ) ? e_xin0 + (size_t)(ROW) * DM + col0 : e_xin1 + (size_t)((ROW) - 2 * SEQ) * DM + col0) : X + (size_t)(ROW) * DM + col0)
#define GLU_LOAD(PI, BUF) do { _Pragma("unroll") for (int h_ = 0; h_ < 2; ++h_) { const int g_ = 2 * (PI) + h_; const int r_ = row0 + (g_ >> 2) * HALF + (g_ & 3) * 16; const float* sp_ = GLU_SRC(r_); \
      st[BUF][h_] = e_sp[r_]; xv[BUF][2 * h_] = *(const f32x4*)(sp_); xv[BUF][2 * h_ + 1] = *(const f32x4*)(sp_ + 16); } } while (0)
    GLU_LOAD(0, 0);
#pragma unroll
    for (int pi = 0; pi < 4; ++pi) {
      if (pi + 1 < 4) GLU_LOAD(pi + 1, (pi + 1) & 1);
#pragma unroll
      for (int h2 = 0; h2 < 2; ++h2) { const int gi = 2 * pi + h2, ai = gi >> 2, m = gi & 3; const int row = row0 + ai * HALF + m * 16; float* rowp = X + (size_t)row * DM + col0; float ssum = 0.f, ssq = 0.f;
#pragma unroll
        for (int n = 0; n < 2; ++n) { f32x4* p = (f32x4*)(rowp + n * 16); const f32x4 x = ((xv[pi & 1][2 * h2 + n] - st[pi & 1][h2].x) * st[pi & 1][h2].y) * lg[n] + lb[n]; const f32x4 o = acc[ai][0][m][n], gt = acc[ai][1][m][n]; f32x4 h;
#pragma unroll
          for (int j = 0; j < 4; ++j) h[j] = o[j] * sigmoidf_(gt[j]);
          const f32x4 z = x * ALPHA + h; *p = z;
          if (e_accOut) { ssum += (z[0] + z[1]) + (z[2] + z[3]); ssq += (z[0] * z[0] + z[1] * z[1]) + (z[2] * z[2] + z[3] * z[3]);
            u32x2 w; w.x = cvt_pk_bf16(z[0], z[1]); w.y = cvt_pk_bf16(z[2], z[3]); *(u32x2*)(e_xbOut + (size_t)row * DM + col0 + n * 16) = w; } }
        if (e_accOut) row_emit(e_accOut, row, ssum, ssq, lane, fq); } }
#undef GLU_LOAD
#undef GLU_SRC
  } else if (g.mode == 7) {
    if (acc[0][0][0][0][0] == 1.2345e30f) *(f32x4*)g.out = acc[1][1][3][1];
  } else {
    float* C = (float*)g.out; const int col0 = u.pn * BM + wc * 32 + 4 * fq;
#pragma unroll
    for (int ai = 0; ai < 2; ++ai)
#pragma unroll
      for (int m = 0; m < 4; ++m) { float* rowp = C + (size_t)(row0 + ai * HALF + m * 16) * g.ldc + col0;
#pragma unroll
        for (int bj = 0; bj < 2; ++bj)
#pragma unroll
          for (int n = 0; n < 2; ++n) *(f32x4*)(rowp + bj * HALF + n * 16) = acc[ai][bj][m][n]; }
  }
}

__device__ __forceinline__ const char* ktile_ptr(const char* b1, const char* b2, int kt, int ksplit, size_t kstep) { return kt < ksplit ? b1 + (size_t)kt * kstep : b2 + (size_t)(kt - ksplit) * kstep; }

__device__ __forceinline__ void gemm_phase(const Ctx& cx, LAS unsigned char* lds, const GemmDesc& g) {
  const int tid = cx.tid_(), wid = __builtin_amdgcn_readfirstlane(tid >> 6), lane = tid & 63, wr = wid >> 2, wc = wid & 3, fr = lane & 15, fq = lane >> 4;
  const int nt = g.nt, ksplit = g.ksplit; const bool perm = g.mode <= 2;
  unsigned voffA[2], voffB[2];
#pragma unroll
  for (int i = 0; i < 2; ++i) { int R, C; stage_rc(tid * 16 + i * 8192, R, C); const int Rb = perm ? ((R & ~31) + perm32(R & 31)) : R;
    voffA[i] = g.chunked ? (unsigned)((R >> 4) * 65536 + (R & 15) * 32 + (C >> 4) * 512 + (C & 15) * 2) : ((unsigned)R * g.rowStrideA + (unsigned)(C * 2)); voffB[i] = (unsigned)Rb * g.ldbBytes + (unsigned)(C * 2); }
  const size_t kstepA = g.chunked ? 2048 : 128, kstepB = 128;
  const size_t hstepA = (size_t)HALF * g.rowStrideA, hstepB = (size_t)HALF * g.ldbBytes, tstepA = 2 * hstepA, tstepB = 2 * hstepB;
  const unsigned ldsw = (unsigned)wid * 1024u;
  const int aoff = lds_byte(wr * 64 + fr, fq * 8), boff = lds_byte(wc * 32 + fr, fq * 8);
#define PG8_SA(b, h) (((b) * 2 + (h)) * HTB)
#define PG8_SB(b, h) ((4 + (b) * 2 + (h)) * HTB)
#define PG8_STAGE(bufoff, gbase, voff) do { _Pragma("unroll") for (int _i = 0; _i < 2; ++_i) \
    __builtin_amdgcn_global_load_lds((const unsigned*)((const char*)(gbase) + (voff)[_i]), (LAS unsigned*)(lds + (bufoff) + ldsw + _i * 8192), 16, 0, 0); } while (0)
#define PG8_LDA(dst, b, h) do { _Pragma("unroll") for (int m = 0; m < 4; ++m) _Pragma("unroll") for (int k = 0; k < 2; ++k) dst[m][k] = *(const LAS bf16x8*)(lds + PG8_SA(b, h) + aoff + m * 2048 + k * 1024); } while (0)
#define PG8_LDB(dst, b, h) do { _Pragma("unroll") for (int n = 0; n < 2; ++n) _Pragma("unroll") for (int k = 0; k < 2; ++k) dst[n][k] = *(const LAS bf16x8*)(lds + PG8_SB(b, h) + boff + n * 2048 + k * 1024); } while (0)
#define PG8_MMA(ai, bj, At, Bt) do { __builtin_amdgcn_s_setprio(1); _Pragma("unroll") for (int m = 0; m < 4; ++m) _Pragma("unroll") for (int n = 0; n < 2; ++n) _Pragma("unroll") for (int k = 0; k < 2; ++k) \
    acc[ai][bj][m][n] = __builtin_amdgcn_mfma_f32_16x16x32_bf16(Bt[n][k], At[m][k], acc[ai][bj][m][n], 0, 0, 0); __builtin_amdgcn_s_setprio(0); } while (0)
#define PG8_WAIT_V(n) asm volatile("s_waitcnt vmcnt(" #n ")" ::: "memory")
#define PG8_WAIT_L(n) asm volatile("s_waitcnt lgkmcnt(" #n ")" ::: "memory")
#define PG8_BAR __builtin_amdgcn_s_barrier()
#define PG8_SCHED __builtin_amdgcn_sched_barrier(0)
  StaticOrder S; S.init(g.nM, g.nN, (int)cx.G, (int)cx.bid, g.wgm);
  Unit cur, nxt; int ui = 0;
  if (!S.next(0, cur)) return;
  f32x4 acc[2][2][4][2];
#pragma unroll
  for (int a = 0; a < 2; ++a)
#pragma unroll
    for (int b = 0; b < 2; ++b)
#pragma unroll
      for (int m = 0; m < 4; ++m)
#pragma unroll
        for (int n = 0; n < 2; ++n) acc[a][b][m][n] = (f32x4){0.f, 0.f, 0.f, 0.f};
  bf16x8 At[4][2], B0[2][2], B1[2][2];
  size_t aoffu = (size_t)cur.pm * tstepA + (size_t)(cur.pn >> g.pnShift) * g.pnStrideA;
  const char* cA1 = g.A + aoffu; const char* cA2 = g.A2 + aoffu; const char* cB = g.Bt + (size_t)cur.pn * tstepB;
  {
    const char* a0 = ktile_ptr(cA1, cA2, 0, ksplit, kstepA); const char* a1 = ktile_ptr(cA1, cA2, 1, ksplit, kstepA);
    PG8_STAGE(PG8_SB(0, 0), cB, voffB); PG8_STAGE(PG8_SB(0, 1), cB + hstepB, voffB); PG8_STAGE(PG8_SA(0, 0), a0, voffA); PG8_STAGE(PG8_SA(0, 1), a0 + hstepA, voffA);
    if (wr == 1) PG8_BAR;
    PG8_WAIT_V(2); PG8_BAR;
    PG8_STAGE(PG8_SB(1, 0), cB + kstepB, voffB); PG8_STAGE(PG8_SA(1, 0), a1, voffA); PG8_STAGE(PG8_SB(1, 1), cB + hstepB + kstepB, voffB);
    PG8_WAIT_V(6); PG8_BAR;
  }
  for (;;) {
    const bool has_next = S.next(ui + 1, nxt);
    const size_t naoff = has_next ? (size_t)nxt.pm * tstepA + (size_t)(nxt.pn >> g.pnShift) * g.pnStrideA : aoffu;
    const char* nA1 = g.A + naoff; const char* nA2 = g.A2 + naoff; const char* nB = has_next ? g.Bt + (size_t)nxt.pn * tstepB : cB;
    for (int t = 0; t < nt; t += 2) {
      const bool last = (t == nt - 2);
      const char* a1 = ktile_ptr(cA1, cA2, t + 1, ksplit, kstepA);
      const char* a2 = last ? ktile_ptr(nA1, nA2, 0, ksplit, kstepA) : ktile_ptr(cA1, cA2, t + 2, ksplit, kstepA);
      const char* a3 = last ? ktile_ptr(nA1, nA2, 1, ksplit, kstepA) : ktile_ptr(cA1, cA2, t + 3, ksplit, kstepA);
      const char* b2 = last ? nB : cB + (size_t)(t + 2) * kstepB; const char* b3 = b2 + kstepB;
      PG8_LDB(B0, 0, 0); PG8_LDB(B1, 0, 1); PG8_SCHED; PG8_LDA(At, 0, 0); PG8_STAGE(PG8_SA(1, 1), a1 + hstepA, voffA);
      PG8_WAIT_V(8); PG8_WAIT_L(0); PG8_BAR; PG8_MMA(0, 0, At, B0); PG8_MMA(0, 1, At, B1); PG8_BAR; PG8_SCHED;
      PG8_LDA(At, 0, 1); PG8_STAGE(PG8_SB(0, 0), b2, voffB); PG8_STAGE(PG8_SB(0, 1), b2 + hstepB, voffB); PG8_STAGE(PG8_SA(0, 0), a2, voffA);
      PG8_WAIT_V(8); PG8_WAIT_L(0); PG8_BAR; PG8_MMA(1, 0, At, B0); PG8_MMA(1, 1, At, B1); PG8_BAR; PG8_SCHED;
      PG8_LDB(B0, 1, 0); PG8_LDB(B1, 1, 1); PG8_SCHED; PG8_LDA(At, 1, 0); PG8_STAGE(PG8_SA(0, 1), a2 + hstepA, voffA);
      PG8_WAIT_V(8); PG8_WAIT_L(0); PG8_BAR; PG8_MMA(0, 0, At, B0); PG8_MMA(0, 1, At, B1); PG8_BAR; PG8_SCHED;
      PG8_LDA(At, 1, 1); PG8_STAGE(PG8_SB(1, 0), b3, voffB); PG8_STAGE(PG8_SB(1, 1), b3 + hstepB, voffB); PG8_STAGE(PG8_SA(1, 0), a3, voffA);
      PG8_WAIT_V(8); PG8_WAIT_L(0); PG8_BAR; PG8_MMA(1, 0, At, B0); PG8_MMA(1, 1, At, B1); PG8_BAR; PG8_SCHED;
    }
    if (wr == 0) PG8_BAR;
    gemm_epilogue(g, acc, cur, wr, wc, fr, fq, lane);
    if (!has_next) break;
#pragma unroll
    for (int a = 0; a < 2; ++a)
#pragma unroll
      for (int b = 0; b < 2; ++b)
#pragma unroll
        for (int m = 0; m < 4; ++m)
#pragma unroll
          for (int n = 0; n < 2; ++n) acc[a][b][m][n] = (f32x4){0.f, 0.f, 0.f, 0.f};
    cur = nxt; cA1 = nA1; cA2 = nA2; cB = nB; aoffu = naoff; ++ui;
    if (wr == 1) PG8_BAR;
  }
  PG8_WAIT_V(0);
  PG8_BAR;
#undef PG8_SA
#undef PG8_SB
#undef PG8_STAGE
#undef PG8_LDA
#undef PG8_LDB
#undef PG8_MMA
#undef PG8_WAIT_V
#undef PG8_WAIT_L
#undef PG8_BAR
#undef PG8_SCHED
}
}

namespace att {
constexpr int D = 128, NW = 8, QBLK = 32, KVBLK = 64;
constexpr float SCALE = 0.088388347648318440f, THR = 8.f;
constexpr int LDQ = QKVD, LDK = 128, LDO = DM;
constexpr size_t SHM_V = KVBLK * D * 2, SHM_K = KVBLK * D * 2, SHM_ATTN = 2 * SHM_V + 2 * SHM_K + NW * 64 * 4;
#define KSWZ(row, colB) ((row) * 256 + ((colB) ^ (((row) & 7) << 4)))
#define SBAR() __builtin_amdgcn_sched_barrier(0)
__device__ __forceinline__ int crow(int r, int hi) { return (r & 3) + 8 * (r >> 2) + 4 * hi; }
__device__ __forceinline__ bf16x8 ld8(const bf16_t* p) { return *reinterpret_cast<const bf16x8*>(p); }
__device__ __forceinline__ void partialSM(f32x16& p0, f32x16& p1, float& m_reg, float& mn, float& alpha) {
  constexpr float C = SCALE * 1.4426950408889634f;
  float pmax = p0[0];
#pragma unroll
  for (int r = 1; r < 16; ++r) pmax = fmaxf(pmax, p0[r]);
#pragma unroll
  for (int r = 0; r < 16; ++r) pmax = fmaxf(pmax, p1[r]);
  { auto rr = __builtin_amdgcn_permlane32_swap(__float_as_uint(pmax), __float_as_uint(pmax), false, false);
    pmax = fmaxf(__uint_as_float(rr[0]), __uint_as_float(rr[1])); }
  if (__builtin_expect(__all(pmax - m_reg <= THR / SCALE), 1)) { mn = m_reg; alpha = 1.f; }
  else { mn = fmaxf(m_reg, pmax); alpha = __builtin_amdgcn_exp2f((m_reg - mn) * C); m_reg = mn; }
  float mnC = -mn * C;
#pragma unroll
  for (int r = 0; r < 16; ++r) p0[r] = fmaf(p0[r], C, mnC);
#pragma unroll
  for (int r = 0; r < 16; ++r) p1[r] = fmaf(p1[r], C, mnC);
#pragma unroll
  for (int r = 0; r < 16; ++r) p0[r] = __builtin_amdgcn_exp2f(p0[r]);
}
__device__ __forceinline__ void finishSM(f32x16& p0, f32x16& p1, float alpha, float& l_reg, bf16x8& pa0, bf16x8& pa1, bf16x8& pa2, bf16x8& pa3) {
#pragma unroll
  for (int r = 0; r < 16; ++r) p1[r] = __builtin_amdgcn_exp2f(p1[r]);
  float ps = 0;
#pragma unroll
  for (int r = 0; r < 16; ++r) ps += p0[r];
#pragma unroll
  for (int r = 0; r < 16; ++r) ps += p1[r];
  { auto rr = __builtin_amdgcn_permlane32_swap(__float_as_uint(ps), __float_as_uint(ps), false, false);
    ps = __uint_as_float(rr[0]) + __uint_as_float(rr[1]); }
  l_reg = l_reg * alpha + ps;
#define PK4(P, BASE, OUT) do { unsigned a0 = cvt_pk_bf16(P[BASE + 0], P[BASE + 1]), a1 = cvt_pk_bf16(P[BASE + 2], P[BASE + 3]);   \
    unsigned b0 = cvt_pk_bf16(P[BASE + 4], P[BASE + 5]), b1 = cvt_pk_bf16(P[BASE + 6], P[BASE + 7]);                              \
    auto r0 = __builtin_amdgcn_permlane32_swap(a0, b0, false, false); auto r1 = __builtin_amdgcn_permlane32_swap(a1, b1, false, false); \
    u32x4 w = {r0[0], r1[0], r0[1], r1[1]}; OUT = *reinterpret_cast<bf16x8*>(&w); } while (0)
  PK4(p0, 0, pa0); PK4(p0, 8, pa1); PK4(p1, 0, pa2); PK4(p1, 8, pa3);
#undef PK4
}
__device__ __forceinline__ void qkt(f32x16& p0, f32x16& p1, const bf16_t* Ks, const bf16x8* qr, int r32, int hi) {
  p0 = f32x16{}; p1 = f32x16{};
#pragma unroll
  for (int d0 = 0; d0 < 8; ++d0) { int cb = (d0 * 16 + hi * 8) * 2;
    bf16x8 b0 = *reinterpret_cast<const bf16x8*>((const char*)Ks + KSWZ(r32, cb));
    bf16x8 b1 = *reinterpret_cast<const bf16x8*>((const char*)Ks + KSWZ(32 + r32, cb));
    p0 = __builtin_amdgcn_mfma_f32_32x32x16_bf16(b0, qr[d0], p0, 0, 0, 0);
    p1 = __builtin_amdgcn_mfma_f32_32x32x16_bf16(b1, qr[d0], p1, 0, 0, 0); }
}
__device__ __forceinline__ int v_st(int k, int c) { const int kk = (k & ~0xC) | ((k & 4) << 1) | ((k & 8) >> 1); return ((kk >> 3) * 4 + (c >> 5)) * 512 + ((kk & 7) * 32 + (c & 31)) * 2; }
__device__ __forceinline__ int v_rd_base(int lane) { return ((lane & 3) << 3) | (((lane >> 2) & 3) << 6) | (((lane >> 4) & 1) << 5) | (((lane >> 5) & 1) << 8); }
constexpr int v_rd_off(int d0, int ks, int half) { return d0 * 512 + ks * 4096 + half * 2048; }
template <int OFF> __device__ __forceinline__ s16x4 tr_read(int vb) {
  s16x4 r; asm volatile("ds_read_b64_tr_b16 %0, %1 offset:%2" : "=&v"(r) : "v"(vb), "i"(OFF) : "memory"); return r;
}
template <int D0> __device__ __forceinline__ void pv_one(f32x16& od, int vb, bf16x8 pa0, bf16x8 pa1, bf16x8 pa2, bf16x8 pa3) {
  const s16x4 l0 = tr_read<v_rd_off(D0, 0, 0)>(vb), h0 = tr_read<v_rd_off(D0, 0, 1)>(vb), l1 = tr_read<v_rd_off(D0, 1, 0)>(vb), h1 = tr_read<v_rd_off(D0, 1, 1)>(vb);
  const s16x4 l2 = tr_read<v_rd_off(D0, 2, 0)>(vb), h2 = tr_read<v_rd_off(D0, 2, 1)>(vb), l3 = tr_read<v_rd_off(D0, 3, 0)>(vb), h3 = tr_read<v_rd_off(D0, 3, 1)>(vb);
  asm volatile("s_waitcnt lgkmcnt(0)" ::: "memory"); SBAR();
#define PK(L, H) (bf16x8){L[0], L[1], L[2], L[3], H[0], H[1], H[2], H[3]}
  od = __builtin_amdgcn_mfma_f32_32x32x16_bf16(pa0, PK(l0, h0), od, 0, 0, 0);
  od = __builtin_amdgcn_mfma_f32_32x32x16_bf16(pa1, PK(l1, h1), od, 0, 0, 0);
  od = __builtin_amdgcn_mfma_f32_32x32x16_bf16(pa2, PK(l2, h2), od, 0, 0, 0);
  od = __builtin_amdgcn_mfma_f32_32x32x16_bf16(pa3, PK(l3, h3), od, 0, 0, 0);
#undef PK
}
__device__ __forceinline__ void pv_d0(f32x16* o, int vb, bf16x8 pa0, bf16x8 pa1, bf16x8 pa2, bf16x8 pa3) {
  pv_one<0>(o[0], vb, pa0, pa1, pa2, pa3); pv_one<1>(o[1], vb, pa0, pa1, pa2, pa3); pv_one<2>(o[2], vb, pa0, pa1, pa2, pa3); pv_one<3>(o[3], vb, pa0, pa1, pa2, pa3);
}
__device__ __forceinline__ void attn_dense_body(const bf16_t* __restrict__ Qb, const bf16_t* __restrict__ Kh, const bf16_t* __restrict__ Vh,
                                                bf16_t* __restrict__ Ob, int seq, char* lds, const Ctx& cx) {
  const int tid = cx.tid_(), wid = tid >> 6, lane = tid & 63, r32 = lane & 31, hi = lane >> 5;
  bf16_t* V_lds = (bf16_t*)lds; bf16_t* K_lds = (bf16_t*)(lds + 2 * SHM_V);
  float* ws = (float*)(lds + 2 * SHM_V + 2 * SHM_K) + wid * 64; float* li_l = ws; float* al_l = ws + 32;
  float m_reg = -1e30f, l_reg = 0; f32x16 o[4] = {}; bf16x8 qr[8];
  const bf16_t* Qw = Qb + (long)(wid * QBLK + r32) * LDQ + hi * 8;
#pragma unroll
  for (int d0 = 0; d0 < 8; ++d0) qr[d0] = ld8(Qw + d0 * 16);
  const int sr = tid >> 4, sc = (tid & 15) * 8, vst0 = v_st(sr, sc), vst1 = v_st(32 + sr, sc);
  const int vb0 = (int)(uintptr_t)V_lds + v_rd_base(lane);
  struct { bf16x8 vs0, vs1, ks0, ks1; } sr_[2];
#define SLOAD(i, k0) do { sr_[i].vs0 = ld8(&Vh[(long)((k0) + sr) * LDK + sc]); sr_[i].vs1 = ld8(&Vh[(long)((k0) + 32 + sr) * LDK + sc]); \
    sr_[i].ks0 = ld8(&Kh[(long)((k0) + sr) * LDK + sc]); sr_[i].ks1 = ld8(&Kh[(long)((k0) + 32 + sr) * LDK + sc]); } while (0)
#define SWRITE(b, i) do { *(bf16x8*)((char*)V_lds + (b) * SHM_V + vst0) = sr_[i].vs0;          \
    *(bf16x8*)((char*)V_lds + (b) * SHM_V + vst1) = sr_[i].vs1; int kc = sc * 2;               \
    *(bf16x8*)((char*)K_lds + (b) * SHM_K + KSWZ(sr, kc)) = sr_[i].ks0;                       \
    *(bf16x8*)((char*)K_lds + (b) * SHM_K + KSWZ(32 + sr, kc)) = sr_[i].ks1; } while (0)
#define SWAIT() asm volatile("s_waitcnt vmcnt(4)" ::: "memory")
#define RESC(a) do { if (__any((a) < 1.f)) { if (hi == 0) al_l[r32] = (a); asm volatile("s_waitcnt lgkmcnt(0)" ::: "memory"); \
    _Pragma("unroll") for (int d = 0; d < 4; ++d) _Pragma("unroll") for (int r = 0; r < 16; ++r) o[d][r] *= al_l[crow(r, hi)]; } } while (0)
  f32x16 pA0, pA1, pB0, pB1; float mnA, mnB, alA, alB; bf16x8 pa0, pa1, pa2, pa3; const int NT = seq / KVBLK;
  constexpr int SE = 0, SO = 1;
  SLOAD(SE, 0); asm volatile("s_waitcnt vmcnt(0)" ::: "memory"); SWRITE(0, SE); __syncthreads();
  qkt(pA0, pA1, K_lds, qr, r32, hi); partialSM(pA0, pA1, m_reg, mnA, alA);
  SLOAD(SO, KVBLK); if (2 < NT) SLOAD(SE, 2 * KVBLK);
  SWAIT(); SWRITE(1, SO); __syncthreads();
  for (int j = 1; j + 1 < NT; j += 2) {
    SBAR(); qkt(pB0, pB1, (bf16_t*)((char*)K_lds + SHM_K), qr, r32, hi);
    finishSM(pA0, pA1, alA, l_reg, pa0, pa1, pa2, pa3); SBAR();
    SLOAD(SO, (j + 2) * KVBLK); SBAR();
    pv_d0(o, vb0, pa0, pa1, pa2, pa3); partialSM(pB0, pB1, m_reg, mnB, alB);
    __syncthreads(); SWAIT(); SWRITE(0, SE);
    RESC(alB); __syncthreads();
    SBAR(); qkt(pA0, pA1, K_lds, qr, r32, hi);
    finishSM(pB0, pB1, alB, l_reg, pa0, pa1, pa2, pa3); SBAR();
    SLOAD(SE, min(j + 3, NT - 1) * KVBLK); SBAR();
    pv_d0(o, vb0 + (int)SHM_V, pa0, pa1, pa2, pa3); partialSM(pA0, pA1, m_reg, mnA, alA);
    __syncthreads(); SWAIT(); SWRITE(1, SO);
    RESC(alA); __syncthreads();
  }
  SBAR(); qkt(pB0, pB1, (bf16_t*)((char*)K_lds + SHM_K), qr, r32, hi);
  finishSM(pA0, pA1, alA, l_reg, pa0, pa1, pa2, pa3); SBAR();
  pv_d0(o, vb0, pa0, pa1, pa2, pa3); partialSM(pB0, pB1, m_reg, mnB, alB);
  __syncthreads(); RESC(alB);
  finishSM(pB0, pB1, alB, l_reg, pa0, pa1, pa2, pa3); SBAR();
  pv_d0(o, vb0 + (int)SHM_V, pa0, pa1, pa2, pa3);
  if (hi == 0) li_l[r32] = l_reg; asm volatile("s_waitcnt lgkmcnt(0)" ::: "memory");
  float rli[16];
#pragma unroll
  for (int r = 0; r < 16; ++r) rli[r] = __builtin_amdgcn_rcpf(li_l[crow(r, hi)]);
  bf16_t* Ow = Ob + (long)(wid * QBLK) * LDO;
#pragma unroll
  for (int r = 0; r < 16; ++r) { int orow = crow(r, hi);
#pragma unroll
    for (int d0 = 0; d0 < 4; ++d0) Ow[(long)orow * LDO + d0 * 32 + r32] = (bf16_t)(cvt_pk_bf16(o[d0][r] * rli[r], 0.f) & 0xffffu); }
#undef SLOAD
#undef SWRITE
#undef SWAIT
#undef RESC
}
}

__device__ __forceinline__ void phase_pre(const Ctx& cx, const Params& p) {
  const size_t gt = (size_t)cx.bid * 512 + cx.tid_(), nth = (size_t)cx.G * 512;
  const size_t n1 = (size_t)2 * SEQ * DM / 4, ntot = (size_t)MTOK * DM / 4;
  f32x4* X4 = (f32x4*)p.X; u32x2* XB2 = (u32x2*)(p.ws + WS_XB);
  for (size_t i = gt; i < ntot; i += 4 * nth) {
    f32x4 v[4];
#pragma unroll
    for (int e = 0; e < 4; ++e) { const size_t ii = i + e * nth; v[e] = (ii < ntot) ? ((ii < n1) ? ((const f32x4*)p.xp)[ii] : ((const f32x4*)p.xs)[ii - n1]) : (f32x4){0.f, 0.f, 0.f, 0.f}; }
#pragma unroll
    for (int e = 0; e < 4; ++e) { const size_t ii = i + e * nth; if (ii < ntot) { u32x2 w; w.x = cvt_pk_bf16(v[e][0], v[e][1]); w.y = cvt_pk_bf16(v[e][2], v[e][3]);
        const size_t tok = ii >> 9; const unsigned ch = (unsigned)(ii & 511) * 4u; XB2[((tok >> 4) * 32768 + (ch >> 4) * 256 + (tok & 15) * 16 + (ch & 15)) >> 2] = w; } }
  }
  for (size_t i = gt; i < (size_t)MTOK * 2 + 2 * DFF; i += nth) { if (i < (size_t)MTOK * 2) ((float*)(p.ws + WS_ACC))[i] = 0.f; else ((float*)(p.ws + WS_CG))[i - (size_t)MTOK * 2] = 0.f; }
  { float z0, o1; asm volatile("v_mov_b32 %0, 0" : "=v"(z0)); asm volatile("v_mov_b32 %0, 1.0" : "=v"(o1)); for (size_t i = gt; i < (size_t)MTOK; i += nth) ((f32x2*)(p.ws + WS_ONE))[i] = (f32x2){z0, o1}; }
  if (gt < 32768) {
    const int idx = (int)gt;
    const float lr = fminf(p.a_re[idx], -1e-4f), li = p.a_im[idx], dt = expf(p.log_step[idx >> 6]);
    const float er = expf(lr * dt), ang = li * dt; const float lbr = er * cosf(ang), lbi = er * sinf(ang);
    const float nr = lbr - 1.f, ni = lbi, den = lr * lr + li * li; const float cr = (nr * lr + ni * li) / den, ci = (ni * lr - nr * li) / den;
    f32x2* T = (f32x2*)(p.ws + WS_PW) + (size_t)idx * 32;
    float pr = 1.f, pi = 0.f;
#pragma unroll
    for (int d = 0; d <= 16; ++d) {
      if (d >= 1) T[15 + d] = (f32x2){pr, pi};
      if (d < 16) T[d] = (f32x2){pr * cr - pi * ci, pr * ci + pi * cr};
      const float t0 = pr * lbr - pi * lbi, t1 = pr * lbi + pi * lbr; pr = t0; pi = t1;
    }
  } else if (gt < 32768 + 2048) {
    const int e = (int)gt - 32768, pos = e >> 5, f = e & 31;
    const float inv = exp2f(-(float)f * (13.287712379549449f / 32.0f)); const float ang = (float)pos * inv;
    ((f32x2*)(p.ws + WS_ROPE))[e] = (f32x2){cosf(ang), sinf(ang)};
  }
}

__device__ __forceinline__ void cvt_job(const Ctx& cx, float* T, const float* __restrict__ src, bf16_t* __restrict__ dst, int K, int N, int ld_dst, int mode,
                                        const float* rs = nullptr, const float* rb = nullptr, float* cgo = nullptr, float* cbo = nullptr) {
  const int tid = cx.tid_(), nK = K >> 6, cnt = nK * (N >> 8);
  float* RED = T + 64 * 257 + 16;
  for (int t = cx.bid; t < cnt; t += cx.G) {
    const int k0 = (t % nK) << 6, n0 = (t / nK) << 8;
    const int r = tid >> 6, c4 = (tid & 63) * 4;
    f32x4 v[8];
#pragma unroll
    for (int i = 0; i < 8; ++i) v[i] = *(const f32x4*)(src + (size_t)(k0 + r + 8 * i) * N + n0 + c4);
    if (rs) { f32x4 pg = {0.f, 0.f, 0.f, 0.f}, pb = {0.f, 0.f, 0.f, 0.f};
#pragma unroll
      for (int i = 0; i < 8; ++i) { const float gk = rs[k0 + r + 8 * i], bk = rb[k0 + r + 8 * i]; pb += v[i] * bk; v[i] *= gk; pg += v[i]; }
      float* rp = RED + r * 256 + c4; rp[0] = pg[0]; rp[1] = pg[1]; rp[2] = pg[2]; rp[3] = pg[3]; rp += 2048; rp[0] = pb[0]; rp[1] = pb[1]; rp[2] = pb[2]; rp[3] = pb[3]; }
#pragma unroll
    for (int i = 0; i < 8; ++i) { float* tp = T + (r + 8 * i) * 257 + c4; tp[0] = v[i][0]; tp[1] = v[i][1]; tp[2] = v[i][2]; tp[3] = v[i][3]; }
    __syncthreads();
    if (rs) { const int which = tid >> 8, n = tid & 255; float s = 0.f;
#pragma unroll
      for (int rr = 0; rr < 8; ++rr) s += RED[which * 2048 + rr * 256 + n];
      __hip_atomic_fetch_add((which ? cbo : cgo) + n0 + n, s, __ATOMIC_RELAXED, __HIP_MEMORY_SCOPE_AGENT); }
    const int n = tid >> 1, kh = (tid & 1) * 32;
    const int nn = n0 + n; const int row = (mode == 0) ? nn : (((nn >> 7) << 8) + (nn & 127) + (mode == 2 ? 128 : 0));
    bf16_t* dp = dst + (size_t)row * ld_dst + k0 + kh;
#pragma unroll
    for (int q = 0; q < 4; ++q) { float w[8];
#pragma unroll
      for (int jj = 0; jj < 8; ++jj) w[jj] = T[(kh + 8 * q + jj) * 257 + n];
      u32x4 o; o.x = cvt_pk_bf16(w[0], w[1]); o.y = cvt_pk_bf16(w[2], w[3]); o.z = cvt_pk_bf16(w[4], w[5]); o.w = cvt_pk_bf16(w[6], w[7]);
      *(u32x4*)(dp + 8 * q) = o; }
    __syncthreads();
  }
}

__device__ __forceinline__ void s5_prep_item(const Ctx& cx, float* L, const Params& p, int j, int g, int hf) {
  const int tid = cx.tid_();
  f32x2* Cc = (f32x2*)L;
  f32x2* Bb = Cc + 2048;
  f32x2* PWs = Bb + 2048;
  float* Kt = (float*)(PWs + 4096);
  { float cr[4], ci[4], br[4], bi[4]; f32x2 pw[8];
#pragma unroll
    for (int k = 0; k < 4; ++k) { const int e = tid + 512 * k, dir = e >> 10, r = e & 1023; const size_t base = ((size_t)(j * 2 + dir) * 128 + g) * 1024 + r;
      cr[k] = p.c_re[base]; ci[k] = p.c_im[base]; br[k] = p.b_re[base]; bi[k] = p.b_im[base]; }
#pragma unroll
    for (int k = 0; k < 8; ++k) { const int e = tid + 512 * k, dir = e >> 11, r = e & 2047; pw[k] = ((const f32x2*)(p.ws + WS_PW))[(((size_t)(j * 2 + dir) * 128 + g) * 64) * 32 + r]; }
#pragma unroll
    for (int k = 0; k < 4; ++k) { const int e = tid + 512 * k; Cc[e] = (f32x2){cr[k], ci[k]}; Bb[e] = (f32x2){br[k], bi[k]}; }
#pragma unroll
    for (int k = 0; k < 8; ++k) PWs[tid + 512 * k] = pw[k]; }
  __syncthreads();
  { const int dir = tid >> 8, d = (tid >> 4) & 15, pp = tid & 15; float acc[16];
#pragma unroll
    for (int q = 0; q < 16; ++q) acc[q] = 0.f;
    for (int n = 0; n < 64; ++n) { const f32x2 c = Cc[(dir * 16 + pp) * 64 + n], w = PWs[(dir * 64 + n) * 32 + d];
      const float Wr = c.x * w.x - c.y * w.y, Wi = c.x * w.y + c.y * w.x;
#pragma unroll
      for (int q = 0; q < 16; ++q) { const f32x2 b = Bb[(dir * 64 + n) * 16 + q]; acc[q] += Wr * b.x - Wi * b.y; } }
#pragma unroll
    for (int q = 0; q < 16; ++q) Kt[((dir * 16 + d) * 16 + pp) * 16 + q] = acc[q]; }
  __syncthreads();
  bf16_t* Mout = (bf16_t*)(p.ws + WS_MIX + 32 * MiB); bf16_t* Mst = (bf16_t*)(p.ws + WS_MIX + 16 * MiB);
  for (int it = 0; it < 16; ++it) { const int id = it * 512 + tid, row_l = id >> 6, cgp = id & 63, t = 8 * hf + (row_l >> 4), pp = row_l & 15; float v[8];
    if (cgp < 32) { const int tp = cgp >> 1, q0 = (cgp & 1) * 8;
#pragma unroll
      for (int e = 0; e < 8; ++e) { const int q = q0 + e; float x = 0.f;
        if (tp <= t) x += Kt[((0 * 16 + (t - tp)) * 16 + pp) * 16 + q];
        if (tp >= t) x += Kt[((1 * 16 + (tp - t)) * 16 + pp) * 16 + q];
        if (tp == t && pp == q) x += p.s5_d[j * DM + g * 16 + pp];
        v[e] = x; }
    } else { const int kk0 = (cgp - 32) * 8, dir = kk0 >> 7, n0 = (kk0 & 127) >> 1, slot = 15 + (dir == 0 ? t + 1 : 16 - t);
#pragma unroll
      for (int e = 0; e < 8; ++e) { const int n = n0 + (e >> 1), ri = e & 1; const f32x2 c = Cc[(dir * 16 + pp) * 64 + n], w = PWs[(dir * 64 + n) * 32 + slot];
        v[e] = ri == 0 ? (c.x * w.x - c.y * w.y) : -(c.x * w.y + c.y * w.x); } }
    u32x4 w4; w4.x = cvt_pk_bf16(v[0], v[1]); w4.y = cvt_pk_bf16(v[2], v[3]); w4.z = cvt_pk_bf16(v[4], v[5]); w4.w = cvt_pk_bf16(v[6], v[7]);
    *(u32x4*)(Mout + ((size_t)(g * 256 + t * 16 + pp)) * 512 + cgp * 8) = w4; }
  for (int it = 0; it < 8; ++it) { const int id = it * 512 + tid, row_l = id >> 5, cgp = id & 31, dir = hf, ri = row_l & 1, n = row_l >> 1, tp = cgp >> 1, q0 = (cgp & 1) * 8;
    const f32x2 w = PWs[(dir * 64 + n) * 32 + (dir == 0 ? 15 - tp : tp)]; float v[8];
#pragma unroll
    for (int e = 0; e < 8; ++e) { const f32x2 b = Bb[(dir * 64 + n) * 16 + q0 + e]; v[e] = ri == 0 ? (w.x * b.x - w.y * b.y) : (w.x * b.y + w.y * b.x); }
    u32x4 w4; w4.x = cvt_pk_bf16(v[0], v[1]); w4.y = cvt_pk_bf16(v[2], v[3]); w4.z = cvt_pk_bf16(v[4], v[5]); w4.w = cvt_pk_bf16(v[6], v[7]);
    *(u32x4*)(Mst + ((size_t)(g * 256 + dir * 128 + row_l)) * 256 + cgp * 8) = w4; }
  __syncthreads();
}

__device__ __forceinline__ void phase_prep(const Ctx& cx, const Params& p, int layer, float* L) {
  const int kind = layer % 3, j = layer / 3;
  if (kind == 0) { for (int it = cx.bid; it < 256; it += cx.G) s5_prep_item(cx, L, p, j, it >> 1, it & 1); }
  cvt_job(cx, L, p.w1 + (size_t)layer * DM * DFF, (bf16_t*)(p.ws + WS_W1T), DM, DFF, DM, 0, LAZY_SCHED ? p.ln1g + layer * DM : nullptr, p.ln1b + layer * DM, (float*)(p.ws + WS_CG), (float*)(p.ws + WS_CG) + DFF);
  cvt_job(cx, L, p.w2 + (size_t)layer * DFF * DM, (bf16_t*)(p.ws + WS_W2T), DFF, DM, DFF, 0);
  if (kind == 0) {
    cvt_job(cx, L, p.s5_wout + (size_t)j * DM * DM, (bf16_t*)(p.ws + WS_MIX), DM, DM, DM, 1);
    cvt_job(cx, L, p.s5_wgate + (size_t)j * DM * DM, (bf16_t*)(p.ws + WS_MIX), DM, DM, DM, 2);
  } else if (kind == 1) {
    for (int gi = 0; gi < 4; ++gi) cvt_job(cx, L, p.pool_w + (size_t)gi * 512 * 512, (bf16_t*)(p.ws + WS_MIX) + (size_t)gi * 512 * 512, 512, 512, 512, 0);
  } else {
    cvt_job(cx, L, p.wqkv, (bf16_t*)(p.ws + WS_MIX), DM, QKVD, DM, 0);
    cvt_job(cx, L, p.wo, (bf16_t*)(p.ws + WS_MIX + 12 * MiB), DM, DM, DM, 0);
  }
}

__device__ __forceinline__ void phase_scan(const Ctx& cx, const Params& p, int j) {
  const int lane = cx.tid_() & 63, wave = cx.tid_() >> 6;
  const bf16_t* S = (const bf16_t*)(p.ws + WS_R); bf16_t* H = (bf16_t*)(p.ws + WS_R + 320 * MiB);
  for (int item = wave * cx.G + cx.bid; item < NBATCH * 128; item += 8 * cx.G) {
    const int g = item & 127, b = item >> 7;
    const f32x2 lamF = ((const f32x2*)(p.ws + WS_PW))[(((size_t)(j * 2 + 0) * 128 + g) * 64 + lane) * 32 + 31];
    const f32x2 lamB = ((const f32x2*)(p.ws + WS_PW))[(((size_t)(j * 2 + 1) * 128 + g) * 64 + lane) * 32 + 31];
    f32x2 hF = {0.f, 0.f}, hB = {0.f, 0.f};
    const unsigned* Sb = (const unsigned*)(S + (size_t)b * 256 * 32768 + g * 256 + 2 * lane);
    unsigned* Hb = (unsigned*)(H + (size_t)b * 256 * 32768 + g * 256 + 2 * lane);
    unsigned sF[8], sB[8];
#pragma unroll
    for (int e = 0; e < 8; ++e) { sF[e] = Sb[(size_t)e * 16384]; sB[e] = Sb[(size_t)(255 - e) * 16384 + 64]; }
    for (int c0 = 0; c0 < 256; c0 += 8) {
      unsigned nF[8], nB[8]; const int c1 = (c0 + 8 < 256) ? c0 + 8 : c0;
#pragma unroll
      for (int e = 0; e < 8; ++e) { nF[e] = Sb[(size_t)(c1 + e) * 16384]; nB[e] = Sb[(size_t)(255 - c1 - e) * 16384 + 64]; }
#pragma unroll
      for (int e = 0; e < 8; ++e) { const int cF = c0 + e, cB = 255 - c0 - e;
        Hb[(size_t)cF * 16384] = cvt_pk_bf16(hF.x, hF.y); Hb[(size_t)cB * 16384 + 64] = cvt_pk_bf16(hB.x, hB.y);
        const float sfx = __uint_as_float(sF[e] << 16), sfy = __uint_as_float(sF[e] & 0xffff0000u), sbx = __uint_as_float(sB[e] << 16), sby = __uint_as_float(sB[e] & 0xffff0000u);
        const float fr_ = lamF.x * hF.x - lamF.y * hF.y + sfx, fi_ = lamF.x * hF.y + lamF.y * hF.x + sfy; hF.x = fr_; hF.y = fi_;
        const float br_ = lamB.x * hB.x - lamB.y * hB.y + sbx, bi_ = lamB.x * hB.y + lamB.y * hB.x + sby; hB.x = br_; hB.y = bi_; }
#pragma unroll
      for (int e = 0; e < 8; ++e) { sF[e] = nF[e]; sB[e] = nB[e]; }
    }
  }
}

#ifndef LN_REPS
#define LN_REPS 1
#endif
__device__ __forceinline__ void phase_ln(const Ctx& cx, const Params& p, const float* gam, const float* bet, bool final_, bool s5lay, bool dummy_in) {
 for (int rep = 0; rep < LN_REPS; ++rep) { const bool dummy = dummy_in || rep > 0; if (rep > 0) final_ = false;
  const int lane = cx.tid_() & 63, gw = cx.bid * 8 + (cx.tid_() >> 6), nw = cx.G * 8;
  if (!dummy) for (int i = cx.bid * 512 + cx.tid_(); i < 2 * DFF; i += cx.G * 512) ((float*)(p.ws + WS_CG))[i] = 0.f;
  f32x2* ST = (f32x2*)(p.ws + (dummy ? WS_R + 480 * MiB : WS_ST));
  int row = gw; f32x4 v[8], g4[8], b4[8];
#pragma unroll
  for (int k = 0; k < 8; ++k) { g4[k] = ((const f32x4*)gam)[k * 64 + lane]; b4[k] = ((const f32x4*)bet)[k * 64 + lane]; }
  { const f32x4* xr = (const f32x4*)(p.X + (size_t)min(row, MTOK - 1) * DM);
#pragma unroll
    for (int k = 0; k < 8; ++k) v[k] = xr[k * 64 + lane]; }
  while (row < MTOK) {
    const int nrow = row + nw; f32x4 nv[8];
    { const f32x4* xn = (const f32x4*)(p.X + (size_t)min(nrow, MTOK - 1) * DM);
#pragma unroll
      for (int k = 0; k < 8; ++k) nv[k] = xn[k * 64 + lane]; }
    u32x2* xb0 = (u32x2*)(p.ws + (dummy ? WS_R + 320 * MiB : WS_XB)); u32x2* xb = xb0 + (size_t)row * (DM / 4);
    f32x4* xo = dummy ? (f32x4*)(p.ws + WS_R) + (size_t)row * (DM / 4) : (f32x4*)(p.X + (size_t)row * DM);
    float s = 0.f, q = 0.f;
#pragma unroll
    for (int k = 0; k < 8; ++k) { s += (v[k][0] + v[k][1]) + (v[k][2] + v[k][3]); q += (v[k][0] * v[k][0] + v[k][1] * v[k][1]) + (v[k][2] * v[k][2] + v[k][3] * v[k][3]); }
#pragma unroll
    for (int o = 32; o >= 1; o >>= 1) { const float s2 = __int_as_float(__builtin_amdgcn_ds_bpermute((lane ^ o) << 2, __float_as_int(s))), q2 = __int_as_float(__builtin_amdgcn_ds_bpermute((lane ^ o) << 2, __float_as_int(q))); s += s2; q += q2; }
    const float mean = s * (1.0f / DM); const float rstd = rsqrtf(fmaxf(q * (1.0f / DM) - mean * mean, 0.f) + LN_EPS);
    if (lane == 0) { ST[row] = (f32x2){mean, rstd}; if (!dummy) { float z0; asm volatile("v_mov_b32 %0, 0" : "=v"(z0)); ((f32x2*)(p.ws + WS_ACC))[row] = (f32x2){z0, z0}; } }
#pragma unroll
    for (int k = 0; k < 8; ++k) {
      const f32x4 o = ((v[k] - mean) * rstd) * g4[k] + b4[k];
      if (final_) xo[k * 64 + lane] = o;
      else { u32x2 w; w.x = cvt_pk_bf16(o[0], o[1]); w.y = cvt_pk_bf16(o[2], o[3]);
        if (s5lay) { const unsigned ch = (unsigned)(k * 64 + lane) * 4u; xb0[((size_t)(row >> 4) * 32768 + (ch >> 4) * 256 + (row & 15) * 16 + (ch & 15)) >> 2] = w; }
        else xb[k * 64 + lane] = w; } }
#pragma unroll
    for (int k = 0; k < 8; ++k) v[k] = nv[k];
    row = nrow;
  }
 }
}

__device__ __forceinline__ f32x4 ldbf4(const u32x2* p) { const u32x2 u = *p; return (f32x4){__uint_as_float(u.x << 16), __uint_as_float(u.x & 0xffff0000u), __uint_as_float(u.y << 16), __uint_as_float(u.y & 0xffff0000u)}; }
__device__ __forceinline__ void phase_poolpre(const Ctx& cx, const Params& p) {
  const int tid = cx.tid_(); const int gi = tid >> 7, w2 = 1 << gi;
  u32x2* P = (u32x2*)(p.ws + WS_R);
  for (int it = cx.bid; it < NBATCH * 128; it += cx.G) {
    const int b = it >> 7, t0 = (it & 127) * 32;
    const u32x2* xb = (const u32x2*)(p.ws + WS_XB) + (size_t)b * SEQ * (DM / 4) + tid;
    f32x4 s = {0.f, 0.f, 0.f, 0.f};
    for (int k = -w2; k < w2; ++k) { const int tt = t0 + k; const float m = (tt >= 0 && tt < SEQ) ? 1.f : 0.f; const int tc = min(max(tt, 0), SEQ - 1); s += ldbf4(xb + (size_t)tc * (DM / 4)) * m; }
    for (int i0 = 0; i0 < 32; i0 += 8) {
      f32x4 c[8], ad[8], sb[8];
#pragma unroll
      for (int e = 0; e < 8; ++e) { const int t = t0 + i0 + e; c[e] = ldbf4(xb + (size_t)t * (DM / 4));
        const int ta = t + w2, ts = t - w2; const float ma = ta < SEQ ? 1.f : 0.f, ms = ts >= 0 ? 1.f : 0.f;
        ad[e] = ldbf4(xb + (size_t)min(ta, SEQ - 1) * (DM / 4)) * ma; sb[e] = ldbf4(xb + (size_t)max(ts, 0) * (DM / 4)) * ms; }
#pragma unroll
      for (int e = 0; e < 8; ++e) { const int t = t0 + i0 + e; const int lo = max(t - w2, 0), hi = min(t + w2, SEQ); const float inv = 1.0f / (float)(hi - lo);
        const f32x4 o = s * inv - c[e]; u32x2 w; w.x = cvt_pk_bf16(o[0], o[1]); w.y = cvt_pk_bf16(o[2], o[3]); P[((size_t)b * SEQ + t) * (DM / 4) + tid] = w;
        s += ad[e] - sb[e]; }
    }
  }
}

__device__ __forceinline__ void phase_rope(const Ctx& cx, const Params& p, bool dummy) {
  const int lane = cx.tid_() & 63, gw = cx.bid * 8 + (cx.tid_() >> 6), nw = cx.G * 8;
  const int hsel = lane >> 5, li = lane & 31, s = li >> 4, fp = li & 15, e0 = s * 64 + 2 * fp, e1 = e0 + 32;
  const f32x2 qa = *(const f32x2*)(p.qnorm + e0), qb = *(const f32x2*)(p.qnorm + e1), ka = *(const f32x2*)(p.knorm + e0), kb = *(const f32x2*)(p.knorm + e1);
  const f32x4* RT = (const f32x4*)(p.ws + WS_ROPE);
  bf16_t* QKV = (bf16_t*)(p.ws + WS_R); bf16_t* Kc = (bf16_t*)(p.ws + WS_R + 400 * MiB); bf16_t* Vc = (bf16_t*)(p.ws + WS_R + 440 * MiB);
  for (int tok = gw; tok < MTOK; tok += nw) {
    const int t = tok & (SEQ - 1); const int pos = s == 0 ? (t >> 6) : (t & 63); const f32x4 cs = RT[pos * 16 + fp];
    bf16_t* row = QKV + (size_t)tok * QKVD;
    unsigned ua[10], ub[10];
    const u32x4 vv = *(const u32x4*)(row + 2560 + (lane >> 4) * 128 + (lane & 15) * 8);
#pragma unroll
    for (int i = 0; i < 10; ++i) { const int hd = 2 * i + hsel; ua[i] = *(const unsigned*)(row + hd * 128 + e0); ub[i] = *(const unsigned*)(row + hd * 128 + e1); }
#pragma unroll
    for (int i = 0; i < 10; ++i) {
      const int hd = 2 * i + hsel; bf16_t* orow_ = (i < 8) ? row + hd * 128 : Kc + ((size_t)((tok >> 12) * 4 + (hd - 16)) * SEQ + t) * 128;
      unsigned* p0 = (unsigned*)(orow_ + e0); unsigned* p1 = (unsigned*)(orow_ + e1);
      const unsigned u0 = ua[i], u1 = ub[i];
      const float x1a = __uint_as_float(u0 << 16), x1b = __uint_as_float(u0 & 0xffff0000u), x2a = __uint_as_float(u1 << 16), x2b = __uint_as_float(u1 & 0xffff0000u);
      float ss = (x1a * x1a + x1b * x1b) + (x2a * x2a + x2b * x2b);
#pragma unroll
      for (int o = 16; o >= 1; o >>= 1) ss += __int_as_float(__builtin_amdgcn_ds_bpermute((lane ^ o) << 2, __float_as_int(ss)));
      const float r = rsqrtf(ss * (1.0f / 128.0f) + RMS_EPS); const bool isq = hd < 16;
      const float y1a = x1a * r * (isq ? qa.x : ka.x), y1b = x1b * r * (isq ? qa.y : ka.y), y2a = x2a * r * (isq ? qb.x : kb.x), y2b = x2b * r * (isq ? qb.y : kb.y);
      const float o1a = y1a * cs[0] - y2a * cs[1], o2a = y2a * cs[0] + y1a * cs[1], o1b = y1b * cs[2] - y2b * cs[3], o2b = y2b * cs[2] + y1b * cs[3];
      if (!dummy || o1a == 1.2345e30f) { *p0 = cvt_pk_bf16(o1a, o1b); *p1 = cvt_pk_bf16(o2a, o2b); }
    }
    *(u32x4*)(Vc + ((size_t)((tok >> 12) * 4 + (lane >> 4)) * SEQ + t) * 128 + (lane & 15) * 8) = vv;
  }
}

__device__ __forceinline__ void phase_attn(const Ctx& cx, const Params& p, char* lds) {
  const bf16_t* QKV = (const bf16_t*)(p.ws + WS_R); bf16_t* O = (bf16_t*)(p.ws + WS_R + 240 * MiB);
  const int G = cx.G, c = cx.bid;
  for (int r = 0;; ++r) {
    int pair, unit;
    if (G == 256) { if (r >= 10) break; const int xcd = c & 7, idx = c >> 3; pair = xcd * 5 + (r >> 1); unit = (r & 1) * 32 + idx; }
    else { const int L = r * G + c; if (L >= 2560) break; pair = L >> 6; unit = L & 63; }
    const int b = pair >> 2, kvh = pair & 3, hq = kvh * 4 + (unit >> 4), qb = unit & 15;
    const bf16_t* Qp = QKV + ((size_t)b * SEQ + qb * 256) * QKVD + hq * 128;
    const bf16_t* Kp = (const bf16_t*)(p.ws + WS_R + 400 * MiB) + (size_t)pair * SEQ * 128;
    const bf16_t* Vp = (const bf16_t*)(p.ws + WS_R + 440 * MiB) + (size_t)pair * SEQ * 128;
    bf16_t* Op = O + ((size_t)b * SEQ + qb * 256) * DM + hq * 128;
    att::attn_dense_body(Qp, Kp, Vp, Op, SEQ, lds, cx);
    __syncthreads();
  }
}


#define XB_TMO      128
#define XB_XCNT(j)  (256  + 64 * (j))
#define XB_XSUB(j)  (1280 + 64 * (j))
#define XB_XGEN(j)  (2304 + 64 * (j))
#define XB_TOP      3328
#define XB_TOPGEN   3392
#define XCD_BAR_WORDS 3456
#define XB_SPIN_CAP (1u << 22)
__device__ __forceinline__ unsigned xb_ld(unsigned* p)              { return __hip_atomic_load(p, __ATOMIC_RELAXED, __HIP_MEMORY_SCOPE_AGENT); }
__device__ __forceinline__ unsigned xb_add(unsigned* p, unsigned v) { return __hip_atomic_fetch_add(p, v, __ATOMIC_RELAXED, __HIP_MEMORY_SCOPE_AGENT); }
__device__ __forceinline__ unsigned xb_xcc_id() { return (unsigned)__builtin_amdgcn_s_getreg((3 << 11) | 20) & 0xFu; }
#define XB_SPIN(cond, bar) do { unsigned _sp = 0; while (cond) { __builtin_amdgcn_s_sleep(1); \
    if ((++_sp & 255u) == 0u) { if (xb_ld(&(bar)[XB_TMO])) break; if (_sp > XB_SPIN_CAP) { atomicAdd(&(bar)[XB_TMO], 1u); break; } } } } while (0)
__device__ __forceinline__ void xcd_barrier_complete(unsigned* bar, unsigned x, unsigned G, unsigned& nloc, unsigned& nx) {
  unsigned sum, cnt, mine, sp = 0u;
  for (;;) {
    sum = 0u; cnt = 0u; mine = 0u;
#pragma unroll
    for (unsigned j = 0; j < 16; ++j) { const unsigned c = xb_ld(&bar[XB_XCNT(j)]); sum += c; cnt += (c > 0u) ? 1u : 0u; mine = (j == x) ? c : mine; }
    if (sum == G) break;
    __builtin_amdgcn_s_sleep(1);
    if ((++sp & 255u) == 0u) { if (xb_ld(&bar[XB_TMO])) break; if (sp > XB_SPIN_CAP) { atomicAdd(&bar[XB_TMO], 1u); break; } }
  }
  nloc = mine > 0u ? mine : 1u; nx = cnt > 0u ? cnt : 1u;
}
__device__ __forceinline__ void xcd_barrier(const Ctx& cx, unsigned* bar, volatile LAS unsigned* st) {
  asm volatile("s_waitcnt vmcnt(0)" ::: "memory");
  __syncthreads();
  if (cx.tid_() == 0) {
    const unsigned x = xb_xcc_id();
    __builtin_amdgcn_s_waitcnt(0);
    unsigned nloc = st[0], nx = st[1];
    if (nloc == 0u) { xcd_barrier_complete(bar, x, (unsigned)cx.G, nloc, nx); st[0] = nloc; st[1] = nx; }
    const unsigned old = xb_add(&bar[XB_XSUB(x)], 1u);
    const unsigned gen = old / nloc;
    if (old + 1u == (gen + 1u) * nloc) {
      __builtin_amdgcn_fence(__ATOMIC_RELEASE, "agent");
      asm volatile("s_waitcnt vmcnt(0)" ::: "memory");
      const unsigned og = xb_add(&bar[XB_TOP], 1u);
      const unsigned tg = og / nx;
      if (og + 1u == (tg + 1u) * nx) xb_add(&bar[XB_TOPGEN], 1u);
      else XB_SPIN(xb_ld(&bar[XB_TOPGEN]) == tg, bar);
      __builtin_amdgcn_fence(__ATOMIC_ACQUIRE, "agent");
      xb_add(&bar[XB_XGEN(x)], 1u);
      asm volatile("s_waitcnt vmcnt(0)" ::: "memory");
    } else {
      XB_SPIN(xb_ld(&bar[XB_XGEN(x)]) == gen, bar);
      __builtin_amdgcn_fence(__ATOMIC_ACQUIRE, "agent");
      asm volatile("s_waitcnt vmcnt(0)" ::: "memory");
    }
  }
  __syncthreads();
}

enum { T_PRE = 0, T_PREP, T_S5G1, T_SCAN, T_S5G2, T_GLU, T_LN1, T_UP, T_DOWN, T_LN2, T_POOLPRE, T_POOLG, T_QKV, T_ROPE, T_ATT, T_WO };

constexpr int NSTEPS = LAZY_SCHED ? 31 : 32;
#ifndef PROBE_MASK
#define PROBE_MASK 0
#endif


__device__ __forceinline__ void run_step(const Ctx& cx, const Params& p, int type, int layer, unsigned char* lds, bool dummy) {
  using namespace pg8;
  unsigned char* ws = p.ws;
  const int j = layer / 3;
  bool is_gemm = false; pg8::GemmDesc g;
  g.A = nullptr; g.A2 = nullptr; g.Bt = nullptr; g.rowStrideA = DM * 2; g.ldbBytes = DM * 2; g.pnStrideA = 0; g.pnShift = 0; g.chunked = 0; g.ksplit = 1 << 20; g.nt = 32; g.nM = MTOK / 256; g.nN = 8;
  g.mode = 0; g.out = nullptr; g.ldc = DM; g.lnsel = 0; g.flags = 0; g.layer = layer; g.wgm = WGM_OTHER;
  switch (type) {
    case T_PRE: phase_pre(cx, p); break;
    case T_PREP: phase_prep(cx, p, layer, (float*)lds); break;
    case T_S5G1: is_gemm = true; g.A = (const char*)(ws + WS_XB); g.A2 = g.A; g.Bt = (const char*)(ws + WS_MIX + 16 * MiB); g.rowStrideA = 65536; g.ldbBytes = 512; g.pnStrideA = 512;
      g.nt = 4; g.nM = 10; g.nN = 128; g.mode = 0; g.out = ws + WS_R; g.ldc = 32768; break;
    case T_SCAN: phase_scan(cx, p, j); break;
    case T_S5G2: is_gemm = true; g.A = (const char*)(ws + WS_XB); g.A2 = (const char*)(ws + WS_R + 320 * MiB); g.Bt = (const char*)(ws + WS_MIX + 32 * MiB); g.rowStrideA = 65536; g.ldbBytes = 1024; g.pnStrideA = 512;
      g.ksplit = 4; g.nt = 8; g.nM = 10; g.nN = 128; g.mode = 2; g.out = ws + WS_R + 480 * MiB; g.ldc = 32768; break;
    case T_GLU: is_gemm = true; g.A = (const char*)(ws + WS_R + 480 * MiB); g.A2 = g.A; g.Bt = (const char*)(ws + WS_MIX); g.chunked = 1; g.nN = 16; g.mode = 5; g.out = p.X; if (layer > 0) { g.flags = F_LN_STATS | (EMIT_ON ? F_EMIT : 0); g.lnsel = 2; } else g.flags = F_XIN | (EMIT_ON ? F_EMIT : 0); break;
    case T_LN1: phase_ln(cx, p, p.ln1g + layer * DM, p.ln1b + layer * DM, false, false, dummy); break;
    case T_UP: is_gemm = true; g.A = (const char*)(ws + WS_XB); g.A2 = g.A; g.Bt = (const char*)(ws + WS_W1T); g.nN = 32; g.mode = 1; g.out = ws + WS_R; g.ldc = DFF; g.wgm = WGM_UP; g.flags = LAZY_SCHED ? (F_LN_ACC | F_FOLD) : 0; break;
    case T_DOWN: is_gemm = true; g.A = (const char*)(ws + WS_R); g.A2 = g.A; g.Bt = (const char*)(ws + WS_W2T); g.rowStrideA = DFF * 2; g.ldbBytes = DFF * 2; g.nt = 128; g.mode = 3; g.out = p.X; g.wgm = WGM_DOWN; g.flags = LAZY_SCHED ? F_LN_ACC : F_LN_STATS; g.lnsel = 1; break;
    case T_LN2: phase_ln(cx, p, p.ln2g + layer * DM, p.ln2b + layer * DM, layer == 3, layer == 2, dummy);
      if (!LAZY_SCHED && layer < 3) { __syncthreads(); phase_prep(cx, p, layer + 1, (float*)lds); } break;
    case T_POOLPRE: phase_poolpre(cx, p); break;
    case T_POOLG: is_gemm = true; g.A = (const char*)(ws + WS_R); g.A2 = g.A; g.Bt = (const char*)(ws + WS_MIX); g.ldbBytes = 1024; g.pnStrideA = 1024; g.pnShift = 1; g.nt = 8; g.mode = 4; g.out = p.X; g.flags = F_CSCALE | F_LN_STATS | (EMIT_ON ? F_EMIT : 0); g.lnsel = 2; break;
    case T_QKV: is_gemm = true; g.A = (const char*)(ws + WS_XB); g.A2 = g.A; g.Bt = (const char*)(ws + WS_MIX); g.nN = 12; g.mode = 0; g.out = ws + WS_R; g.ldc = QKVD; break;
    case T_ROPE: phase_rope(cx, p, dummy); break;
    case T_ATT: phase_attn(cx, p, (char*)lds); break;
    case T_WO: is_gemm = true; g.A = (const char*)(ws + WS_R + 240 * MiB); g.A2 = g.A; g.Bt = (const char*)(ws + WS_MIX + 12 * MiB); g.mode = 3; g.out = p.X; g.flags = F_LN_STATS | (EMIT_ON ? F_EMIT : 0); g.lnsel = 2; break;
    default: break;
  }
  if (is_gemm) { if (dummy && g.mode >= 3 && g.mode <= 5) g.mode = 7; pg8::gemm_phase(cx, (LAS unsigned char*)lds, g); }
}


__device__ __forceinline__ void step_info(int s, int& type, int& layer) {
  if (s == 0) { type = T_PRE; layer = 0; return; }
  int r;
#if LAZY_SCHED
  if (s < 9) { layer = 0; r = s - 1; } else if (s < 15) { layer = 1; r = s - 9; } else if (s < 23) { layer = 2; r = s - 15; } else { layer = 3; r = s - 23; }
#else
  if (s < 10) { layer = 0; r = s - 1; } else if (s < 16) { layer = 1; r = s - 10 + 1; } else if (s < 24) { layer = 2; r = s - 16 + 1; } else { layer = 3; r = s - 24 + 1; }
#endif
  const int kind = layer % 3;
  if (r == 0) { type = T_PREP; return; }
  const int nmix = kind == 1 ? 2 : 4;
  if (r <= nmix) {
    const int m = r - 1;
    if (kind == 0) type = (m == 0) ? T_S5G1 : (m == 1) ? T_SCAN : (m == 2) ? T_S5G2 : T_GLU;
    else if (kind == 1) type = (m == 0) ? T_POOLPRE : T_POOLG;
    else type = (m == 0) ? T_QKV : (m == 1) ? T_ROPE : (m == 2) ? T_ATT : T_WO;
    return;
  }
  const int q = r - nmix - 1;
#if LAZY_SCHED
  type = (q == 0) ? T_UP : (q == 1) ? T_DOWN : T_LN2;
#else
  type = (q == 0) ? T_LN1 : (q == 1) ? T_UP : (q == 2) ? T_DOWN : T_LN2;
#endif
}
__global__ void __launch_bounds__(512) fwd_megakernel(Params p_unused) {
  extern __shared__ __attribute__((aligned(16))) unsigned char lds[];
  cg::grid_group grid = cg::this_grid();
  const int wave0 = __builtin_amdgcn_readfirstlane((int)threadIdx.x >> 6);
  { volatile LAS unsigned* st0 = (volatile LAS unsigned*)((LAS unsigned char*)lds + 128 * 1024);
    if (threadIdx.x < 4) st0[threadIdx.x] = 0u;
    __syncthreads();
    KargP pq = (KargP)__builtin_amdgcn_kernarg_segment_ptr();
    if (threadIdx.x == 0) (void)xb_add(&((unsigned*)(pq->ws + WS_BAR))[XB_XCNT(xb_xcc_id())], 1u); }
  for (int s = 0; s < NSTEPS; ++s) {
    int type, layer; step_info(s, type, layer);
    KargP pp = (KargP)__builtin_amdgcn_kernarg_segment_ptr();
    asm volatile("" : "+s"(pp));
    Ctx cx; { int b_ = (int)blockIdx.x, g_ = (int)gridDim.x; asm volatile("" : "+s"(b_)); asm volatile("" : "+s"(g_)); cx.wave0 = wave0; cx.bid = b_; cx.G = g_; }
#if defined(__HIP_DEVICE_COMPILE__)
    const Params p = *pp;
#else
    const Params p = p_unused;
#endif
    run_step(cx, p, type, layer, lds, false);
    if (s + 1 < NSTEPS) {
      if (s == 0) grid.sync();
      else { xcd_barrier(cx, (unsigned*)(p.ws + WS_BAR), (volatile LAS unsigned*)((LAS unsigned char*)lds + 128 * 1024)); }
    }
  }
}
extern "C" void kernel_launch(void* const* d_in, const int* in_sizes, int n_in, void* d_out, int out_size, void* d_ws, size_t ws_size,
                              hipStream_t stream) {
  static int grid_blocks = 0;
  if (!grid_blocks) {
    int dev = 0, cus = 0, per_cu = 0;
    (void)hipGetDevice(&dev);
    (void)hipDeviceGetAttribute(&cus, hipDeviceAttributeMultiprocessorCount, dev);
    (void)hipFuncSetAttribute((const void*)fwd_megakernel, hipFuncAttributeMaxDynamicSharedMemorySize, LDS_BYTES);
    (void)hipOccupancyMaxActiveBlocksPerMultiprocessor(&per_cu, (const void*)fwd_megakernel, 512, LDS_BYTES);
    if (per_cu != 1) per_cu = 1;
    grid_blocks = cus * per_cu;
    if (ws_size < WS_END) fprintf(stderr, "kernel_launch: workspace too small: %zu < %zu\n", ws_size, (size_t)WS_END);
  }
  Params p{};
  p.xp = (const float*)d_in[0]; p.xs = (const float*)d_in[1];
  p.a_re = (const float*)d_in[2]; p.a_im = (const float*)d_in[3]; p.log_step = (const float*)d_in[4];
  p.b_re = (const float*)d_in[5]; p.b_im = (const float*)d_in[6]; p.c_re = (const float*)d_in[7]; p.c_im = (const float*)d_in[8];
  p.s5_d = (const float*)d_in[9]; p.s5_wout = (const float*)d_in[10]; p.s5_wgate = (const float*)d_in[11];
  p.pool_w = (const float*)d_in[12]; p.pool_scale = (const float*)d_in[13];
  p.wqkv = (const float*)d_in[14]; p.qnorm = (const float*)d_in[15]; p.knorm = (const float*)d_in[16]; p.wo = (const float*)d_in[17];
  p.ln1g = (const float*)d_in[18]; p.ln1b = (const float*)d_in[19]; p.ln2g = (const float*)d_in[20]; p.ln2b = (const float*)d_in[21];
  p.w1 = (const float*)d_in[22]; p.w2 = (const float*)d_in[23];
  p.X = (float*)d_out; p.ws = (unsigned char*)d_ws;
  (void)hipMemsetAsync((char*)d_ws + WS_BAR, 0, XCD_BAR_WORDS * 4, stream);
  void* args[] = {&p};
  hipError_t e = hipLaunchCooperativeKernel((const void*)fwd_megakernel, dim3(grid_blocks), dim3(512), args, LDS_BYTES, stream);
  if (e != hipSuccess) fprintf(stderr, "cooperative launch failed: %s (grid %d)\n", hipGetErrorString(e), grid_blocks);
}
```

```cpp
#include <hip/hip_runtime.h>
#include <hip/hip_cooperative_groups.h>
#include <cstdio>
#include <cstdint>
namespace cg = cooperative_groups;
#ifndef WGM_DOWN
#define WGM_DOWN 4
#endif
#ifndef WGM_UP
#define WGM_UP 8
#endif
#ifndef WGM_OTHER
#define WGM_OTHER 4
#endif
#ifndef LAZY_SCHED
#define LAZY_SCHED 0
#endif
#ifndef EMIT_ON
#define EMIT_ON 0
#endif

#define LAS __attribute__((address_space(3)))
typedef unsigned short bf16_t;
typedef short bf16x8 __attribute__((ext_vector_type(8)));
typedef short s16x4 __attribute__((ext_vector_type(4)));
typedef float f32x2 __attribute__((ext_vector_type(2)));
typedef float f32x4 __attribute__((ext_vector_type(4)));
typedef float f32x16 __attribute__((ext_vector_type(16)));
typedef unsigned u32x2 __attribute__((ext_vector_type(2)));
typedef unsigned u32x4 __attribute__((ext_vector_type(4)));

constexpr int DM = 2048, NBATCH = 10, SEQ = 4096, MTOK = NBATCH * SEQ, DFF = 8192, QKVD = 3072;
constexpr float ALPHA = 1.681792830507429f;
constexpr float LN_EPS = 1e-5f, RMS_EPS = 1e-6f;
constexpr size_t MiB = 1024ull * 1024ull;
constexpr size_t WS_PW = 0;
constexpr size_t WS_ROPE = 8 * MiB;
constexpr size_t WS_BAR = 10 * MiB;
constexpr size_t WS_ACC = 11 * MiB;
constexpr size_t WS_CG = 12 * MiB;
constexpr size_t WS_ONE = 13 * MiB;
constexpr size_t WS_ST = 9 * MiB;
constexpr size_t WS_WB = 16 * MiB;
constexpr size_t WS_W1T = WS_WB, WS_W2T = WS_WB + 32 * MiB, WS_MIX = WS_WB + 64 * MiB;
constexpr size_t WS_XB = 144 * MiB;
constexpr size_t WS_R = 304 * MiB;
constexpr size_t WS_END = WS_R + 640 * MiB;
constexpr int LDS_BYTES = 129 * 1024;

struct Params {
  const float* xp; const float* xs;
  const float* a_re; const float* a_im; const float* log_step; const float* b_re; const float* b_im; const float* c_re; const float* c_im;
  const float* s5_d; const float* s5_wout; const float* s5_wgate; const float* pool_w; const float* pool_scale;
  const float* wqkv; const float* qnorm; const float* knorm; const float* wo;
  const float* ln1g; const float* ln1b; const float* ln2g; const float* ln2b; const float* w1; const float* w2;
  float* X; unsigned char* ws;
};

typedef __attribute__((address_space(4))) const Params* KargP;
struct Ctx { int wave0, bid, G;
  __device__ __forceinline__ int tid_() const { int l_; asm volatile("v_mbcnt_lo_u32_b32 %0, -1, 0\n\tv_mbcnt_hi_u32_b32 %0, -1, %0" : "=v"(l_)); return wave0 * 64 + l_; } };
__device__ __forceinline__ unsigned cvt_pk_bf16(float lo, float hi) { unsigned r; asm volatile("v_cvt_pk_bf16_f32 %0, %1, %2" : "=v"(r) : "v"(lo), "v"(hi)); return r; }
__device__ __forceinline__ float bf2f(bf16_t h) { return __uint_as_float(((unsigned)h) << 16); }
__device__ __forceinline__ float wave_sum(float v, int lane) {
#pragma unroll
  for (int o = 32; o >= 1; o >>= 1) v += __int_as_float(__builtin_amdgcn_ds_bpermute((lane ^ o) << 2, __float_as_int(v)));
  return v;
}
__device__ __forceinline__ float gelu_tanh(float x) {
  const float u = 0.7978845608028654f * (x + 0.044715f * x * x * x);
  return x * __builtin_amdgcn_rcpf(1.0f + __builtin_amdgcn_exp2f(-2.885390081777927f * u));
}
__device__ __forceinline__ float sigmoidf_(float x) { return __builtin_amdgcn_rcpf(1.0f + __builtin_amdgcn_exp2f(-1.4426950408889634f * x)); }

namespace pg8 {
constexpr int BM = 256, BK = 64, HALF = 128, HTB = HALF * BK * 2, STAGE_BYTES = 8 * HTB, NXCD = 8, WGM = 4;
__device__ __forceinline__ int lds_byte(int r, int c) { const int st = (r >> 4) * 2 + (c >> 5), rr = r & 15, cc = c & 31, ob = rr * 64 + cc * 2; return st * 1024 + (ob ^ (((ob >> 9) & 1) << 5)); }
__device__ __forceinline__ void stage_rc(int b, int& R, int& C) { const int st = b / 1024, sb = b % 1024, swz = sb ^ (((sb >> 9) & 1) << 5); R = (st >> 1) * 16 + swz / 64; C = (st & 1) * 32 + (swz % 64) / 2; }
__device__ __forceinline__ int perm32(int rho) { const int n = rho >> 4, i = rho & 15; return 8 * (i >> 2) + 4 * n + (i & 3); }

struct Unit { int pm, pn; };
struct GemmDesc {
  const char* A; const char* A2; const char* Bt;
  unsigned rowStrideA, ldbBytes, pnStrideA; int pnShift, chunked, ksplit, nt, nM, nN;
  int mode; void* out; int ldc;
  int wgm;
  int lnsel, flags, layer;
};
enum { F_LN_STATS = 1, F_LN_ACC = 2, F_EMIT = 4, F_XIN = 8, F_FOLD = 16, F_CSCALE = 32 };
struct StaticOrder {
  int nM, nN, nwg, G, c, wgm;
  __device__ void init(int nM_, int nN_, int G_, int c_, int wgm_) { nM = nM_; nN = nN_; nwg = nM * nN; G = G_; c = c_; wgm = wgm_; }
  __device__ bool next(int i, Unit& u) const {
    const long L = (long)i * G + c; if (L >= nwg) return false;
    int wgid = (int)L; { const int q = nwg / NXCD, r = nwg % NXCD, xcd = wgid % NXCD, off = wgid / NXCD; wgid = (xcd < r ? xcd * (q + 1) : r * (q + 1) + (xcd - r) * q) + off; }
    const int nig = wgm * nN, gid = wgid / nig, fm = gid * wgm, gsz = (nM - fm) < wgm ? (nM - fm) : wgm;
    u.pm = fm + ((wgid % nig) % gsz); u.pn = (wgid % nig) / gsz; return true;
  }
};

__device__ __forceinline__ f32x2 row_stats(const f32x2* stats, const float* accIn, int row) {
  if (accIn) { const f32x2 a = *(const f32x2*)(accIn + 2 * (size_t)row); const float mean = a.x * (1.0f / DM); return (f32x2){mean, rsqrtf(fmaxf(a.y * (1.0f / DM) - mean * mean, 0.f) + LN_EPS)}; }
  return stats ? stats[row] : (f32x2){0.f, 1.f};
}
__device__ __forceinline__ void row_emit(float* accOut, int row, float s, float q, int lane, int fq) {
  s += __int_as_float(__builtin_amdgcn_ds_bpermute((lane ^ 16) << 2, __float_as_int(s))); q += __int_as_float(__builtin_amdgcn_ds_bpermute((lane ^ 16) << 2, __float_as_int(q)));
  s += __int_as_float(__builtin_amdgcn_ds_bpermute((lane ^ 32) << 2, __float_as_int(s))); q += __int_as_float(__builtin_amdgcn_ds_bpermute((lane ^ 32) << 2, __float_as_int(q)));
  if (fq == 0) { __hip_atomic_fetch_add(accOut + 2 * (size_t)row, s, __ATOMIC_RELAXED, __HIP_MEMORY_SCOPE_AGENT); __hip_atomic_fetch_add(accOut + 2 * (size_t)row + 1, q, __ATOMIC_RELAXED, __HIP_MEMORY_SCOPE_AGENT); }
}
__device__ __forceinline__ void gemm_epilogue(const GemmDesc& g, const f32x4 (&acc)[2][2][4][2], const Unit& u, int wr, int wc, int fr, int fq, int lane) {
  const int row0 = u.pm * BM + wr * 64 + fr;
  KargP pp = (KargP)__builtin_amdgcn_kernarg_segment_ptr(); asm volatile("" : "+s"(pp));
  unsigned char* const ws_ = pp->ws;
  const float* e_lng = nullptr; const float* e_lnb = nullptr;
  if (g.lnsel == 1) { e_lng = pp->ln1g + g.layer * DM; e_lnb = pp->ln1b + g.layer * DM; } else if (g.lnsel == 2) { e_lng = pp->ln2g + (g.layer - 1) * DM; e_lnb = pp->ln2b + (g.layer - 1) * DM; }
  const f32x2* const e_stats = (g.flags & F_LN_STATS) ? (const f32x2*)(ws_ + WS_ST) : nullptr;
  const float* const e_accIn = (g.flags & F_LN_ACC) ? (const float*)(ws_ + WS_ACC) : nullptr;
  float* const e_accOut = (g.flags & F_EMIT) ? (float*)(ws_ + WS_ACC) : nullptr; bf16_t* const e_xbOut = (bf16_t*)(ws_ + WS_XB);
  const float* const e_cg = (g.flags & F_FOLD) ? (const float*)(ws_ + WS_CG) : nullptr; const float* const e_cb = (const float*)(ws_ + WS_CG) + DFF;
  const float* const e_cscale = (g.flags & F_CSCALE) ? pp->pool_scale : nullptr;
  const float* const e_xin0 = (g.flags & F_XIN) ? pp->xp : nullptr; const float* const e_xin1 = pp->xs;
  if (g.mode <= 2) {
    bf16_t* O = (bf16_t*)g.out; const int col0 = u.pn * BM + wc * 32 + 8 * fq;
    const bool fold = (g.mode == 1) && (e_cg != nullptr);
    f32x4 fg[2][2], fb[2][2]; f32x2 fst[8];
    if (fold) {
#pragma unroll
      for (int bj = 0; bj < 2; ++bj)
#pragma unroll
        for (int n = 0; n < 2; ++n) { fg[bj][n] = *(const f32x4*)(e_cg + col0 + bj * HALF + 4 * n); fb[bj][n] = *(const f32x4*)(e_cb + col0 + bj * HALF + 4 * n); }
#pragma unroll
      for (int gi = 0; gi < 8; ++gi) fst[gi] = *(const f32x2*)(e_accIn + 2 * (size_t)(row0 + (gi >> 2) * HALF + (gi & 3) * 16));
#pragma unroll
      for (int gi = 0; gi < 8; ++gi) { const float mean = fst[gi].x * (1.0f / DM); fst[gi] = (f32x2){mean, rsqrtf(fmaxf(fst[gi].y * (1.0f / DM) - mean * mean, 0.f) + LN_EPS)}; }
    }
#pragma unroll
    for (int ai = 0; ai < 2; ++ai)
#pragma unroll
      for (int m = 0; m < 4; ++m) { bf16_t* rowp = O + (size_t)(row0 + ai * HALF + m * 16) * g.ldc + col0;
#pragma unroll
        for (int bj = 0; bj < 2; ++bj) { f32x4 v0 = acc[ai][bj][m][0], v1 = acc[ai][bj][m][1];
          if (g.mode == 1) {
            if (fold) { const f32x2 st = fst[ai * 4 + m]; v0 = (v0 - fg[bj][0] * st.x) * st.y + fb[bj][0]; v1 = (v1 - fg[bj][1] * st.x) * st.y + fb[bj][1]; }
#pragma unroll
            for (int j = 0; j < 4; ++j) { const float a = fmaxf(v0[j], 0.f), b = fmaxf(v1[j], 0.f); v0[j] = a * a; v1[j] = b * b; } }
          if (g.mode == 2) {
#pragma unroll
            for (int j = 0; j < 4; ++j) { v0[j] = gelu_tanh(v0[j]); v1[j] = gelu_tanh(v1[j]); } }
          u32x4 w; w.x = cvt_pk_bf16(v0[0], v0[1]); w.y = cvt_pk_bf16(v0[2], v0[3]); w.z = cvt_pk_bf16(v1[0], v1[1]); w.w = cvt_pk_bf16(v1[2], v1[3]);
          *(u32x4*)(rowp + bj * HALF) = w; } }
  } else if (g.mode == 3 || g.mode == 4) {
    float* X = (float*)g.out; const int col0 = u.pn * BM + wc * 32 + 4 * fq; const bool ln = e_stats != nullptr || e_accIn != nullptr;
    f32x4 cs[2][2], lg[2][2], lb[2][2];
#pragma unroll
    for (int bj = 0; bj < 2; ++bj)
#pragma unroll
      for (int n = 0; n < 2; ++n) { cs[bj][n] = (g.mode == 4) ? *(const f32x4*)(e_cscale + col0 + bj * HALF + n * 16) : (f32x4){1.f, 1.f, 1.f, 1.f};
        lg[bj][n] = ln ? *(const f32x4*)(e_lng + col0 + bj * HALF + n * 16) : (f32x4){1.f, 1.f, 1.f, 1.f}; lb[bj][n] = ln ? *(const f32x4*)(e_lnb + col0 + bj * HALF + n * 16) : (f32x4){0.f, 0.f, 0.f, 0.f}; }
    f32x2 st[2]; f32x4 xv[2][4];
    const f32x2* const e_sp = e_accIn ? (const f32x2*)e_accIn : (e_stats ? e_stats : (const f32x2*)(ws_ + WS_ONE));
#define RES_LOAD(GI, BUF) do { const int r_ = row0 + ((GI) >> 2) * HALF + ((GI) & 3) * 16; const float* rp_ = X + (size_t)r_ * DM + col0; \
      st[BUF] = e_sp[r_]; \
      _Pragma("unroll") for (int q_ = 0; q_ < 4; ++q_) xv[BUF][q_] = *(const f32x4*)(rp_ + (q_ >> 1) * HALF + (q_ & 1) * 16); } while (0)
    RES_LOAD(0, 0);
#pragma unroll
    for (int gi = 0; gi < 8; ++gi) { const int ai = gi >> 2, m = gi & 3; const int row = row0 + ai * HALF + m * 16; float* rowp = X + (size_t)row * DM + col0;
      if (gi + 1 < 8) RES_LOAD(gi + 1, (gi + 1) & 1);
      float ssum = 0.f, ssq = 0.f; f32x2 sm = st[gi & 1];
      if (e_accIn) { const float mean = sm.x * (1.0f / DM); sm = (f32x2){mean, rsqrtf(fmaxf(sm.y * (1.0f / DM) - mean * mean, 0.f) + LN_EPS)}; }
#pragma unroll
      for (int bj = 0; bj < 2; ++bj)
#pragma unroll
        for (int n = 0; n < 2; ++n) { f32x4* p = (f32x4*)(rowp + bj * HALF + n * 16); const f32x4 x = ((xv[gi & 1][bj * 2 + n] - sm.x) * sm.y) * lg[bj][n] + lb[bj][n]; const f32x4 o = x * ALPHA + acc[ai][bj][m][n] * cs[bj][n]; *p = o;
          if (e_accOut) { ssum += (o[0] + o[1]) + (o[2] + o[3]); ssq += (o[0] * o[0] + o[1] * o[1]) + (o[2] * o[2] + o[3] * o[3]);
            u32x2 w; w.x = cvt_pk_bf16(o[0], o[1]); w.y = cvt_pk_bf16(o[2], o[3]); *(u32x2*)(e_xbOut + (size_t)row * DM + col0 + bj * HALF + n * 16) = w; } }
      if (e_accOut) row_emit(e_accOut, row, ssum, ssq, lane, fq); }
#undef RES_LOAD
  } else if (g.mode == 5) {
    float* X = (float*)g.out; const int col0 = u.pn * HALF + wc * 32 + 4 * fq; const bool ln = e_stats != nullptr;
    f32x4 lg[2], lb[2];
#pragma unroll
    for (int n = 0; n < 2; ++n) { lg[n] = ln ? *(const f32x4*)(e_lng + col0 + n * 16) : (f32x4){1.f, 1.f, 1.f, 1.f}; lb[n] = ln ? *(const f32x4*)(e_lnb + col0 + n * 16) : (f32x4){0.f, 0.f, 0.f, 0.f}; }
    f32x2 st[2][2]; f32x4 xv[2][4];
    const f32x2* const e_sp = e_stats ? e_stats : (const f32x2*)(ws_ + WS_ONE);
#define GLU_SRC(ROW) (e_xin0 ? (((ROW) < 2 * SEQ) ? e_xin0 + (size_t)(ROW) * DM + col0 : e_xin1 + (size_t)((ROW) - 2 * SEQ) * DM + col0) : X + (size_t)(ROW) * DM + col0)
#define GLU_LOAD(PI, BUF) do { _Pragma("unroll") for (int h_ = 0; h_ < 2; ++h_) { const int g_ = 2 * (PI) + h_; const int r_ = row0 + (g_ >> 2) * HALF + (g_ & 3) * 16; const float* sp_ = GLU_SRC(r_); \
      st[BUF][h_] = e_sp[r_]; xv[BUF][2 * h_] = *(const f32x4*)(sp_); xv[BUF][2 * h_ + 1] = *(const f32x4*)(sp_ + 16); } } while (0)
    GLU_LOAD(0, 0);
#pragma unroll
    for (int pi = 0; pi < 4; ++pi) {
      if (pi + 1 < 4) GLU_LOAD(pi + 1, (pi + 1) & 1);
#pragma unroll
      for (int h2 = 0; h2 < 2; ++h2) { const int gi = 2 * pi + h2, ai = gi >> 2, m = gi & 3; const int row = row0 + ai * HALF + m * 16; float* rowp = X + (size_t)row * DM + col0; float ssum = 0.f, ssq = 0.f;
#pragma unroll
        for (int n = 0; n < 2; ++n) { f32x4* p = (f32x4*)(rowp + n * 16); const f32x4 x = ((xv[pi & 1][2 * h2 + n] - st[pi & 1][h2].x) * st[pi & 1][h2].y) * lg[n] + lb[n]; const f32x4 o = acc[ai][0][m][n], gt = acc[ai][1][m][n]; f32x4 h;
#pragma unroll
          for (int j = 0; j < 4; ++j) h[j] = o[j] * sigmoidf_(gt[j]);
          const f32x4 z = x * ALPHA + h; *p = z;
          if (e_accOut) { ssum += (z[0] + z[1]) + (z[2] + z[3]); ssq += (z[0] * z[0] + z[1] * z[1]) + (z[2] * z[2] + z[3] * z[3]);
            u32x2 w; w.x = cvt_pk_bf16(z[0], z[1]); w.y = cvt_pk_bf16(z[2], z[3]); *(u32x2*)(e_xbOut + (size_t)row * DM + col0 + n * 16) = w; } }
        if (e_accOut) row_emit(e_accOut, row, ssum, ssq, lane, fq); } }
#undef GLU_LOAD
#undef GLU_SRC
  } else if (g.mode == 7) {
    if (acc[0][0][0][0][0] == 1.2345e30f) *(f32x4*)g.out = acc[1][1][3][1];
  } else {
    float* C = (float*)g.out; const int col0 = u.pn * BM + wc * 32 + 4 * fq;
#pragma unroll
    for (int ai = 0; ai < 2; ++ai)
#pragma unroll
      for (int m = 0; m < 4; ++m) { float* rowp = C + (size_t)(row0 + ai * HALF + m * 16) * g.ldc + col0;
#pragma unroll
        for (int bj = 0; bj < 2; ++bj)
#pragma unroll
          for (int n = 0; n < 2; ++n) *(f32x4*)(rowp + bj * HALF + n * 16) = acc[ai][bj][m][n]; }
  }
}

__device__ __forceinline__ const char* ktile_ptr(const char* b1, const char* b2, int kt, int ksplit, size_t kstep) { return kt < ksplit ? b1 + (size_t)kt * kstep : b2 + (size_t)(kt - ksplit) * kstep; }

__device__ __forceinline__ void gemm_phase(const Ctx& cx, LAS unsigned char* lds, const GemmDesc& g) {
  const int tid = cx.tid_(), wid = __builtin_amdgcn_readfirstlane(tid >> 6), lane = tid & 63, wr = wid >> 2, wc = wid & 3, fr = lane & 15, fq = lane >> 4;
  const int nt = g.nt, ksplit = g.ksplit; const bool perm = g.mode <= 2;
  unsigned voffA[2], voffB[2];
#pragma unroll
  for (int i = 0; i < 2; ++i) { int R, C; stage_rc(tid * 16 + i * 8192, R, C); const int Rb = perm ? ((R & ~31) + perm32(R & 31)) : R;
    voffA[i] = g.chunked ? (unsigned)((R >> 4) * 65536 + (R & 15) * 32 + (C >> 4) * 512 + (C & 15) * 2) : ((unsigned)R * g.rowStrideA + (unsigned)(C * 2)); voffB[i] = (unsigned)Rb * g.ldbBytes + (unsigned)(C * 2); }
  const size_t kstepA = g.chunked ? 2048 : 128, kstepB = 128;
  const size_t hstepA = (size_t)HALF * g.rowStrideA, hstepB = (size_t)HALF * g.ldbBytes, tstepA = 2 * hstepA, tstepB = 2 * hstepB;
  const unsigned ldsw = (unsigned)wid * 1024u;
  const int aoff = lds_byte(wr * 64 + fr, fq * 8), boff = lds_byte(wc * 32 + fr, fq * 8);
#define PG8_SA(b, h) (((b) * 2 + (h)) * HTB)
#define PG8_SB(b, h) ((4 + (b) * 2 + (h)) * HTB)
#define PG8_STAGE(bufoff, gbase, voff) do { _Pragma("unroll") for (int _i = 0; _i < 2; ++_i) \
    __builtin_amdgcn_global_load_lds((const unsigned*)((const char*)(gbase) + (voff)[_i]), (LAS unsigned*)(lds + (bufoff) + ldsw + _i * 8192), 16, 0, 0); } while (0)
#define PG8_LDA(dst, b, h) do { _Pragma("unroll") for (int m = 0; m < 4; ++m) _Pragma("unroll") for (int k = 0; k < 2; ++k) dst[m][k] = *(const LAS bf16x8*)(lds + PG8_SA(b, h) + aoff + m * 2048 + k * 1024); } while (0)
#define PG8_LDB(dst, b, h) do { _Pragma("unroll") for (int n = 0; n < 2; ++n) _Pragma("unroll") for (int k = 0; k < 2; ++k) dst[n][k] = *(const LAS bf16x8*)(lds + PG8_SB(b, h) + boff + n * 2048 + k * 1024); } while (0)
#define PG8_MMA(ai, bj, At, Bt) do { __builtin_amdgcn_s_setprio(1); _Pragma("unroll") for (int m = 0; m < 4; ++m) _Pragma("unroll") for (int n = 0; n < 2; ++n) _Pragma("unroll") for (int k = 0; k < 2; ++k) \
    acc[ai][bj][m][n] = __builtin_amdgcn_mfma_f32_16x16x32_bf16(Bt[n][k], At[m][k], acc[ai][bj][m][n], 0, 0, 0); __builtin_amdgcn_s_setprio(0); } while (0)
#define PG8_WAIT_V(n) asm volatile("s_waitcnt vmcnt(" #n ")" ::: "memory")
#define PG8_WAIT_L(n) asm volatile("s_waitcnt lgkmcnt(" #n ")" ::: "memory")
#define PG8_BAR __builtin_amdgcn_s_barrier()
#define PG8_SCHED __builtin_amdgcn_sched_barrier(0)
  StaticOrder S; S.init(g.nM, g.nN, (int)cx.G, (int)cx.bid, g.wgm);
  Unit cur, nxt; int ui = 0;
  if (!S.next(0, cur)) return;
  f32x4 acc[2][2][4][2];
#pragma unroll
  for (int a = 0; a < 2; ++a)
#pragma unroll
    for (int b = 0; b < 2; ++b)
#pragma unroll
      for (int m = 0; m < 4; ++m)
#pragma unroll
        for (int n = 0; n < 2; ++n) acc[a][b][m][n] = (f32x4){0.f, 0.f, 0.f, 0.f};
  bf16x8 At[4][2], B0[2][2], B1[2][2];
  size_t aoffu = (size_t)cur.pm * tstepA + (size_t)(cur.pn >> g.pnShift) * g.pnStrideA;
  const char* cA1 = g.A + aoffu; const char* cA2 = g.A2 + aoffu; const char* cB = g.Bt + (size_t)cur.pn * tstepB;
  {
    const char* a0 = ktile_ptr(cA1, cA2, 0, ksplit, kstepA); const char* a1 = ktile_ptr(cA1, cA2, 1, ksplit, kstepA);
    PG8_STAGE(PG8_SB(0, 0), cB, voffB); PG8_STAGE(PG8_SB(0, 1), cB + hstepB, voffB); PG8_STAGE(PG8_SA(0, 0), a0, voffA); PG8_STAGE(PG8_SA(0, 1), a0 + hstepA, voffA);
    if (wr == 1) PG8_BAR;
    PG8_WAIT_V(2); PG8_BAR;
    PG8_STAGE(PG8_SB(1, 0), cB + kstepB, voffB); PG8_STAGE(PG8_SA(1, 0), a1, voffA); PG8_STAGE(PG8_SB(1, 1), cB + hstepB + kstepB, voffB);
    PG8_WAIT_V(6); PG8_BAR;
  }
  for (;;) {
    const bool has_next = S.next(ui + 1, nxt);
    const size_t naoff = has_next ? (size_t)nxt.pm * tstepA + (size_t)(nxt.pn >> g.pnShift) * g.pnStrideA : aoffu;
    const char* nA1 = g.A + naoff; const char* nA2 = g.A2 + naoff; const char* nB = has_next ? g.Bt + (size_t)nxt.pn * tstepB : cB;
    for (int t = 0; t < nt; t += 2) {
      const bool last = (t == nt - 2);
      const char* a1 = ktile_ptr(cA1, cA2, t + 1, ksplit, kstepA);
      const char* a2 = last ? ktile_ptr(nA1, nA2, 0, ksplit, kstepA) : ktile_ptr(cA1, cA2, t + 2, ksplit, kstepA);
      const char* a3 = last ? ktile_ptr(nA1, nA2, 1, ksplit, kstepA) : ktile_ptr(cA1, cA2, t + 3, ksplit, kstepA);
      const char* b2 = last ? nB : cB + (size_t)(t + 2) * kstepB; const char* b3 = b2 + kstepB;
      PG8_LDB(B0, 0, 0); PG8_LDB(B1, 0, 1); PG8_SCHED; PG8_LDA(At, 0, 0); PG8_STAGE(PG8_SA(1, 1), a1 + hstepA, voffA);
      PG8_WAIT_V(8); PG8_WAIT_L(0); PG8_BAR; PG8_MMA(0, 0, At, B0); PG8_MMA(0, 1, At, B1); PG8_BAR; PG8_SCHED;
      PG8_LDA(At, 0, 1); PG8_STAGE(PG8_SB(0, 0), b2, voffB); PG8_STAGE(PG8_SB(0, 1), b2 + hstepB, voffB); PG8_STAGE(PG8_SA(0, 0), a2, voffA);
      PG8_WAIT_V(8); PG8_WAIT_L(0); PG8_BAR; PG8_MMA(1, 0, At, B0); PG8_MMA(1, 1, At, B1); PG8_BAR; PG8_SCHED;
      PG8_LDB(B0, 1, 0); PG8_LDB(B1, 1, 1); PG8_SCHED; PG8_LDA(At, 1, 0); PG8_STAGE(PG8_SA(0, 1), a2 + hstepA, voffA);
      PG8_WAIT_V(8); PG8_WAIT_L(0); PG8_BAR; PG8_MMA(0, 0, At, B0); PG8_MMA(0, 1, At, B1); PG8_BAR; PG8_SCHED;
      PG8_LDA(At, 1, 1); PG8_STAGE(PG8_SB(1, 0), b3, voffB); PG8_STAGE(PG8_SB(1, 1), b3 + hstepB, voffB); PG8_STAGE(PG8_SA(1, 0), a3, voffA);
      PG8_WAIT_V(8); PG8_WAIT_L(0); PG8_BAR; PG8_MMA(1, 0, At, B0); PG8_MMA(1, 1, At, B1); PG8_BAR; PG8_SCHED;
    }
    if (wr == 0) PG8_BAR;
    gemm_epilogue(g, acc, cur, wr, wc, fr, fq, lane);
    if (!has_next) break;
#pragma unroll
    for (int a = 0; a < 2; ++a)
#pragma unroll
      for (int b = 0; b < 2; ++b)
#pragma unroll
        for (int m = 0; m < 4; ++m)
#pragma unroll
          for (int n = 0; n < 2; ++n) acc[a][b][m][n] = (f32x4){0.f, 0.f, 0.f, 0.f};
    cur = nxt; cA1 = nA1; cA2 = nA2; cB = nB; aoffu = naoff; ++ui;
    if (wr == 1) PG8_BAR;
  }
  PG8_WAIT_V(0);
  PG8_BAR;
#undef PG8_SA
#undef PG8_SB
#undef PG8_STAGE
#undef PG8_LDA
#undef PG8_LDB
#undef PG8_MMA
#undef PG8_WAIT_V
#undef PG8_WAIT_L
#undef PG8_BAR
#undef PG8_SCHED
}
}

namespace att {
constexpr int D = 128, NW = 8, QBLK = 32, KVBLK = 64;
constexpr float SCALE = 0.088388347648318440f, THR = 8.f;
constexpr int LDQ = QKVD, LDK = QKVD, LDO = DM;
constexpr size_t SHM_V = KVBLK * D * 2, SHM_K = KVBLK * D * 2, SHM_ATTN = 2 * SHM_V + 2 * SHM_K + NW * 64 * 4;
#define KSWZ(row, colB) ((row) * 256 + ((colB) ^ (((row) & 7) << 4)))
#define SBAR() __builtin_amdgcn_sched_barrier(0)
__device__ __forceinline__ int crow(int r, int hi) { return (r & 3) + 8 * (r >> 2) + 4 * hi; }
__device__ __forceinline__ bf16x8 ld8(const bf16_t* p) { return *reinterpret_cast<const bf16x8*>(p); }
__device__ __forceinline__ void partialSM(f32x16& p0, f32x16& p1, float& m_reg, float& mn, float& alpha) {
  constexpr float C = SCALE * 1.4426950408889634f;
  float pmax = p0[0];
#pragma unroll
  for (int r = 1; r < 16; ++r) pmax = fmaxf(pmax, p0[r]);
#pragma unroll
  for (int r = 0; r < 16; ++r) pmax = fmaxf(pmax, p1[r]);
  { auto rr = __builtin_amdgcn_permlane32_swap(__float_as_uint(pmax), __float_as_uint(pmax), false, false);
    pmax = fmaxf(__uint_as_float(rr[0]), __uint_as_float(rr[1])); }
  if (__builtin_expect(__all(pmax - m_reg <= THR / SCALE), 1)) { mn = m_reg; alpha = 1.f; }
  else { mn = fmaxf(m_reg, pmax); alpha = __builtin_amdgcn_exp2f((m_reg - mn) * C); m_reg = mn; }
  float mnC = -mn * C;
#pragma unroll
  for (int r = 0; r < 16; ++r) p0[r] = fmaf(p0[r], C, mnC);
#pragma unroll
  for (int r = 0; r < 16; ++r) p1[r] = fmaf(p1[r], C, mnC);
#pragma unroll
  for (int r = 0; r < 16; ++r) p0[r] = __builtin_amdgcn_exp2f(p0[r]);
}
__device__ __forceinline__ void finishSM(f32x16& p0, f32x16& p1, float alpha, float& l_reg, bf16x8& pa0, bf16x8& pa1, bf16x8& pa2, bf16x8& pa3) {
#pragma unroll
  for (int r = 0; r < 16; ++r) p1[r] = __builtin_amdgcn_exp2f(p1[r]);
  float ps = 0;
#pragma unroll
  for (int r = 0; r < 16; ++r) ps += p0[r];
#pragma unroll
  for (int r = 0; r < 16; ++r) ps += p1[r];
  { auto rr = __builtin_amdgcn_permlane32_swap(__float_as_uint(ps), __float_as_uint(ps), false, false);
    ps = __uint_as_float(rr[0]) + __uint_as_float(rr[1]); }
  l_reg = l_reg * alpha + ps;
#define PK4(P, BASE, OUT) do { unsigned a0 = cvt_pk_bf16(P[BASE + 0], P[BASE + 1]), a1 = cvt_pk_bf16(P[BASE + 2], P[BASE + 3]);   \
    unsigned b0 = cvt_pk_bf16(P[BASE + 4], P[BASE + 5]), b1 = cvt_pk_bf16(P[BASE + 6], P[BASE + 7]);                              \
    auto r0 = __builtin_amdgcn_permlane32_swap(a0, b0, false, false); auto r1 = __builtin_amdgcn_permlane32_swap(a1, b1, false, false); \
    u32x4 w = {r0[0], r1[0], r0[1], r1[1]}; OUT = *reinterpret_cast<bf16x8*>(&w); } while (0)
  PK4(p0, 0, pa0); PK4(p0, 8, pa1); PK4(p1, 0, pa2); PK4(p1, 8, pa3);
#undef PK4
}
__device__ __forceinline__ void qkt(f32x16& p0, f32x16& p1, const bf16_t* Ks, const bf16x8* qr, int r32, int hi) {
  p0 = f32x16{}; p1 = f32x16{};
#pragma unroll
  for (int d0 = 0; d0 < 8; ++d0) { int cb = (d0 * 16 + hi * 8) * 2;
    bf16x8 b0 = *reinterpret_cast<const bf16x8*>((const char*)Ks + KSWZ(r32, cb));
    bf16x8 b1 = *reinterpret_cast<const bf16x8*>((const char*)Ks + KSWZ(32 + r32, cb));
    p0 = __builtin_amdgcn_mfma_f32_32x32x16_bf16(b0, qr[d0], p0, 0, 0, 0);
    p1 = __builtin_amdgcn_mfma_f32_32x32x16_bf16(b1, qr[d0], p1, 0, 0, 0); }
}
__device__ __forceinline__ int v_st(int k, int c) { const int kk = (k & ~0xC) | ((k & 4) << 1) | ((k & 8) >> 1); return ((kk >> 3) * 4 + (c >> 5)) * 512 + ((kk & 7) * 32 + (c & 31)) * 2; }
__device__ __forceinline__ int v_rd_base(int lane) { return ((lane & 3) << 3) | (((lane >> 2) & 3) << 6) | (((lane >> 4) & 1) << 5) | (((lane >> 5) & 1) << 8); }
constexpr int v_rd_off(int d0, int ks, int half) { return d0 * 512 + ks * 4096 + half * 2048; }
template <int OFF> __device__ __forceinline__ s16x4 tr_read(int vb) {
  s16x4 r; asm volatile("ds_read_b64_tr_b16 %0, %1 offset:%2" : "=&v"(r) : "v"(vb), "i"(OFF) : "memory"); return r;
}
template <int D0> __device__ __forceinline__ void pv_one(f32x16& od, int vb, bf16x8 pa0, bf16x8 pa1, bf16x8 pa2, bf16x8 pa3) {
  const s16x4 l0 = tr_read<v_rd_off(D0, 0, 0)>(vb), h0 = tr_read<v_rd_off(D0, 0, 1)>(vb), l1 = tr_read<v_rd_off(D0, 1, 0)>(vb), h1 = tr_read<v_rd_off(D0, 1, 1)>(vb);
  const s16x4 l2 = tr_read<v_rd_off(D0, 2, 0)>(vb), h2 = tr_read<v_rd_off(D0, 2, 1)>(vb), l3 = tr_read<v_rd_off(D0, 3, 0)>(vb), h3 = tr_read<v_rd_off(D0, 3, 1)>(vb);
  asm volatile("s_waitcnt lgkmcnt(0)" ::: "memory"); SBAR();
#define PK(L, H) (bf16x8){L[0], L[1], L[2], L[3], H[0], H[1], H[2], H[3]}
  od = __builtin_amdgcn_mfma_f32_32x32x16_bf16(pa0, PK(l0, h0), od, 0, 0, 0);
  od = __builtin_amdgcn_mfma_f32_32x32x16_bf16(pa1, PK(l1, h1), od, 0, 0, 0);
  od = __builtin_amdgcn_mfma_f32_32x32x16_bf16(pa2, PK(l2, h2), od, 0, 0, 0);
  od = __builtin_amdgcn_mfma_f32_32x32x16_bf16(pa3, PK(l3, h3), od, 0, 0, 0);
#undef PK
}
__device__ __forceinline__ void pv_d0(f32x16* o, int vb, bf16x8 pa0, bf16x8 pa1, bf16x8 pa2, bf16x8 pa3) {
  pv_one<0>(o[0], vb, pa0, pa1, pa2, pa3); pv_one<1>(o[1], vb, pa0, pa1, pa2, pa3); pv_one<2>(o[2], vb, pa0, pa1, pa2, pa3); pv_one<3>(o[3], vb, pa0, pa1, pa2, pa3);
}
__device__ __forceinline__ void attn_dense_body(const bf16_t* __restrict__ Qb, const bf16_t* __restrict__ Kh, const bf16_t* __restrict__ Vh,
                                                bf16_t* __restrict__ Ob, int seq, char* lds, const Ctx& cx) {
  const int tid = cx.tid_(), wid = tid >> 6, lane = tid & 63, r32 = lane & 31, hi = lane >> 5;
  bf16_t* V_lds = (bf16_t*)lds; bf16_t* K_lds = (bf16_t*)(lds + 2 * SHM_V);
  float* ws = (float*)(lds + 2 * SHM_V + 2 * SHM_K) + wid * 64; float* li_l = ws; float* al_l = ws + 32;
  float m_reg = -1e30f, l_reg = 0; f32x16 o[4] = {}; bf16x8 qr[8];
  const bf16_t* Qw = Qb + (long)(wid * QBLK + r32) * LDQ + hi * 8;
#pragma unroll
  for (int d0 = 0; d0 < 8; ++d0) qr[d0] = ld8(Qw + d0 * 16);
  const int sr = tid >> 4, sc = (tid & 15) * 8, vst0 = v_st(sr, sc), vst1 = v_st(32 + sr, sc);
  const int vb0 = (int)(uintptr_t)V_lds + v_rd_base(lane);
  struct { bf16x8 vs0, vs1, ks0, ks1; } sr_[2];
#define SLOAD(i, k0) do { sr_[i].vs0 = ld8(&Vh[(long)((k0) + sr) * LDK + sc]); sr_[i].vs1 = ld8(&Vh[(long)((k0) + 32 + sr) * LDK + sc]); \
    sr_[i].ks0 = ld8(&Kh[(long)((k0) + sr) * LDK + sc]); sr_[i].ks1 = ld8(&Kh[(long)((k0) + 32 + sr) * LDK + sc]); } while (0)
#define SWRITE(b, i) do { *(bf16x8*)((char*)V_lds + (b) * SHM_V + vst0) = sr_[i].vs0;          \
    *(bf16x8*)((char*)V_lds + (b) * SHM_V + vst1) = sr_[i].vs1; int kc = sc * 2;               \
    *(bf16x8*)((char*)K_lds + (b) * SHM_K + KSWZ(sr, kc)) = sr_[i].ks0;                       \
    *(bf16x8*)((char*)K_lds + (b) * SHM_K + KSWZ(32 + sr, kc)) = sr_[i].ks1; } while (0)
#define SWAIT() asm volatile("s_waitcnt vmcnt(4)" ::: "memory")
#define RESC(a) do { if (__any((a) < 1.f)) { if (hi == 0) al_l[r32] = (a); asm volatile("s_waitcnt lgkmcnt(0)" ::: "memory"); \
    _Pragma("unroll") for (int d = 0; d < 4; ++d) _Pragma("unroll") for (int r = 0; r < 16; ++r) o[d][r] *= al_l[crow(r, hi)]; } } while (0)
  f32x16 pA0, pA1, pB0, pB1; float mnA, mnB, alA, alB; bf16x8 pa0, pa1, pa2, pa3; const int NT = seq / KVBLK;
  constexpr int SE = 0, SO = 1;
  SLOAD(SE, 0); asm volatile("s_waitcnt vmcnt(0)" ::: "memory"); SWRITE(0, SE); __syncthreads();
  qkt(pA0, pA1, K_lds, qr, r32, hi); partialSM(pA0, pA1, m_reg, mnA, alA);
  SLOAD(SO, KVBLK); if (2 < NT) SLOAD(SE, 2 * KVBLK);
  SWAIT(); SWRITE(1, SO); __syncthreads();
  for (int j = 1; j + 1 < NT; j += 2) {
    SBAR(); qkt(pB0, pB1, (bf16_t*)((char*)K_lds + SHM_K), qr, r32, hi);
    finishSM(pA0, pA1, alA, l_reg, pa0, pa1, pa2, pa3); SBAR();
    SLOAD(SO, (j + 2) * KVBLK); SBAR();
    pv_d0(o, vb0, pa0, pa1, pa2, pa3); partialSM(pB0, pB1, m_reg, mnB, alB);
    __syncthreads(); SWAIT(); SWRITE(0, SE);
    RESC(alB); __syncthreads();
    SBAR(); qkt(pA0, pA1, K_lds, qr, r32, hi);
    finishSM(pB0, pB1, alB, l_reg, pa0, pa1, pa2, pa3); SBAR();
    SLOAD(SE, min(j + 3, NT - 1) * KVBLK); SBAR();
    pv_d0(o, vb0 + (int)SHM_V, pa0, pa1, pa2, pa3); partialSM(pA0, pA1, m_reg, mnA, alA);
    __syncthreads(); SWAIT(); SWRITE(1, SO);
    RESC(alA); __syncthreads();
  }
  SBAR(); qkt(pB0, pB1, (bf16_t*)((char*)K_lds + SHM_K), qr, r32, hi);
  finishSM(pA0, pA1, alA, l_reg, pa0, pa1, pa2, pa3); SBAR();
  pv_d0(o, vb0, pa0, pa1, pa2, pa3); partialSM(pB0, pB1, m_reg, mnB, alB);
  __syncthreads(); RESC(alB);
  finishSM(pB0, pB1, alB, l_reg, pa0, pa1, pa2, pa3); SBAR();
  pv_d0(o, vb0 + (int)SHM_V, pa0, pa1, pa2, pa3);
  if (hi == 0) li_l[r32] = l_reg; asm volatile("s_waitcnt lgkmcnt(0)" ::: "memory");
  float rli[16];
#pragma unroll
  for (int r = 0; r < 16; ++r) rli[r] = __builtin_amdgcn_rcpf(li_l[crow(r, hi)]);
  bf16_t* Ow = Ob + (long)(wid * QBLK) * LDO;
#pragma unroll
  for (int r = 0; r < 16; ++r) { int orow = crow(r, hi);
#pragma unroll
    for (int d0 = 0; d0 < 4; ++d0) Ow[(long)orow * LDO + d0 * 32 + r32] = (bf16_t)(cvt_pk_bf16(o[d0][r] * rli[r], 0.f) & 0xffffu); }
#undef SLOAD
#undef SWRITE
#undef SWAIT
#undef RESC
}
}

__device__ __forceinline__ void phase_pre(const Ctx& cx, const Params& p) {
  const size_t gt = (size_t)cx.bid * 512 + cx.tid_(), nth = (size_t)cx.G * 512;
  const size_t n1 = (size_t)2 * SEQ * DM / 4, ntot = (size_t)MTOK * DM / 4;
  f32x4* X4 = (f32x4*)p.X; u32x2* XB2 = (u32x2*)(p.ws + WS_XB);
  for (size_t i = gt; i < ntot; i += 4 * nth) {
    f32x4 v[4];
#pragma unroll
    for (int e = 0; e < 4; ++e) { const size_t ii = i + e * nth; v[e] = (ii < ntot) ? ((ii < n1) ? ((const f32x4*)p.xp)[ii] : ((const f32x4*)p.xs)[ii - n1]) : (f32x4){0.f, 0.f, 0.f, 0.f}; }
#pragma unroll
    for (int e = 0; e < 4; ++e) { const size_t ii = i + e * nth; if (ii < ntot) { u32x2 w; w.x = cvt_pk_bf16(v[e][0], v[e][1]); w.y = cvt_pk_bf16(v[e][2], v[e][3]);
        const size_t tok = ii >> 9; const unsigned ch = (unsigned)(ii & 511) * 4u; XB2[((tok >> 4) * 32768 + (ch >> 4) * 256 + (tok & 15) * 16 + (ch & 15)) >> 2] = w; } }
  }
  for (size_t i = gt; i < (size_t)MTOK * 2 + 2 * DFF; i += nth) { if (i < (size_t)MTOK * 2) ((float*)(p.ws + WS_ACC))[i] = 0.f; else ((float*)(p.ws + WS_CG))[i - (size_t)MTOK * 2] = 0.f; }
  { float z0, o1; asm volatile("v_mov_b32 %0, 0" : "=v"(z0)); asm volatile("v_mov_b32 %0, 1.0" : "=v"(o1)); for (size_t i = gt; i < (size_t)MTOK; i += nth) ((f32x2*)(p.ws + WS_ONE))[i] = (f32x2){z0, o1}; }
  if (gt < 32768) {
    const int idx = (int)gt;
    const float lr = fminf(p.a_re[idx], -1e-4f), li = p.a_im[idx], dt = expf(p.log_step[idx >> 6]);
    const float er = expf(lr * dt), ang = li * dt; const float lbr = er * cosf(ang), lbi = er * sinf(ang);
    const float nr = lbr - 1.f, ni = lbi, den = lr * lr + li * li; const float cr = (nr * lr + ni * li) / den, ci = (ni * lr - nr * li) / den;
    f32x2* T = (f32x2*)(p.ws + WS_PW) + (size_t)idx * 32;
    float pr = 1.f, pi = 0.f;
#pragma unroll
    for (int d = 0; d <= 16; ++d) {
      if (d >= 1) T[15 + d] = (f32x2){pr, pi};
      if (d < 16) T[d] = (f32x2){pr * cr - pi * ci, pr * ci + pi * cr};
      const float t0 = pr * lbr - pi * lbi, t1 = pr * lbi + pi * lbr; pr = t0; pi = t1;
    }
  } else if (gt < 32768 + 2048) {
    const int e = (int)gt - 32768, pos = e >> 5, f = e & 31;
    const float inv = exp2f(-(float)f * (13.287712379549449f / 32.0f)); const float ang = (float)pos * inv;
    ((f32x2*)(p.ws + WS_ROPE))[e] = (f32x2){cosf(ang), sinf(ang)};
  }
}

__device__ __forceinline__ void cvt_job(const Ctx& cx, float* T, const float* __restrict__ src, bf16_t* __restrict__ dst, int K, int N, int ld_dst, int mode,
                                        const float* rs = nullptr, const float* rb = nullptr, float* cgo = nullptr, float* cbo = nullptr) {
  const int tid = cx.tid_(), nK = K >> 6, cnt = nK * (N >> 8);
  float* RED = T + 64 * 257 + 16;
  for (int t = cx.bid; t < cnt; t += cx.G) {
    const int k0 = (t % nK) << 6, n0 = (t / nK) << 8;
    const int r = tid >> 6, c4 = (tid & 63) * 4;
    f32x4 v[8];
#pragma unroll
    for (int i = 0; i < 8; ++i) v[i] = *(const f32x4*)(src + (size_t)(k0 + r + 8 * i) * N + n0 + c4);
    if (rs) { f32x4 pg = {0.f, 0.f, 0.f, 0.f}, pb = {0.f, 0.f, 0.f, 0.f};
#pragma unroll
      for (int i = 0; i < 8; ++i) { const float gk = rs[k0 + r + 8 * i], bk = rb[k0 + r + 8 * i]; pb += v[i] * bk; v[i] *= gk; pg += v[i]; }
      float* rp = RED + r * 256 + c4; rp[0] = pg[0]; rp[1] = pg[1]; rp[2] = pg[2]; rp[3] = pg[3]; rp += 2048; rp[0] = pb[0]; rp[1] = pb[1]; rp[2] = pb[2]; rp[3] = pb[3]; }
#pragma unroll
    for (int i = 0; i < 8; ++i) { float* tp = T + (r + 8 * i) * 257 + c4; tp[0] = v[i][0]; tp[1] = v[i][1]; tp[2] = v[i][2]; tp[3] = v[i][3]; }
    __syncthreads();
    if (rs) { const int which = tid >> 8, n = tid & 255; float s = 0.f;
#pragma unroll
      for (int rr = 0; rr < 8; ++rr) s += RED[which * 2048 + rr * 256 + n];
      __hip_atomic_fetch_add((which ? cbo : cgo) + n0 + n, s, __ATOMIC_RELAXED, __HIP_MEMORY_SCOPE_AGENT); }
    const int n = tid >> 1, kh = (tid & 1) * 32;
    const int nn = n0 + n; const int row = (mode == 0) ? nn : (((nn >> 7) << 8) + (nn & 127) + (mode == 2 ? 128 : 0));
    bf16_t* dp = dst + (size_t)row * ld_dst + k0 + kh;
#pragma unroll
    for (int q = 0; q < 4; ++q) { float w[8];
#pragma unroll
      for (int jj = 0; jj < 8; ++jj) w[jj] = T[(kh + 8 * q + jj) * 257 + n];
      u32x4 o; o.x = cvt_pk_bf16(w[0], w[1]); o.y = cvt_pk_bf16(w[2], w[3]); o.z = cvt_pk_bf16(w[4], w[5]); o.w = cvt_pk_bf16(w[6], w[7]);
      *(u32x4*)(dp + 8 * q) = o; }
    __syncthreads();
  }
}

__device__ __forceinline__ void s5_prep_item(const Ctx& cx, float* L, const Params& p, int j, int g, int hf) {
  const int tid = cx.tid_();
  f32x2* Cc = (f32x2*)L;
  f32x2* Bb = Cc + 2048;
  f32x2* PWs = Bb + 2048;
  float* Kt = (float*)(PWs + 4096);
  { float cr[4], ci[4], br[4], bi[4]; f32x2 pw[8];
#pragma unroll
    for (int k = 0; k < 4; ++k) { const int e = tid + 512 * k, dir = e >> 10, r = e & 1023; const size_t base = ((size_t)(j * 2 + dir) * 128 + g) * 1024 + r;
      cr[k] = p.c_re[base]; ci[k] = p.c_im[base]; br[k] = p.b_re[base]; bi[k] = p.b_im[base]; }
#pragma unroll
    for (int k = 0; k < 8; ++k) { const int e = tid + 512 * k, dir = e >> 11, r = e & 2047; pw[k] = ((const f32x2*)(p.ws + WS_PW))[(((size_t)(j * 2 + dir) * 128 + g) * 64) * 32 + r]; }
#pragma unroll
    for (int k = 0; k < 4; ++k) { const int e = tid + 512 * k; Cc[e] = (f32x2){cr[k], ci[k]}; Bb[e] = (f32x2){br[k], bi[k]}; }
#pragma unroll
    for (int k = 0; k < 8; ++k) PWs[tid + 512 * k] = pw[k]; }
  __syncthreads();
  { const int dir = tid >> 8, d = (tid >> 4) & 15, pp = tid & 15; float acc[16];
#pragma unroll
    for (int q = 0; q < 16; ++q) acc[q] = 0.f;
    for (int n = 0; n < 64; ++n) { const f32x2 c = Cc[(dir * 16 + pp) * 64 + n], w = PWs[(dir * 64 + n) * 32 + d];
      const float Wr = c.x * w.x - c.y * w.y, Wi = c.x * w.y + c.y * w.x;
#pragma unroll
      for (int q = 0; q < 16; ++q) { const f32x2 b = Bb[(dir * 64 + n) * 16 + q]; acc[q] += Wr * b.x - Wi * b.y; } }
#pragma unroll
    for (int q = 0; q < 16; ++q) Kt[((dir * 16 + d) * 16 + pp) * 16 + q] = acc[q]; }
  __syncthreads();
  bf16_t* Mout = (bf16_t*)(p.ws + WS_MIX + 32 * MiB); bf16_t* Mst = (bf16_t*)(p.ws + WS_MIX + 16 * MiB);
  for (int it = 0; it < 16; ++it) { const int id = it * 512 + tid, row_l = id >> 6, cgp = id & 63, t = 8 * hf + (row_l >> 4), pp = row_l & 15; float v[8];
    if (cgp < 32) { const int tp = cgp >> 1, q0 = (cgp & 1) * 8;
#pragma unroll
      for (int e = 0; e < 8; ++e) { const int q = q0 + e; float x = 0.f;
        if (tp <= t) x += Kt[((0 * 16 + (t - tp)) * 16 + pp) * 16 + q];
        if (tp >= t) x += Kt[((1 * 16 + (tp - t)) * 16 + pp) * 16 + q];
        if (tp == t && pp == q) x += p.s5_d[j * DM + g * 16 + pp];
        v[e] = x; }
    } else { const int kk0 = (cgp - 32) * 8, dir = kk0 >> 7, n0 = (kk0 & 127) >> 1, slot = 15 + (dir == 0 ? t + 1 : 16 - t);
#pragma unroll
      for (int e = 0; e < 8; ++e) { const int n = n0 + (e >> 1), ri = e & 1; const f32x2 c = Cc[(dir * 16 + pp) * 64 + n], w = PWs[(dir * 64 + n) * 32 + slot];
        v[e] = ri == 0 ? (c.x * w.x - c.y * w.y) : -(c.x * w.y + c.y * w.x); } }
    u32x4 w4; w4.x = cvt_pk_bf16(v[0], v[1]); w4.y = cvt_pk_bf16(v[2], v[3]); w4.z = cvt_pk_bf16(v[4], v[5]); w4.w = cvt_pk_bf16(v[6], v[7]);
    *(u32x4*)(Mout + ((size_t)(g * 256 + t * 16 + pp)) * 512 + cgp * 8) = w4; }
  for (int it = 0; it < 8; ++it) { const int id = it * 512 + tid, row_l = id >> 5, cgp = id & 31, dir = hf, ri = row_l & 1, n = row_l >> 1, tp = cgp >> 1, q0 = (cgp & 1) * 8;
    const f32x2 w = PWs[(dir * 64 + n) * 32 + (dir == 0 ? 15 - tp : tp)]; float v[8];
#pragma unroll
    for (int e = 0; e < 8; ++e) { const f32x2 b = Bb[(dir * 64 + n) * 16 + q0 + e]; v[e] = ri == 0 ? (w.x * b.x - w.y * b.y) : (w.x * b.y + w.y * b.x); }
    u32x4 w4; w4.x = cvt_pk_bf16(v[0], v[1]); w4.y = cvt_pk_bf16(v[2], v[3]); w4.z = cvt_pk_bf16(v[4], v[5]); w4.w = cvt_pk_bf16(v[6], v[7]);
    *(u32x4*)(Mst + ((size_t)(g * 256 + dir * 128 + row_l)) * 256 + cgp * 8) = w4; }
  __syncthreads();
}

__device__ __forceinline__ void phase_prep(const Ctx& cx, const Params& p, int layer, float* L) {
  const int kind = layer % 3, j = layer / 3;
  if (kind == 0) { for (int it = cx.bid; it < 256; it += cx.G) s5_prep_item(cx, L, p, j, it >> 1, it & 1); }
  cvt_job(cx, L, p.w1 + (size_t)layer * DM * DFF, (bf16_t*)(p.ws + WS_W1T), DM, DFF, DM, 0, LAZY_SCHED ? p.ln1g + layer * DM : nullptr, p.ln1b + layer * DM, (float*)(p.ws + WS_CG), (float*)(p.ws + WS_CG) + DFF);
  cvt_job(cx, L, p.w2 + (size_t)layer * DFF * DM, (bf16_t*)(p.ws + WS_W2T), DFF, DM, DFF, 0);
  if (kind == 0) {
    cvt_job(cx, L, p.s5_wout + (size_t)j * DM * DM, (bf16_t*)(p.ws + WS_MIX), DM, DM, DM, 1);
    cvt_job(cx, L, p.s5_wgate + (size_t)j * DM * DM, (bf16_t*)(p.ws + WS_MIX), DM, DM, DM, 2);
  } else if (kind == 1) {
    for (int gi = 0; gi < 4; ++gi) cvt_job(cx, L, p.pool_w + (size_t)gi * 512 * 512, (bf16_t*)(p.ws + WS_MIX) + (size_t)gi * 512 * 512, 512, 512, 512, 0);
  } else {
    cvt_job(cx, L, p.wqkv, (bf16_t*)(p.ws + WS_MIX), DM, QKVD, DM, 0);
    cvt_job(cx, L, p.wo, (bf16_t*)(p.ws + WS_MIX + 12 * MiB), DM, DM, DM, 0);
  }
}

__device__ __forceinline__ void phase_scan(const Ctx& cx, const Params& p, int j, bool own) {
  const int lane = cx.tid_() & 63, wave = cx.tid_() >> 6;
  pg8::StaticOrder SO; SO.init(10, 128, (int)cx.G, (int)cx.bid, WGM_OTHER);
  const bf16_t* S = (const bf16_t*)(p.ws + WS_R); bf16_t* H = (bf16_t*)(p.ws + WS_R + 320 * MiB);
  for (int it = wave;; it += 8) {
    int g, b;
    if (own) { pg8::Unit u; if (!SO.next(it, u)) break; b = u.pm; g = u.pn; }
    else { const int item = it * cx.G + cx.bid; if (item >= NBATCH * 128) break; g = item & 127; b = item >> 7; }
    const f32x2 lamF = ((const f32x2*)(p.ws + WS_PW))[(((size_t)(j * 2 + 0) * 128 + g) * 64 + lane) * 32 + 31];
    const f32x2 lamB = ((const f32x2*)(p.ws + WS_PW))[(((size_t)(j * 2 + 1) * 128 + g) * 64 + lane) * 32 + 31];
    f32x2 hF = {0.f, 0.f}, hB = {0.f, 0.f};
    const unsigned* Sb = (const unsigned*)(S + (size_t)b * 256 * 32768 + g * 256 + 2 * lane);
    unsigned* Hb = (unsigned*)(H + (size_t)b * 256 * 32768 + g * 256 + 2 * lane);
    unsigned sF[8], sB[8];
#pragma unroll
    for (int e = 0; e < 8; ++e) { sF[e] = Sb[(size_t)e * 16384]; sB[e] = Sb[(size_t)(255 - e) * 16384 + 64]; }
    for (int c0 = 0; c0 < 256; c0 += 8) {
      unsigned nF[8], nB[8]; const int c1 = (c0 + 8 < 256) ? c0 + 8 : c0;
#pragma unroll
      for (int e = 0; e < 8; ++e) { nF[e] = Sb[(size_t)(c1 + e) * 16384]; nB[e] = Sb[(size_t)(255 - c1 - e) * 16384 + 64]; }
#pragma unroll
      for (int e = 0; e < 8; ++e) { const int cF = c0 + e, cB = 255 - c0 - e;
        Hb[(size_t)cF * 16384] = cvt_pk_bf16(hF.x, hF.y); Hb[(size_t)cB * 16384 + 64] = cvt_pk_bf16(hB.x, hB.y);
        const float sfx = __uint_as_float(sF[e] << 16), sfy = __uint_as_float(sF[e] & 0xffff0000u), sbx = __uint_as_float(sB[e] << 16), sby = __uint_as_float(sB[e] & 0xffff0000u);
        const float fr_ = lamF.x * hF.x - lamF.y * hF.y + sfx, fi_ = lamF.x * hF.y + lamF.y * hF.x + sfy; hF.x = fr_; hF.y = fi_;
        const float br_ = lamB.x * hB.x - lamB.y * hB.y + sbx, bi_ = lamB.x * hB.y + lamB.y * hB.x + sby; hB.x = br_; hB.y = bi_; }
#pragma unroll
      for (int e = 0; e < 8; ++e) { sF[e] = nF[e]; sB[e] = nB[e]; }
    }
  }
}

#ifndef LN_REPS
#define LN_REPS 1
#endif
__device__ __forceinline__ void phase_ln(const Ctx& cx, const Params& p, const float* gam, const float* bet, bool final_, bool s5lay, bool dummy_in) {
 for (int rep = 0; rep < LN_REPS; ++rep) { const bool dummy = dummy_in || rep > 0; if (rep > 0) final_ = false;
  const int lane = cx.tid_() & 63, gw = cx.bid * 8 + (cx.tid_() >> 6), nw = cx.G * 8;
  if (!dummy) for (int i = cx.bid * 512 + cx.tid_(); i < 2 * DFF; i += cx.G * 512) ((float*)(p.ws + WS_CG))[i] = 0.f;
  f32x2* ST = (f32x2*)(p.ws + (dummy ? WS_R + 480 * MiB : WS_ST));
  int row = gw; f32x4 v[8], g4[8], b4[8];
#pragma unroll
  for (int k = 0; k < 8; ++k) { g4[k] = ((const f32x4*)gam)[k * 64 + lane]; b4[k] = ((const f32x4*)bet)[k * 64 + lane]; }
  { const f32x4* xr = (const f32x4*)(p.X + (size_t)min(row, MTOK - 1) * DM);
#pragma unroll
    for (int k = 0; k < 8; ++k) v[k] = xr[k * 64 + lane]; }
  while (row < MTOK) {
    const int nrow = row + nw; f32x4 nv[8];
    { const f32x4* xn = (const f32x4*)(p.X + (size_t)min(nrow, MTOK - 1) * DM);
#pragma unroll
      for (int k = 0; k < 8; ++k) nv[k] = xn[k * 64 + lane]; }
    u32x2* xb0 = (u32x2*)(p.ws + (dummy ? WS_R + 320 * MiB : WS_XB)); u32x2* xb = xb0 + (size_t)row * (DM / 4);
    f32x4* xo = dummy ? (f32x4*)(p.ws + WS_R) + (size_t)row * (DM / 4) : (f32x4*)(p.X + (size_t)row * DM);
    float s = 0.f, q = 0.f;
#pragma unroll
    for (int k = 0; k < 8; ++k) { s += (v[k][0] + v[k][1]) + (v[k][2] + v[k][3]); q += (v[k][0] * v[k][0] + v[k][1] * v[k][1]) + (v[k][2] * v[k][2] + v[k][3] * v[k][3]); }
#pragma unroll
    for (int o = 32; o >= 1; o >>= 1) { const float s2 = __int_as_float(__builtin_amdgcn_ds_bpermute((lane ^ o) << 2, __float_as_int(s))), q2 = __int_as_float(__builtin_amdgcn_ds_bpermute((lane ^ o) << 2, __float_as_int(q))); s += s2; q += q2; }
    const float mean = s * (1.0f / DM); const float rstd = rsqrtf(fmaxf(q * (1.0f / DM) - mean * mean, 0.f) + LN_EPS);
    if (lane == 0) { ST[row] = (f32x2){mean, rstd}; if (!dummy) { float z0; asm volatile("v_mov_b32 %0, 0" : "=v"(z0)); ((f32x2*)(p.ws + WS_ACC))[row] = (f32x2){z0, z0}; } }
#pragma unroll
    for (int k = 0; k < 8; ++k) {
      const f32x4 o = ((v[k] - mean) * rstd) * g4[k] + b4[k];
      if (final_) xo[k * 64 + lane] = o;
      else { u32x2 w; w.x = cvt_pk_bf16(o[0], o[1]); w.y = cvt_pk_bf16(o[2], o[3]);
        if (s5lay) { const unsigned ch = (unsigned)(k * 64 + lane) * 4u; xb0[((size_t)(row >> 4) * 32768 + (ch >> 4) * 256 + (row & 15) * 16 + (ch & 15)) >> 2] = w; }
        else xb[k * 64 + lane] = w; } }
#pragma unroll
    for (int k = 0; k < 8; ++k) v[k] = nv[k];
    row = nrow;
  }
 }
}

__device__ __forceinline__ f32x4 ldbf4(const u32x2* p) { const u32x2 u = *p; return (f32x4){__uint_as_float(u.x << 16), __uint_as_float(u.x & 0xffff0000u), __uint_as_float(u.y << 16), __uint_as_float(u.y & 0xffff0000u)}; }
__device__ __forceinline__ void phase_poolpre(const Ctx& cx, const Params& p) {
  const int tid = cx.tid_(); const int gi = tid >> 7, w2 = 1 << gi;
  u32x2* P = (u32x2*)(p.ws + WS_R);
  for (int it = cx.bid; it < NBATCH * 128; it += cx.G) {
    const int b = it >> 7, t0 = (it & 127) * 32;
    const u32x2* xb = (const u32x2*)(p.ws + WS_XB) + (size_t)b * SEQ * (DM / 4) + tid;
    f32x4 s = {0.f, 0.f, 0.f, 0.f};
    for (int k = -w2; k < w2; ++k) { const int tt = t0 + k; const float m = (tt >= 0 && tt < SEQ) ? 1.f : 0.f; const int tc = min(max(tt, 0), SEQ - 1); s += ldbf4(xb + (size_t)tc * (DM / 4)) * m; }
    for (int i0 = 0; i0 < 32; i0 += 8) {
      f32x4 c[8], ad[8], sb[8];
#pragma unroll
      for (int e = 0; e < 8; ++e) { const int t = t0 + i0 + e; c[e] = ldbf4(xb + (size_t)t * (DM / 4));
        const int ta = t + w2, ts = t - w2; const float ma = ta < SEQ ? 1.f : 0.f, ms = ts >= 0 ? 1.f : 0.f;
        ad[e] = ldbf4(xb + (size_t)min(ta, SEQ - 1) * (DM / 4)) * ma; sb[e] = ldbf4(xb + (size_t)max(ts, 0) * (DM / 4)) * ms; }
#pragma unroll
      for (int e = 0; e < 8; ++e) { const int t = t0 + i0 + e; const int lo = max(t - w2, 0), hi = min(t + w2, SEQ); const float inv = 1.0f / (float)(hi - lo);
        const f32x4 o = s * inv - c[e]; u32x2 w; w.x = cvt_pk_bf16(o[0], o[1]); w.y = cvt_pk_bf16(o[2], o[3]); P[((size_t)b * SEQ + t) * (DM / 4) + tid] = w;
        s += ad[e] - sb[e]; }
    }
  }
}

__device__ __forceinline__ void phase_rope(const Ctx& cx, const Params& p, bool dummy) {
  const int lane = cx.tid_() & 63, gw = cx.bid * 8 + (cx.tid_() >> 6), nw = cx.G * 8;
  const int hsel = lane >> 5, li = lane & 31, s = li >> 4, fp = li & 15, e0 = s * 64 + 2 * fp, e1 = e0 + 32;
  const f32x2 qa = *(const f32x2*)(p.qnorm + e0), qb = *(const f32x2*)(p.qnorm + e1), ka = *(const f32x2*)(p.knorm + e0), kb = *(const f32x2*)(p.knorm + e1);
  const f32x4* RT = (const f32x4*)(p.ws + WS_ROPE);
  bf16_t* QKV = (bf16_t*)(p.ws + WS_R);
  for (int tok = gw; tok < MTOK; tok += nw) {
    const int t = tok & (SEQ - 1); const int pos = s == 0 ? (t >> 6) : (t & 63); const f32x4 cs = RT[pos * 16 + fp];
    bf16_t* row = QKV + (size_t)tok * QKVD;
    unsigned ua[10], ub[10];
#pragma unroll
    for (int i = 0; i < 10; ++i) { const int hd = 2 * i + hsel; ua[i] = *(const unsigned*)(row + hd * 128 + e0); ub[i] = *(const unsigned*)(row + hd * 128 + e1); }
#pragma unroll
    for (int i = 0; i < 10; ++i) {
      const int hd = 2 * i + hsel; unsigned* p0 = (unsigned*)(row + hd * 128 + e0); unsigned* p1 = (unsigned*)(row + hd * 128 + e1);
      const unsigned u0 = ua[i], u1 = ub[i];
      const float x1a = __uint_as_float(u0 << 16), x1b = __uint_as_float(u0 & 0xffff0000u), x2a = __uint_as_float(u1 << 16), x2b = __uint_as_float(u1 & 0xffff0000u);
      float ss = (x1a * x1a + x1b * x1b) + (x2a * x2a + x2b * x2b);
#pragma unroll
      for (int o = 16; o >= 1; o >>= 1) ss += __int_as_float(__builtin_amdgcn_ds_bpermute((lane ^ o) << 2, __float_as_int(ss)));
      const float r = rsqrtf(ss * (1.0f / 128.0f) + RMS_EPS); const bool isq = hd < 16;
      const float y1a = x1a * r * (isq ? qa.x : ka.x), y1b = x1b * r * (isq ? qa.y : ka.y), y2a = x2a * r * (isq ? qb.x : kb.x), y2b = x2b * r * (isq ? qb.y : kb.y);
      const float o1a = y1a * cs[0] - y2a * cs[1], o2a = y2a * cs[0] + y1a * cs[1], o1b = y1b * cs[2] - y2b * cs[3], o2b = y2b * cs[2] + y1b * cs[3];
      if (!dummy || o1a == 1.2345e30f) { *p0 = cvt_pk_bf16(o1a, o1b); *p1 = cvt_pk_bf16(o2a, o2b); }
    }
  }
}

__device__ __forceinline__ void phase_attn(const Ctx& cx, const Params& p, char* lds) {
  const bf16_t* QKV = (const bf16_t*)(p.ws + WS_R); bf16_t* O = (bf16_t*)(p.ws + WS_R + 240 * MiB);
  const int G = cx.G, c = cx.bid;
  for (int r = 0;; ++r) {
    int pair, unit;
    if (G == 256) { if (r >= 10) break; const int xcd = c & 7, idx = c >> 3; pair = xcd * 5 + (r >> 1); unit = (r & 1) * 32 + idx; }
    else { const int L = r * G + c; if (L >= 2560) break; pair = L >> 6; unit = L & 63; }
    const int b = pair >> 2, kvh = pair & 3, hq = kvh * 4 + (unit >> 4), qb = unit & 15;
    const bf16_t* Qp = QKV + ((size_t)b * SEQ + qb * 256) * QKVD + hq * 128;
    const bf16_t* Kp = QKV + (size_t)b * SEQ * QKVD + 2048 + kvh * 128;
    const bf16_t* Vp = Kp + 512;
    bf16_t* Op = O + ((size_t)b * SEQ + qb * 256) * DM + hq * 128;
    att::attn_dense_body(Qp, Kp, Vp, Op, SEQ, lds, cx);
    __syncthreads();
  }
}


#define XB_TMO      128
#define XB_XCNT(j)  (256  + 64 * (j))
#define XB_XSUB(j)  (1280 + 64 * (j))
#define XB_XGEN(j)  (2304 + 64 * (j))
#define XB_TOP      3328
#define XB_TOPGEN   3392
#define XCD_BAR_WORDS 3456
#define XB_SPIN_CAP (1u << 22)
__device__ __forceinline__ unsigned xb_ld(unsigned* p)              { return __hip_atomic_load(p, __ATOMIC_RELAXED, __HIP_MEMORY_SCOPE_AGENT); }
__device__ __forceinline__ unsigned xb_add(unsigned* p, unsigned v) { return __hip_atomic_fetch_add(p, v, __ATOMIC_RELAXED, __HIP_MEMORY_SCOPE_AGENT); }
__device__ __forceinline__ unsigned xb_xcc_id() { return (unsigned)__builtin_amdgcn_s_getreg((3 << 11) | 20) & 0xFu; }
#define XB_SPIN(cond, bar) do { unsigned _sp = 0; while (cond) { __builtin_amdgcn_s_sleep(1); \
    if ((++_sp & 255u) == 0u) { if (xb_ld(&(bar)[XB_TMO])) break; if (_sp > XB_SPIN_CAP) { atomicAdd(&(bar)[XB_TMO], 1u); break; } } } } while (0)
__device__ __forceinline__ void xcd_barrier_complete(unsigned* bar, unsigned x, unsigned G, unsigned& nloc, unsigned& nx) {
  unsigned sum, cnt, mine, sp = 0u;
  for (;;) {
    sum = 0u; cnt = 0u; mine = 0u;
#pragma unroll
    for (unsigned j = 0; j < 16; ++j) { const unsigned c = xb_ld(&bar[XB_XCNT(j)]); sum += c; cnt += (c > 0u) ? 1u : 0u; mine = (j == x) ? c : mine; }
    if (sum == G) break;
    __builtin_amdgcn_s_sleep(1);
    if ((++sp & 255u) == 0u) { if (xb_ld(&bar[XB_TMO])) break; if (sp > XB_SPIN_CAP) { atomicAdd(&bar[XB_TMO], 1u); break; } }
  }
  nloc = mine > 0u ? mine : 1u; nx = cnt > 0u ? cnt : 1u;
}
__device__ __forceinline__ void xcd_barrier(const Ctx& cx, unsigned* bar, volatile LAS unsigned* st) {
  asm volatile("s_waitcnt vmcnt(0)" ::: "memory");
  __syncthreads();
  if (cx.tid_() == 0) {
    const unsigned x = xb_xcc_id();
    __builtin_amdgcn_s_waitcnt(0);
    unsigned nloc = st[0], nx = st[1];
    if (nloc == 0u) { xcd_barrier_complete(bar, x, (unsigned)cx.G, nloc, nx); st[0] = nloc; st[1] = nx; }
    const unsigned old = xb_add(&bar[XB_XSUB(x)], 1u);
    const unsigned gen = old / nloc;
    if (old + 1u == (gen + 1u) * nloc) {
      __builtin_amdgcn_fence(__ATOMIC_RELEASE, "agent");
      asm volatile("s_waitcnt vmcnt(0)" ::: "memory");
      const unsigned og = xb_add(&bar[XB_TOP], 1u);
      const unsigned tg = og / nx;
      if (og + 1u == (tg + 1u) * nx) xb_add(&bar[XB_TOPGEN], 1u);
      else XB_SPIN(xb_ld(&bar[XB_TOPGEN]) == tg, bar);
      __builtin_amdgcn_fence(__ATOMIC_ACQUIRE, "agent");
      xb_add(&bar[XB_XGEN(x)], 1u);
      asm volatile("s_waitcnt vmcnt(0)" ::: "memory");
    } else {
      XB_SPIN(xb_ld(&bar[XB_XGEN(x)]) == gen, bar);
      __builtin_amdgcn_fence(__ATOMIC_ACQUIRE, "agent");
      asm volatile("s_waitcnt vmcnt(0)" ::: "memory");
    }
  }
  __syncthreads();
}

enum { T_PRE = 0, T_PREP, T_S5G1, T_SCAN, T_S5G2, T_GLU, T_LN1, T_UP, T_DOWN, T_LN2, T_POOLPRE, T_POOLG, T_QKV, T_ROPE, T_ATT, T_WO };

constexpr int NSTEPS = LAZY_SCHED ? 31 : 30;
#ifndef PROBE_MASK
#define PROBE_MASK 0
#endif


__device__ __forceinline__ void run_step(const Ctx& cx, const Params& p, int type, int layer, unsigned char* lds, bool dummy) {
  using namespace pg8;
  unsigned char* ws = p.ws;
  const int j = layer / 3;
  bool is_gemm = false; pg8::GemmDesc g;
  g.A = nullptr; g.A2 = nullptr; g.Bt = nullptr; g.rowStrideA = DM * 2; g.ldbBytes = DM * 2; g.pnStrideA = 0; g.pnShift = 0; g.chunked = 0; g.ksplit = 1 << 20; g.nt = 32; g.nM = MTOK / 256; g.nN = 8;
  g.mode = 0; g.out = nullptr; g.ldc = DM; g.lnsel = 0; g.flags = 0; g.layer = layer; g.wgm = WGM_OTHER;
  switch (type) {
    case T_PRE: phase_pre(cx, p); break;
    case T_PREP: phase_prep(cx, p, layer, (float*)lds); break;
    case T_S5G1: is_gemm = true; g.A = (const char*)(ws + WS_XB); g.A2 = g.A; g.Bt = (const char*)(ws + WS_MIX + 16 * MiB); g.rowStrideA = 65536; g.ldbBytes = 512; g.pnStrideA = 512;
      g.nt = 4; g.nM = 10; g.nN = 128; g.mode = 0; g.out = ws + WS_R; g.ldc = 32768; break;
    case T_SCAN: phase_scan(cx, p, j, false); break;
    case T_S5G2: is_gemm = true; g.A = (const char*)(ws + WS_XB); g.A2 = (const char*)(ws + WS_R + 320 * MiB); g.Bt = (const char*)(ws + WS_MIX + 32 * MiB); g.rowStrideA = 65536; g.ldbBytes = 1024; g.pnStrideA = 512;
      g.ksplit = 4; g.nt = 8; g.nM = 10; g.nN = 128; g.mode = 2; g.out = ws + WS_R + 480 * MiB; g.ldc = 32768; break;
    case T_GLU: is_gemm = true; g.A = (const char*)(ws + WS_R + 480 * MiB); g.A2 = g.A; g.Bt = (const char*)(ws + WS_MIX); g.chunked = 1; g.nN = 16; g.mode = 5; g.out = p.X; if (layer > 0) { g.flags = F_LN_STATS | (EMIT_ON ? F_EMIT : 0); g.lnsel = 2; } else g.flags = F_XIN | (EMIT_ON ? F_EMIT : 0); break;
    case T_LN1: phase_ln(cx, p, p.ln1g + layer * DM, p.ln1b + layer * DM, false, false, dummy); break;
    case T_UP: is_gemm = true; g.A = (const char*)(ws + WS_XB); g.A2 = g.A; g.Bt = (const char*)(ws + WS_W1T); g.nN = 32; g.mode = 1; g.out = ws + WS_R; g.ldc = DFF; g.wgm = WGM_UP; g.flags = LAZY_SCHED ? (F_LN_ACC | F_FOLD) : 0; break;
    case T_DOWN: is_gemm = true; g.A = (const char*)(ws + WS_R); g.A2 = g.A; g.Bt = (const char*)(ws + WS_W2T); g.rowStrideA = DFF * 2; g.ldbBytes = DFF * 2; g.nt = 128; g.mode = 3; g.out = p.X; g.wgm = WGM_DOWN; g.flags = LAZY_SCHED ? F_LN_ACC : F_LN_STATS; g.lnsel = 1; break;
    case T_LN2: phase_ln(cx, p, p.ln2g + layer * DM, p.ln2b + layer * DM, layer == 3, layer == 2, dummy);
      if (!LAZY_SCHED && layer < 3) { __syncthreads(); phase_prep(cx, p, layer + 1, (float*)lds); } break;
    case T_POOLPRE: phase_poolpre(cx, p); break;
    case T_POOLG: is_gemm = true; g.A = (const char*)(ws + WS_R); g.A2 = g.A; g.Bt = (const char*)(ws + WS_MIX); g.ldbBytes = 1024; g.pnStrideA = 1024; g.pnShift = 1; g.nt = 8; g.mode = 4; g.out = p.X; g.flags = F_CSCALE | F_LN_STATS | (EMIT_ON ? F_EMIT : 0); g.lnsel = 2; break;
    case T_QKV: is_gemm = true; g.A = (const char*)(ws + WS_XB); g.A2 = g.A; g.Bt = (const char*)(ws + WS_MIX); g.nN = 12; g.mode = 0; g.out = ws + WS_R; g.ldc = QKVD; break;
    case T_ROPE: phase_rope(cx, p, dummy); break;
    case T_ATT: phase_attn(cx, p, (char*)lds); break;
    case T_WO: is_gemm = true; g.A = (const char*)(ws + WS_R + 240 * MiB); g.A2 = g.A; g.Bt = (const char*)(ws + WS_MIX + 12 * MiB); g.mode = 3; g.out = p.X; g.flags = F_LN_STATS | (EMIT_ON ? F_EMIT : 0); g.lnsel = 2; break;
    default: break;
  }
  if (is_gemm) { if (dummy && g.mode >= 3 && g.mode <= 5) g.mode = 7; pg8::gemm_phase(cx, (LAS unsigned char*)lds, g);
    if (type == T_S5G1) { __builtin_amdgcn_fence(__ATOMIC_ACQUIRE, "agent"); asm volatile("s_waitcnt vmcnt(0)" ::: "memory"); __syncthreads(); phase_scan(cx, p, j, true); } }
}


__device__ __forceinline__ void step_info(int s, int& type, int& layer) {
  if (s == 0) { type = T_PRE; layer = 0; return; }
  int r;
#if LAZY_SCHED
  if (s < 9) { layer = 0; r = s - 1; } else if (s < 15) { layer = 1; r = s - 9; } else if (s < 23) { layer = 2; r = s - 15; } else { layer = 3; r = s - 23; }
#else
  if (s < 9) { layer = 0; r = s - 1; } else if (s < 15) { layer = 1; r = s - 9 + 1; } else if (s < 23) { layer = 2; r = s - 15 + 1; } else { layer = 3; r = s - 23 + 1; }
#endif
  const int kind = layer % 3;
  if (r == 0) { type = T_PREP; return; }
  const int nmix = kind == 1 ? 2 : (kind == 0 ? 3 : 4);
  if (r <= nmix) {
    const int m = r - 1;
    if (kind == 0) type = (m == 0) ? T_S5G1 : (m == 1) ? T_S5G2 : T_GLU;
    else if (kind == 1) type = (m == 0) ? T_POOLPRE : T_POOLG;
    else type = (m == 0) ? T_QKV : (m == 1) ? T_ROPE : (m == 2) ? T_ATT : T_WO;
    return;
  }
  const int q = r - nmix - 1;
#if LAZY_SCHED
  type = (q == 0) ? T_UP : (q == 1) ? T_DOWN : T_LN2;
#else
  type = (q == 0) ? T_LN1 : (q == 1) ? T_UP : (q == 2) ? T_DOWN : T_LN2;
#endif
}
__global__ void __launch_bounds__(512) fwd_megakernel(Params p_unused) {
  extern __shared__ __attribute__((aligned(16))) unsigned char lds[];
  cg::grid_group grid = cg::this_grid();
  const int wave0 = __builtin_amdgcn_readfirstlane((int)threadIdx.x >> 6);
  { volatile LAS unsigned* st0 = (volatile LAS unsigned*)((LAS unsigned char*)lds + 128 * 1024);
    if (threadIdx.x < 4) st0[threadIdx.x] = 0u;
    __syncthreads();
    KargP pq = (KargP)__builtin_amdgcn_kernarg_segment_ptr();
    if (threadIdx.x == 0) (void)xb_add(&((unsigned*)(pq->ws + WS_BAR))[XB_XCNT(xb_xcc_id())], 1u); }
  for (int s = 0; s < NSTEPS; ++s) {
    int type, layer; step_info(s, type, layer);
    KargP pp = (KargP)__builtin_amdgcn_kernarg_segment_ptr();
    asm volatile("" : "+s"(pp));
    Ctx cx; { int b_ = (int)blockIdx.x, g_ = (int)gridDim.x; asm volatile("" : "+s"(b_)); asm volatile("" : "+s"(g_)); cx.wave0 = wave0; cx.bid = b_; cx.G = g_; }
#if defined(__HIP_DEVICE_COMPILE__)
    const Params p = *pp;
#else
    const Params p = p_unused;
#endif
    run_step(cx, p, type, layer, lds, false);
    if (s + 1 < NSTEPS) {
      if (s == 0) grid.sync();
      else { xcd_barrier(cx, (unsigned*)(p.ws + WS_BAR), (volatile LAS unsigned*)((LAS unsigned char*)lds + 128 * 1024)); }
    }
  }
}
extern "C" void kernel_launch(void* const* d_in, const int* in_sizes, int n_in, void* d_out, int out_size, void* d_ws, size_t ws_size,
                              hipStream_t stream) {
  static int grid_blocks = 0;
  if (!grid_blocks) {
    int dev = 0, cus = 0, per_cu = 0;
    (void)hipGetDevice(&dev);
    (void)hipDeviceGetAttribute(&cus, hipDeviceAttributeMultiprocessorCount, dev);
    (void)hipFuncSetAttribute((const void*)fwd_megakernel, hipFuncAttributeMaxDynamicSharedMemorySize, LDS_BYTES);
    (void)hipOccupancyMaxActiveBlocksPerMultiprocessor(&per_cu, (const void*)fwd_megakernel, 512, LDS_BYTES);
    if (per_cu != 1) per_cu = 1;
    grid_blocks = cus * per_cu;
    if (ws_size < WS_END) fprintf(stderr, "kernel_launch: workspace too small: %zu < %zu\n", ws_size, (size_t)WS_END);
  }
  Params p{};
  p.xp = (const float*)d_in[0]; p.xs = (const float*)d_in[1];
  p.a_re = (const float*)d_in[2]; p.a_im = (const float*)d_in[3]; p.log_step = (const float*)d_in[4];
  p.b_re = (const float*)d_in[5]; p.b_im = (const float*)d_in[6]; p.c_re = (const float*)d_in[7]; p.c_im = (const float*)d_in[8];
  p.s5_d = (const float*)d_in[9]; p.s5_wout = (const float*)d_in[10]; p.s5_wgate = (const float*)d_in[11];
  p.pool_w = (const float*)d_in[12]; p.pool_scale = (const float*)d_in[13];
  p.wqkv = (const float*)d_in[14]; p.qnorm = (const float*)d_in[15]; p.knorm = (const float*)d_in[16]; p.wo = (const float*)d_in[17];
  p.ln1g = (const float*)d_in[18]; p.ln1b = (const float*)d_in[19]; p.ln2g = (const float*)d_in[20]; p.ln2b = (const float*)d_in[21];
  p.w1 = (const float*)d_in[22]; p.w2 = (const float*)d_in[23];
  p.X = (float*)d_out; p.ws = (unsigned char*)d_ws;
  (void)hipMemsetAsync((char*)d_ws + WS_BAR, 0, XCD_BAR_WORDS * 4, stream);
  void* args[] = {&p};
  hipError_t e = hipLaunchCooperativeKernel((const void*)fwd_megakernel, dim3(grid_blocks), dim3(512), args, LDS_BYTES, stream);
  if (e != hipSuccess) fprintf(stderr, "cooperative launch failed: %s (grid %d)\n", hipGetErrorString(e), grid_blocks);
}
```

```cpp
#include <hip/hip_runtime.h>
#include <hip/hip_cooperative_groups.h>
#include <cstdio>
#include <cstdint>
namespace cg = cooperative_groups;
#ifndef WGM_DOWN
#define WGM_DOWN 4
#endif
#ifndef WGM_UP
#define WGM_UP 8
#endif
#ifndef WGM_OTHER
#define WGM_OTHER 4
#endif
#ifndef LAZY_SCHED
#define LAZY_SCHED 0
#endif
#ifndef EMIT_ON
#define EMIT_ON 0
#endif

#define LAS __attribute__((address_space(3)))
typedef unsigned short bf16_t;
typedef short bf16x8 __attribute__((ext_vector_type(8)));
typedef short s16x4 __attribute__((ext_vector_type(4)));
typedef float f32x2 __attribute__((ext_vector_type(2)));
typedef float f32x4 __attribute__((ext_vector_type(4)));
typedef float f32x16 __attribute__((ext_vector_type(16)));
typedef unsigned u32x2 __attribute__((ext_vector_type(2)));
typedef unsigned u32x4 __attribute__((ext_vector_type(4)));

constexpr int DM = 2048, NBATCH = 10, SEQ = 4096, MTOK = NBATCH * SEQ, DFF = 8192, QKVD = 3072;
constexpr float ALPHA = 1.681792830507429f;
constexpr float LN_EPS = 1e-5f, RMS_EPS = 1e-6f;
constexpr size_t MiB = 1024ull * 1024ull;
constexpr size_t WS_PW = 0;
constexpr size_t WS_ROPE = 8 * MiB;
constexpr size_t WS_BAR = 10 * MiB;
constexpr size_t WS_ACC = 11 * MiB;
constexpr size_t WS_CG = 12 * MiB;
constexpr size_t WS_ONE = 13 * MiB;
constexpr size_t WS_ST = 9 * MiB;
constexpr size_t WS_WB = 16 * MiB;
constexpr size_t WS_W1T = WS_WB, WS_W2T = WS_WB + 32 * MiB, WS_MIX = WS_WB + 64 * MiB;
constexpr size_t WS_XB = 144 * MiB;
constexpr size_t WS_R = 304 * MiB;
constexpr size_t WS_END = WS_R + 640 * MiB;
constexpr int LDS_BYTES = 129 * 1024;

struct Params {
  const float* xp; const float* xs;
  const float* a_re; const float* a_im; const float* log_step; const float* b_re; const float* b_im; const float* c_re; const float* c_im;
  const float* s5_d; const float* s5_wout; const float* s5_wgate; const float* pool_w; const float* pool_scale;
  const float* wqkv; const float* qnorm; const float* knorm; const float* wo;
  const float* ln1g; const float* ln1b; const float* ln2g; const float* ln2b; const float* w1; const float* w2;
  float* X; unsigned char* ws;
};

typedef __attribute__((address_space(4))) const Params* KargP;
struct Ctx { int wave0, bid, G;
  __device__ __forceinline__ int tid_() const { int l_; asm volatile("v_mbcnt_lo_u32_b32 %0, -1, 0\n\tv_mbcnt_hi_u32_b32 %0, -1, %0" : "=v"(l_)); return wave0 * 64 + l_; } };
__device__ __forceinline__ unsigned cvt_pk_bf16(float lo, float hi) { unsigned r; asm volatile("v_cvt_pk_bf16_f32 %0, %1, %2" : "=v"(r) : "v"(lo), "v"(hi)); return r; }
__device__ __forceinline__ float bf2f(bf16_t h) { return __uint_as_float(((unsigned)h) << 16); }
__device__ __forceinline__ float wave_sum(float v, int lane) {
#pragma unroll
  for (int o = 32; o >= 1; o >>= 1) v += __int_as_float(__builtin_amdgcn_ds_bpermute((lane ^ o) << 2, __float_as_int(v)));
  return v;
}
__device__ __forceinline__ float gelu_tanh(float x) {
  const float u = 0.7978845608028654f * (x + 0.044715f * x * x * x);
  return x * __builtin_amdgcn_rcpf(1.0f + __builtin_amdgcn_exp2f(-2.885390081777927f * u));
}
__device__ __forceinline__ float sigmoidf_(float x) { return __builtin_amdgcn_rcpf(1.0f + __builtin_amdgcn_exp2f(-1.4426950408889634f * x)); }

namespace pg8 {
constexpr int BM = 256, BK = 64, HALF = 128, HTB = HALF * BK * 2, STAGE_BYTES = 8 * HTB, NXCD = 8, WGM = 4;
__device__ __forceinline__ int lds_byte(int r, int c) { const int st = (r >> 4) * 2 + (c >> 5), rr = r & 15, cc = c & 31, ob = rr * 64 + cc * 2; return st * 1024 + (ob ^ (((ob >> 9) & 1) << 5)); }
__device__ __forceinline__ void stage_rc(int b, int& R, int& C) { const int st = b / 1024, sb = b % 1024, swz = sb ^ (((sb >> 9) & 1) << 5); R = (st >> 1) * 16 + swz / 64; C = (st & 1) * 32 + (swz % 64) / 2; }
__device__ __forceinline__ int perm32(int rho) { const int n = rho >> 4, i = rho & 15; return 8 * (i >> 2) + 4 * n + (i & 3); }

struct Unit { int pm, pn; };
struct GemmDesc {
  const char* A; const char* A2; const char* Bt;
  unsigned rowStrideA, ldbBytes, pnStrideA; int pnShift, chunked, ksplit, nt, nM, nN;
  int mode; void* out; int ldc;
  int wgm;
  int lnsel, flags, layer;
};
enum { F_LN_STATS = 1, F_LN_ACC = 2, F_EMIT = 4, F_XIN = 8, F_FOLD = 16, F_CSCALE = 32 };
struct StaticOrder {
  int nM, nN, nwg, G, c, wgm;
  __device__ void init(int nM_, int nN_, int G_, int c_, int wgm_) { nM = nM_; nN = nN_; nwg = nM * nN; G = G_; c = c_; wgm = wgm_; }
  __device__ bool next(int i, Unit& u) const {
    const long L = (long)i * G + c; if (L >= nwg) return false;
    int wgid = (int)L; { const int q = nwg / NXCD, r = nwg % NXCD, xcd = wgid % NXCD, off = wgid / NXCD; wgid = (xcd < r ? xcd * (q + 1) : r * (q + 1) + (xcd - r) * q) + off; }
    const int nig = wgm * nN, gid = wgid / nig, fm = gid * wgm, gsz = (nM - fm) < wgm ? (nM - fm) : wgm;
    u.pm = fm + ((wgid % nig) % gsz); u.pn = (wgid % nig) / gsz; return true;
  }
};

__device__ __forceinline__ f32x2 row_stats(const f32x2* stats, const float* accIn, int row) {
  if (accIn) { const f32x2 a = *(const f32x2*)(accIn + 2 * (size_t)row); const float mean = a.x * (1.0f / DM); return (f32x2){mean, rsqrtf(fmaxf(a.y * (1.0f / DM) - mean * mean, 0.f) + LN_EPS)}; }
  return stats ? stats[row] : (f32x2){0.f, 1.f};
}
__device__ __forceinline__ void row_emit(float* accOut, int row, float s, float q, int lane, int fq) {
  s += __int_as_float(__builtin_amdgcn_ds_bpermute((lane ^ 16) << 2, __float_as_int(s))); q += __int_as_float(__builtin_amdgcn_ds_bpermute((lane ^ 16) << 2, __float_as_int(q)));
  s += __int_as_float(__builtin_amdgcn_ds_bpermute((lane ^ 32) << 2, __float_as_int(s))); q += __int_as_float(__builtin_amdgcn_ds_bpermute((lane ^ 32) << 2, __float_as_int(q)));
  if (fq == 0) { __hip_atomic_fetch_add(accOut + 2 * (size_t)row, s, __ATOMIC_RELAXED, __HIP_MEMORY_SCOPE_AGENT); __hip_atomic_fetch_add(accOut + 2 * (size_t)row + 1, q, __ATOMIC_RELAXED, __HIP_MEMORY_SCOPE_AGENT); }
}
__device__ __forceinline__ void gemm_epilogue(const GemmDesc& g, const f32x4 (&acc)[2][2][4][2], const Unit& u, int wr, int wc, int fr, int fq, int lane) {
  const int row0 = u.pm * BM + wr * 64 + fr;
  KargP pp = (KargP)__builtin_amdgcn_kernarg_segment_ptr(); asm volatile("" : "+s"(pp));
  unsigned char* const ws_ = pp->ws;
  const float* e_lng = nullptr; const float* e_lnb = nullptr;
  if (g.lnsel == 1) { e_lng = pp->ln1g + g.layer * DM; e_lnb = pp->ln1b + g.layer * DM; } else if (g.lnsel == 2) { e_lng = pp->ln2g + (g.layer - 1) * DM; e_lnb = pp->ln2b + (g.layer - 1) * DM; }
  const f32x2* const e_stats = (g.flags & F_LN_STATS) ? (const f32x2*)(ws_ + WS_ST) : nullptr;
  const float* const e_accIn = (g.flags & F_LN_ACC) ? (const float*)(ws_ + WS_ACC) : nullptr;
  float* const e_accOut = (g.flags & F_EMIT) ? (float*)(ws_ + WS_ACC) : nullptr; bf16_t* const e_xbOut = (bf16_t*)(ws_ + WS_XB);
  const float* const e_cg = (g.flags & F_FOLD) ? (const float*)(ws_ + WS_CG) : nullptr; const float* const e_cb = (const float*)(ws_ + WS_CG) + DFF;
  const float* const e_cscale = (g.flags & F_CSCALE) ? pp->pool_scale : nullptr;
  const float* const e_xin0 = (g.flags & F_XIN) ? pp->xp : nullptr; const float* const e_xin1 = pp->xs;
  if (g.mode <= 2) {
    bf16_t* O = (bf16_t*)g.out; const int col0 = u.pn * BM + wc * 32 + 8 * fq;
    const bool fold = (g.mode == 1) && (e_cg != nullptr);
    f32x4 fg[2][2], fb[2][2]; f32x2 fst[8];
    if (fold) {
#pragma unroll
      for (int bj = 0; bj < 2; ++bj)
#pragma unroll
        for (int n = 0; n < 2; ++n) { fg[bj][n] = *(const f32x4*)(e_cg + col0 + bj * HALF + 4 * n); fb[bj][n] = *(const f32x4*)(e_cb + col0 + bj * HALF + 4 * n); }
#pragma unroll
      for (int gi = 0; gi < 8; ++gi) fst[gi] = *(const f32x2*)(e_accIn + 2 * (size_t)(row0 + (gi >> 2) * HALF + (gi & 3) * 16));
#pragma unroll
      for (int gi = 0; gi < 8; ++gi) { const float mean = fst[gi].x * (1.0f / DM); fst[gi] = (f32x2){mean, rsqrtf(fmaxf(fst[gi].y * (1.0f / DM) - mean * mean, 0.f) + LN_EPS)}; }
    }
#pragma unroll
    for (int ai = 0; ai < 2; ++ai)
#pragma unroll
      for (int m = 0; m < 4; ++m) { bf16_t* rowp = O + (size_t)(row0 + ai * HALF + m * 16) * g.ldc + col0;
#pragma unroll
        for (int bj = 0; bj < 2; ++bj) { f32x4 v0 = acc[ai][bj][m][0], v1 = acc[ai][bj][m][1];
          if (g.mode == 1) {
            if (fold) { const f32x2 st = fst[ai * 4 + m]; v0 = (v0 - fg[bj][0] * st.x) * st.y + fb[bj][0]; v1 = (v1 - fg[bj][1] * st.x) * st.y + fb[bj][1]; }
#pragma unroll
            for (int j = 0; j < 4; ++j) { const float a = fmaxf(v0[j], 0.f), b = fmaxf(v1[j], 0.f); v0[j] = a * a; v1[j] = b * b; } }
          if (g.mode == 2) {
#pragma unroll
            for (int j = 0; j < 4; ++j) { v0[j] = gelu_tanh(v0[j]); v1[j] = gelu_tanh(v1[j]); } }
          u32x4 w; w.x = cvt_pk_bf16(v0[0], v0[1]); w.y = cvt_pk_bf16(v0[2], v0[3]); w.z = cvt_pk_bf16(v1[0], v1[1]); w.w = cvt_pk_bf16(v1[2], v1[3]);
          *(u32x4*)(rowp + bj * HALF) = w; } }
  } else if (g.mode == 3 || g.mode == 4) {
    float* X = (float*)g.out; const int col0 = u.pn * BM + wc * 32 + 4 * fq; const bool ln = e_stats != nullptr || e_accIn != nullptr;
    f32x4 cs[2][2], lg[2][2], lb[2][2];
#pragma unroll
    for (int bj = 0; bj < 2; ++bj)
#pragma unroll
      for (int n = 0; n < 2; ++n) { cs[bj][n] = (g.mode == 4) ? *(const f32x4*)(e_cscale + col0 + bj * HALF + n * 16) : (f32x4){1.f, 1.f, 1.f, 1.f};
        lg[bj][n] = ln ? *(const f32x4*)(e_lng + col0 + bj * HALF + n * 16) : (f32x4){1.f, 1.f, 1.f, 1.f}; lb[bj][n] = ln ? *(const f32x4*)(e_lnb + col0 + bj * HALF + n * 16) : (f32x4){0.f, 0.f, 0.f, 0.f}; }
    f32x2 st[2]; f32x4 xv[2][4];
    const f32x2* const e_sp = e_accIn ? (const f32x2*)e_accIn : (e_stats ? e_stats : (const f32x2*)(ws_ + WS_ONE));
#define RES_LOAD(GI, BUF) do { const int r_ = row0 + ((GI) >> 2) * HALF + ((GI) & 3) * 16; const float* rp_ = X + (size_t)r_ * DM + col0; \
      st[BUF] = e_sp[r_]; \
      _Pragma("unroll") for (int q_ = 0; q_ < 4; ++q_) xv[BUF][q_] = *(const f32x4*)(rp_ + (q_ >> 1) * HALF + (q_ & 1) * 16); } while (0)
    RES_LOAD(0, 0);
#pragma unroll
    for (int gi = 0; gi < 8; ++gi) { const int ai = gi >> 2, m = gi & 3; const int row = row0 + ai * HALF + m * 16; float* rowp = X + (size_t)row * DM + col0;
      if (gi + 1 < 8) RES_LOAD(gi + 1, (gi + 1) & 1);
      float ssum = 0.f, ssq = 0.f; f32x2 sm = st[gi & 1];
      if (e_accIn) { const float mean = sm.x * (1.0f / DM); sm = (f32x2){mean, rsqrtf(fmaxf(sm.y * (1.0f / DM) - mean * mean, 0.f) + LN_EPS)}; }
#pragma unroll
      for (int bj = 0; bj < 2; ++bj)
#pragma unroll
        for (int n = 0; n < 2; ++n) { f32x4* p = (f32x4*)(rowp + bj * HALF + n * 16); const f32x4 x = ((xv[gi & 1][bj * 2 + n] - sm.x) * sm.y) * lg[bj][n] + lb[bj][n]; const f32x4 o = x * ALPHA + acc[ai][bj][m][n] * cs[bj][n]; *p = o;
          if (e_accOut) { ssum += (o[0] + o[1]) + (o[2] + o[3]); ssq += (o[0] * o[0] + o[1] * o[1]) + (o[2] * o[2] + o[3] * o[3]);
            u32x2 w; w.x = cvt_pk_bf16(o[0], o[1]); w.y = cvt_pk_bf16(o[2], o[3]); *(u32x2*)(e_xbOut + (size_t)row * DM + col0 + bj * HALF + n * 16) = w; } }
      if (e_accOut) row_emit(e_accOut, row, ssum, ssq, lane, fq); }
#undef RES_LOAD
  } else if (g.mode == 5) {
    float* X = (float*)g.out; const int col0 = u.pn * HALF + wc * 32 + 4 * fq; const bool ln = e_stats != nullptr;
    f32x4 lg[2], lb[2];
#pragma unroll
    for (int n = 0; n < 2; ++n) { lg[n] = ln ? *(const f32x4*)(e_lng + col0 + n * 16) : (f32x4){1.f, 1.f, 1.f, 1.f}; lb[n] = ln ? *(const f32x4*)(e_lnb + col0 + n * 16) : (f32x4){0.f, 0.f, 0.f, 0.f}; }
    f32x2 st[2][2]; f32x4 xv[2][4];
    const f32x2* const e_sp = e_stats ? e_stats : (const f32x2*)(ws_ + WS_ONE);
#define GLU_SRC(ROW) (e_xin0 ? (((ROW) < 2 * SEQ) ? e_xin0 + (size_t)(ROW) * DM + col0 : e_xin1 + (size_t)((ROW) - 2 * SEQ) * DM + col0) : X + (size_t)(ROW) * DM + col0)
#define GLU_LOAD(PI, BUF) do { _Pragma("unroll") for (int h_ = 0; h_ < 2; ++h_) { const int g_ = 2 * (PI) + h_; const int r_ = row0 + (g_ >> 2) * HALF + (g_ & 3) * 16; const float* sp_ = GLU_SRC(r_); \
      st[BUF][h_] = e_sp[r_]; xv[BUF][2 * h_] = *(const f32x4*)(sp_); xv[BUF][2 * h_ + 1] = *(const f32x4*)(sp_ + 16); } } while (0)
    GLU_LOAD(0, 0);
#pragma unroll
    for (int pi = 0; pi < 4; ++pi) {
      if (pi + 1 < 4) GLU_LOAD(pi + 1, (pi + 1) & 1);
#pragma unroll
      for (int h2 = 0; h2 < 2; ++h2) { const int gi = 2 * pi + h2, ai = gi >> 2, m = gi & 3; const int row = row0 + ai * HALF + m * 16; float* rowp = X + (size_t)row * DM + col0; float ssum = 0.f, ssq = 0.f;
#pragma unroll
        for (int n = 0; n < 2; ++n) { f32x4* p = (f32x4*)(rowp + n * 16); const f32x4 x = ((xv[pi & 1][2 * h2 + n] - st[pi & 1][h2].x) * st[pi & 1][h2].y) * lg[n] + lb[n]; const f32x4 o = acc[ai][0][m][n], gt = acc[ai][1][m][n]; f32x4 h;
#pragma unroll
          for (int j = 0; j < 4; ++j) h[j] = o[j] * sigmoidf_(gt[j]);
          const f32x4 z = x * ALPHA + h; *p = z;
          if (e_accOut) { ssum += (z[0] + z[1]) + (z[2] + z[3]); ssq += (z[0] * z[0] + z[1] * z[1]) + (z[2] * z[2] + z[3] * z[3]);
            u32x2 w; w.x = cvt_pk_bf16(z[0], z[1]); w.y = cvt_pk_bf16(z[2], z[3]); *(u32x2*)(e_xbOut + (size_t)row * DM + col0 + n * 16) = w; } }
        if (e_accOut) row_emit(e_accOut, row, ssum, ssq, lane, fq); } }
#undef GLU_LOAD
#undef GLU_SRC
  } else if (g.mode == 7) {
    if (acc[0][0][0][0][0] == 1.2345e30f) *(f32x4*)g.out = acc[1][1][3][1];
  } else {
    float* C = (float*)g.out; const int col0 = u.pn * BM + wc * 32 + 4 * fq;
#pragma unroll
    for (int ai = 0; ai < 2; ++ai)
#pragma unroll
      for (int m = 0; m < 4; ++m) { float* rowp = C + (size_t)(row0 + ai * HALF + m * 16) * g.ldc + col0;
#pragma unroll
        for (int bj = 0; bj < 2; ++bj)
#pragma unroll
          for (int n = 0; n < 2; ++n) *(f32x4*)(rowp + bj * HALF + n * 16) = acc[ai][bj][m][n]; }
  }
}

__device__ __forceinline__ const char* ktile_ptr(const char* b1, const char* b2, int kt, int ksplit, size_t kstep) { return kt < ksplit ? b1 + (size_t)kt * kstep : b2 + (size_t)(kt - ksplit) * kstep; }

__device__ __forceinline__ void gemm_phase(const Ctx& cx, LAS unsigned char* lds, const GemmDesc& g) {
  const int tid = cx.tid_(), wid = __builtin_amdgcn_readfirstlane(tid >> 6), lane = tid & 63, wr = wid >> 2, wc = wid & 3, fr = lane & 15, fq = lane >> 4;
  const int nt = g.nt, ksplit = g.ksplit; const bool perm = g.mode <= 2;
  unsigned voffA[2], voffB[2];
#pragma unroll
  for (int i = 0; i < 2; ++i) { int R, C; stage_rc(tid * 16 + i * 8192, R, C); const int Rb = perm ? ((R & ~31) + perm32(R & 31)) : R;
    voffA[i] = g.chunked ? (unsigned)((R >> 4) * 65536 + (R & 15) * 32 + (C >> 4) * 512 + (C & 15) * 2) : ((unsigned)R * g.rowStrideA + (unsigned)(C * 2)); voffB[i] = (unsigned)Rb * g.ldbBytes + (unsigned)(C * 2); }
  const size_t kstepA = g.chunked ? 2048 : 128, kstepB = 128;
  const size_t hstepA = (size_t)HALF * g.rowStrideA, hstepB = (size_t)HALF * g.ldbBytes, tstepA = 2 * hstepA, tstepB = 2 * hstepB;
  const unsigned ldsw = (unsigned)wid * 1024u;
  const int aoff = lds_byte(wr * 64 + fr, fq * 8), boff = lds_byte(wc * 32 + fr, fq * 8);
#define PG8_SA(b, h) (((b) * 2 + (h)) * HTB)
#define PG8_SB(b, h) ((4 + (b) * 2 + (h)) * HTB)
#define PG8_STAGE(bufoff, gbase, voff) do { _Pragma("unroll") for (int _i = 0; _i < 2; ++_i) \
    __builtin_amdgcn_global_load_lds((const unsigned*)((const char*)(gbase) + (voff)[_i]), (LAS unsigned*)(lds + (bufoff) + ldsw + _i * 8192), 16, 0, 0); } while (0)
#define PG8_LDA(dst, b, h) do { _Pragma("unroll") for (int m = 0; m < 4; ++m) _Pragma("unroll") for (int k = 0; k < 2; ++k) dst[m][k] = *(const LAS bf16x8*)(lds + PG8_SA(b, h) + aoff + m * 2048 + k * 1024); } while (0)
#define PG8_LDB(dst, b, h) do { _Pragma("unroll") for (int n = 0; n < 2; ++n) _Pragma("unroll") for (int k = 0; k < 2; ++k) dst[n][k] = *(const LAS bf16x8*)(lds + PG8_SB(b, h) + boff + n * 2048 + k * 1024); } while (0)
#define PG8_MMA(ai, bj, At, Bt) do { __builtin_amdgcn_s_setprio(1); _Pragma("unroll") for (int m = 0; m < 4; ++m) _Pragma("unroll") for (int n = 0; n < 2; ++n) _Pragma("unroll") for (int k = 0; k < 2; ++k) \
    acc[ai][bj][m][n] = __builtin_amdgcn_mfma_f32_16x16x32_bf16(Bt[n][k], At[m][k], acc[ai][bj][m][n], 0, 0, 0); __builtin_amdgcn_s_setprio(0); } while (0)
#define PG8_WAIT_V(n) asm volatile("s_waitcnt vmcnt(" #n ")" ::: "memory")
#define PG8_WAIT_L(n) asm volatile("s_waitcnt lgkmcnt(" #n ")" ::: "memory")
#define PG8_BAR __builtin_amdgcn_s_barrier()
#define PG8_SCHED __builtin_amdgcn_sched_barrier(0)
  StaticOrder S; S.init(g.nM, g.nN, (int)cx.G, (int)cx.bid, g.wgm);
  Unit cur, nxt; int ui = 0;
  if (!S.next(0, cur)) return;
  f32x4 acc[2][2][4][2];
#pragma unroll
  for (int a = 0; a < 2; ++a)
#pragma unroll
    for (int b = 0; b < 2; ++b)
#pragma unroll
      for (int m = 0; m < 4; ++m)
#pragma unroll
        for (int n = 0; n < 2; ++n) acc[a][b][m][n] = (f32x4){0.f, 0.f, 0.f, 0.f};
  bf16x8 At[4][2], B0[2][2], B1[2][2];
  size_t aoffu = (size_t)cur.pm * tstepA + (size_t)(cur.pn >> g.pnShift) * g.pnStrideA;
  const char* cA1 = g.A + aoffu; const char* cA2 = g.A2 + aoffu; const char* cB = g.Bt + (size_t)cur.pn * tstepB;
  {
    const char* a0 = ktile_ptr(cA1, cA2, 0, ksplit, kstepA); const char* a1 = ktile_ptr(cA1, cA2, 1, ksplit, kstepA);
    PG8_STAGE(PG8_SB(0, 0), cB, voffB); PG8_STAGE(PG8_SB(0, 1), cB + hstepB, voffB); PG8_STAGE(PG8_SA(0, 0), a0, voffA); PG8_STAGE(PG8_SA(0, 1), a0 + hstepA, voffA);
    if (wr == 1) PG8_BAR;
    PG8_WAIT_V(2); PG8_BAR;
    PG8_STAGE(PG8_SB(1, 0), cB + kstepB, voffB); PG8_STAGE(PG8_SA(1, 0), a1, voffA); PG8_STAGE(PG8_SB(1, 1), cB + hstepB + kstepB, voffB);
    PG8_WAIT_V(6); PG8_BAR;
  }
  for (;;) {
    const bool has_next = S.next(ui + 1, nxt);
    const size_t naoff = has_next ? (size_t)nxt.pm * tstepA + (size_t)(nxt.pn >> g.pnShift) * g.pnStrideA : aoffu;
    const char* nA1 = g.A + naoff; const char* nA2 = g.A2 + naoff; const char* nB = has_next ? g.Bt + (size_t)nxt.pn * tstepB : cB;
    for (int t = 0; t < nt; t += 2) {
      const bool last = (t == nt - 2);
      const char* a1 = ktile_ptr(cA1, cA2, t + 1, ksplit, kstepA);
      const char* a2 = last ? ktile_ptr(nA1, nA2, 0, ksplit, kstepA) : ktile_ptr(cA1, cA2, t + 2, ksplit, kstepA);
      const char* a3 = last ? ktile_ptr(nA1, nA2, 1, ksplit, kstepA) : ktile_ptr(cA1, cA2, t + 3, ksplit, kstepA);
      const char* b2 = last ? nB : cB + (size_t)(t + 2) * kstepB; const char* b3 = b2 + kstepB;
      PG8_LDB(B0, 0, 0); PG8_LDB(B1, 0, 1); PG8_SCHED; PG8_LDA(At, 0, 0); PG8_STAGE(PG8_SA(1, 1), a1 + hstepA, voffA);
      PG8_WAIT_V(8); PG8_WAIT_L(0); PG8_BAR; PG8_MMA(0, 0, At, B0); PG8_MMA(0, 1, At, B1); PG8_BAR; PG8_SCHED;
      PG8_LDA(At, 0, 1); PG8_STAGE(PG8_SB(0, 0), b2, voffB); PG8_STAGE(PG8_SB(0, 1), b2 + hstepB, voffB); PG8_STAGE(PG8_SA(0, 0), a2, voffA);
      PG8_WAIT_V(8); PG8_WAIT_L(0); PG8_BAR; PG8_MMA(1, 0, At, B0); PG8_MMA(1, 1, At, B1); PG8_BAR; PG8_SCHED;
      PG8_LDB(B0, 1, 0); PG8_LDB(B1, 1, 1); PG8_SCHED; PG8_LDA(At, 1, 0); PG8_STAGE(PG8_SA(0, 1), a2 + hstepA, voffA);
      PG8_WAIT_V(8); PG8_WAIT_L(0); PG8_BAR; PG8_MMA(0, 0, At, B0); PG8_MMA(0, 1, At, B1); PG8_BAR; PG8_SCHED;
      PG8_LDA(At, 1, 1); PG8_STAGE(PG8_SB(1, 0), b3, voffB); PG8_STAGE(PG8_SB(1, 1), b3 + hstepB, voffB); PG8_STAGE(PG8_SA(1, 0), a3, voffA);
      PG8_WAIT_V(8); PG8_WAIT_L(0); PG8_BAR; PG8_MMA(1, 0, At, B0); PG8_MMA(1, 1, At, B1); PG8_BAR; PG8_SCHED;
    }
    if (wr == 0) PG8_BAR;
    gemm_epilogue(g, acc, cur, wr, wc, fr, fq, lane);
    if (!has_next) break;
#pragma unroll
    for (int a = 0; a < 2; ++a)
#pragma unroll
      for (int b = 0; b < 2; ++b)
#pragma unroll
        for (int m = 0; m < 4; ++m)
#pragma unroll
          for (int n = 0; n < 2; ++n) acc[a][b][m][n] = (f32x4){0.f, 0.f, 0.f, 0.f};
    cur = nxt; cA1 = nA1; cA2 = nA2; cB = nB; aoffu = naoff; ++ui;
    if (wr == 1) PG8_BAR;
  }
  PG8_WAIT_V(0);
  PG8_BAR;
#undef PG8_SA
#undef PG8_SB
#undef PG8_STAGE
#undef PG8_LDA
#undef PG8_LDB
#undef PG8_MMA
#undef PG8_WAIT_V
#undef PG8_WAIT_L
#undef PG8_BAR
#undef PG8_SCHED
}
}

namespace att {
constexpr int D = 128, NW = 8, QBLK = 32, KVBLK = 64;
constexpr float SCALE = 0.088388347648318440f, THR = 8.f;
constexpr int LDQ = QKVD, LDK = QKVD, LDO = DM;
constexpr size_t SHM_V = KVBLK * D * 2, SHM_K = KVBLK * D * 2, SHM_ATTN = 2 * SHM_V + 2 * SHM_K + NW * 64 * 4;
#define KSWZ(row, colB) ((row) * 256 + ((colB) ^ (((row) & 7) << 4)))
#define SBAR() __builtin_amdgcn_sched_barrier(0)
__device__ __forceinline__ int crow(int r, int hi) { return (r & 3) + 8 * (r >> 2) + 4 * hi; }
__device__ __forceinline__ bf16x8 ld8(const bf16_t* p) { return *reinterpret_cast<const bf16x8*>(p); }
__device__ __forceinline__ void partialSM(f32x16& p0, f32x16& p1, float& m_reg, float& mn, float& alpha) {
  constexpr float C = SCALE * 1.4426950408889634f;
  float pmax = p0[0];
#pragma unroll
  for (int r = 1; r < 16; ++r) pmax = fmaxf(pmax, p0[r]);
#pragma unroll
  for (int r = 0; r < 16; ++r) pmax = fmaxf(pmax, p1[r]);
  { auto rr = __builtin_amdgcn_permlane32_swap(__float_as_uint(pmax), __float_as_uint(pmax), false, false);
    pmax = fmaxf(__uint_as_float(rr[0]), __uint_as_float(rr[1])); }
  if (__builtin_expect(__all(pmax - m_reg <= THR / SCALE), 1)) { mn = m_reg; alpha = 1.f; }
  else { mn = fmaxf(m_reg, pmax); alpha = __builtin_amdgcn_exp2f((m_reg - mn) * C); m_reg = mn; }
  float mnC = -mn * C;
#pragma unroll
  for (int r = 0; r < 16; ++r) p0[r] = fmaf(p0[r], C, mnC);
#pragma unroll
  for (int r = 0; r < 16; ++r) p1[r] = fmaf(p1[r], C, mnC);
#pragma unroll
  for (int r = 0; r < 16; ++r) p0[r] = __builtin_amdgcn_exp2f(p0[r]);
}
__device__ __forceinline__ void finishSM(f32x16& p0, f32x16& p1, float alpha, float& l_reg, bf16x8& pa0, bf16x8& pa1, bf16x8& pa2, bf16x8& pa3) {
#pragma unroll
  for (int r = 0; r < 16; ++r) p1[r] = __builtin_amdgcn_exp2f(p1[r]);
  float ps = 0;
#pragma unroll
  for (int r = 0; r < 16; ++r) ps += p0[r];
#pragma unroll
  for (int r = 0; r < 16; ++r) ps += p1[r];
  { auto rr = __builtin_amdgcn_permlane32_swap(__float_as_uint(ps), __float_as_uint(ps), false, false);
    ps = __uint_as_float(rr[0]) + __uint_as_float(rr[1]); }
  l_reg = l_reg * alpha + ps;
#define PK4(P, BASE, OUT) do { unsigned a0 = cvt_pk_bf16(P[BASE + 0], P[BASE + 1]), a1 = cvt_pk_bf16(P[BASE + 2], P[BASE + 3]);   \
    unsigned b0 = cvt_pk_bf16(P[BASE + 4], P[BASE + 5]), b1 = cvt_pk_bf16(P[BASE + 6], P[BASE + 7]);                              \
    auto r0 = __builtin_amdgcn_permlane32_swap(a0, b0, false, false); auto r1 = __builtin_amdgcn_permlane32_swap(a1, b1, false, false); \
    u32x4 w = {r0[0], r1[0], r0[1], r1[1]}; OUT = *reinterpret_cast<bf16x8*>(&w); } while (0)
  PK4(p0, 0, pa0); PK4(p0, 8, pa1); PK4(p1, 0, pa2); PK4(p1, 8, pa3);
#undef PK4
}
__device__ __forceinline__ void qkt(f32x16& p0, f32x16& p1, const bf16_t* Ks, const bf16x8* qr, int r32, int hi) {
  p0 = f32x16{}; p1 = f32x16{};
#pragma unroll
  for (int d0 = 0; d0 < 8; ++d0) { int cb = (d0 * 16 + hi * 8) * 2;
    bf16x8 b0 = *reinterpret_cast<const bf16x8*>((const char*)Ks + KSWZ(r32, cb));
    bf16x8 b1 = *reinterpret_cast<const bf16x8*>((const char*)Ks + KSWZ(32 + r32, cb));
    p0 = __builtin_amdgcn_mfma_f32_32x32x16_bf16(b0, qr[d0], p0, 0, 0, 0);
    p1 = __builtin_amdgcn_mfma_f32_32x32x16_bf16(b1, qr[d0], p1, 0, 0, 0); }
}
__device__ __forceinline__ int v_st(int k, int c) { const int kk = (k & ~0xC) | ((k & 4) << 1) | ((k & 8) >> 1); return ((kk >> 3) * 4 + (c >> 5)) * 512 + ((kk & 7) * 32 + (c & 31)) * 2; }
__device__ __forceinline__ int v_rd_base(int lane) { return ((lane & 3) << 3) | (((lane >> 2) & 3) << 6) | (((lane >> 4) & 1) << 5) | (((lane >> 5) & 1) << 8); }
constexpr int v_rd_off(int d0, int ks, int half) { return d0 * 512 + ks * 4096 + half * 2048; }
template <int OFF> __device__ __forceinline__ s16x4 tr_read(int vb) {
  s16x4 r; asm volatile("ds_read_b64_tr_b16 %0, %1 offset:%2" : "=&v"(r) : "v"(vb), "i"(OFF) : "memory"); return r;
}
template <int D0> __device__ __forceinline__ void pv_one(f32x16& od, int vb, bf16x8 pa0, bf16x8 pa1, bf16x8 pa2, bf16x8 pa3) {
  const s16x4 l0 = tr_read<v_rd_off(D0, 0, 0)>(vb), h0 = tr_read<v_rd_off(D0, 0, 1)>(vb), l1 = tr_read<v_rd_off(D0, 1, 0)>(vb), h1 = tr_read<v_rd_off(D0, 1, 1)>(vb);
  const s16x4 l2 = tr_read<v_rd_off(D0, 2, 0)>(vb), h2 = tr_read<v_rd_off(D0, 2, 1)>(vb), l3 = tr_read<v_rd_off(D0, 3, 0)>(vb), h3 = tr_read<v_rd_off(D0, 3, 1)>(vb);
  asm volatile("s_waitcnt lgkmcnt(0)" ::: "memory"); SBAR();
#define PK(L, H) (bf16x8){L[0], L[1], L[2], L[3], H[0], H[1], H[2], H[3]}
  od = __builtin_amdgcn_mfma_f32_32x32x16_bf16(pa0, PK(l0, h0), od, 0, 0, 0);
  od = __builtin_amdgcn_mfma_f32_32x32x16_bf16(pa1, PK(l1, h1), od, 0, 0, 0);
  od = __builtin_amdgcn_mfma_f32_32x32x16_bf16(pa2, PK(l2, h2), od, 0, 0, 0);
  od = __builtin_amdgcn_mfma_f32_32x32x16_bf16(pa3, PK(l3, h3), od, 0, 0, 0);
#undef PK
}
__device__ __forceinline__ void pv_d0(f32x16* o, int vb, bf16x8 pa0, bf16x8 pa1, bf16x8 pa2, bf16x8 pa3) {
  pv_one<0>(o[0], vb, pa0, pa1, pa2, pa3); pv_one<1>(o[1], vb, pa0, pa1, pa2, pa3); pv_one<2>(o[2], vb, pa0, pa1, pa2, pa3); pv_one<3>(o[3], vb, pa0, pa1, pa2, pa3);
}
__device__ __forceinline__ void attn_dense_body(const bf16_t* __restrict__ Qb, const bf16_t* __restrict__ Kh, const bf16_t* __restrict__ Vh,
                                                bf16_t* __restrict__ Ob, int seq, char* lds, const Ctx& cx) {
  const int tid = cx.tid_(), wid = tid >> 6, lane = tid & 63, r32 = lane & 31, hi = lane >> 5;
  bf16_t* V_lds = (bf16_t*)lds; bf16_t* K_lds = (bf16_t*)(lds + 2 * SHM_V);
  float* ws = (float*)(lds + 2 * SHM_V + 2 * SHM_K) + wid * 64; float* li_l = ws; float* al_l = ws + 32;
  float m_reg = -1e30f, l_reg = 0; f32x16 o[4] = {}; bf16x8 qr[8];
  const bf16_t* Qw = Qb + (long)(wid * QBLK + r32) * LDQ + hi * 8;
#pragma unroll
  for (int d0 = 0; d0 < 8; ++d0) qr[d0] = ld8(Qw + d0 * 16);
  const int sr = tid >> 4, sc = (tid & 15) * 8, vst0 = v_st(sr, sc), vst1 = v_st(32 + sr, sc);
  const int vb0 = (int)(uintptr_t)V_lds + v_rd_base(lane);
  struct { bf16x8 vs0, vs1, ks0, ks1; } sr_[2];
#define SLOAD(i, k0) do { sr_[i].vs0 = ld8(&Vh[(long)((k0) + sr) * LDK + sc]); sr_[i].vs1 = ld8(&Vh[(long)((k0) + 32 + sr) * LDK + sc]); \
    sr_[i].ks0 = ld8(&Kh[(long)((k0) + sr) * LDK + sc]); sr_[i].ks1 = ld8(&Kh[(long)((k0) + 32 + sr) * LDK + sc]); } while (0)
#define SWRITE(b, i) do { *(bf16x8*)((char*)V_lds + (b) * SHM_V + vst0) = sr_[i].vs0;          \
    *(bf16x8*)((char*)V_lds + (b) * SHM_V + vst1) = sr_[i].vs1; int kc = sc * 2;               \
    *(bf16x8*)((char*)K_lds + (b) * SHM_K + KSWZ(sr, kc)) = sr_[i].ks0;                       \
    *(bf16x8*)((char*)K_lds + (b) * SHM_K + KSWZ(32 + sr, kc)) = sr_[i].ks1; } while (0)
#define SWAIT() asm volatile("s_waitcnt vmcnt(4)" ::: "memory")
#define RESC(a) do { if (__any((a) < 1.f)) { if (hi == 0) al_l[r32] = (a); asm volatile("s_waitcnt lgkmcnt(0)" ::: "memory"); \
    _Pragma("unroll") for (int d = 0; d < 4; ++d) _Pragma("unroll") for (int r = 0; r < 16; ++r) o[d][r] *= al_l[crow(r, hi)]; } } while (0)
  f32x16 pA0, pA1, pB0, pB1; float mnA, mnB, alA, alB; bf16x8 pa0, pa1, pa2, pa3; const int NT = seq / KVBLK;
  constexpr int SE = 0, SO = 1;
  SLOAD(SE, 0); asm volatile("s_waitcnt vmcnt(0)" ::: "memory"); SWRITE(0, SE); __syncthreads();
  qkt(pA0, pA1, K_lds, qr, r32, hi); partialSM(pA0, pA1, m_reg, mnA, alA);
  SLOAD(SO, KVBLK); if (2 < NT) SLOAD(SE, 2 * KVBLK);
  SWAIT(); SWRITE(1, SO); __syncthreads();
  for (int j = 1; j + 1 < NT; j += 2) {
    SBAR(); qkt(pB0, pB1, (bf16_t*)((char*)K_lds + SHM_K), qr, r32, hi);
    finishSM(pA0, pA1, alA, l_reg, pa0, pa1, pa2, pa3); SBAR();
    SLOAD(SO, (j + 2) * KVBLK); SBAR();
    pv_d0(o, vb0, pa0, pa1, pa2, pa3); partialSM(pB0, pB1, m_reg, mnB, alB);
    __syncthreads(); SWAIT(); SWRITE(0, SE);
    RESC(alB); __syncthreads();
    SBAR(); qkt(pA0, pA1, K_lds, qr, r32, hi);
    finishSM(pB0, pB1, alB, l_reg, pa0, pa1, pa2, pa3); SBAR();
    SLOAD(SE, min(j + 3, NT - 1) * KVBLK); SBAR();
    pv_d0(o, vb0 + (int)SHM_V, pa0, pa1, pa2, pa3); partialSM(pA0, pA1, m_reg, mnA, alA);
    __syncthreads(); SWAIT(); SWRITE(1, SO);
    RESC(alA); __syncthreads();
  }
  SBAR(); qkt(pB0, pB1, (bf16_t*)((char*)K_lds + SHM_K), qr, r32, hi);
  finishSM(pA0, pA1, alA, l_reg, pa0, pa1, pa2, pa3); SBAR();
  pv_d0(o, vb0, pa0, pa1, pa2, pa3); partialSM(pB0, pB1, m_reg, mnB, alB);
  __syncthreads(); RESC(alB);
  finishSM(pB0, pB1, alB, l_reg, pa0, pa1, pa2, pa3); SBAR();
  pv_d0(o, vb0 + (int)SHM_V, pa0, pa1, pa2, pa3);
  if (hi == 0) li_l[r32] = l_reg; asm volatile("s_waitcnt lgkmcnt(0)" ::: "memory");
  float rli[16];
#pragma unroll
  for (int r = 0; r < 16; ++r) rli[r] = __builtin_amdgcn_rcpf(li_l[crow(r, hi)]);
  bf16_t* Ow = Ob + (long)(wid * QBLK) * LDO;
#pragma unroll
  for (int r = 0; r < 16; ++r) { int orow = crow(r, hi);
#pragma unroll
    for (int d0 = 0; d0 < 4; ++d0) Ow[(long)orow * LDO + d0 * 32 + r32] = (bf16_t)(cvt_pk_bf16(o[d0][r] * rli[r], 0.f) & 0xffffu); }
#undef SLOAD
#undef SWRITE
#undef SWAIT
#undef RESC
}
}

__device__ __forceinline__ void phase_pre(const Ctx& cx, const Params& p) {
  const size_t gt = (size_t)cx.bid * 512 + cx.tid_(), nth = (size_t)cx.G * 512;
  const size_t n1 = (size_t)2 * SEQ * DM / 4, ntot = (size_t)MTOK * DM / 4;
  f32x4* X4 = (f32x4*)p.X; u32x2* XB2 = (u32x2*)(p.ws + WS_XB);
  for (size_t i = gt; i < ntot; i += 4 * nth) {
    f32x4 v[4];
#pragma unroll
    for (int e = 0; e < 4; ++e) { const size_t ii = i + e * nth; v[e] = (ii < ntot) ? ((ii < n1) ? ((const f32x4*)p.xp)[ii] : ((const f32x4*)p.xs)[ii - n1]) : (f32x4){0.f, 0.f, 0.f, 0.f}; }
#pragma unroll
    for (int e = 0; e < 4; ++e) { const size_t ii = i + e * nth; if (ii < ntot) { u32x2 w; w.x = cvt_pk_bf16(v[e][0], v[e][1]); w.y = cvt_pk_bf16(v[e][2], v[e][3]);
        const size_t tok = ii >> 9; const unsigned ch = (unsigned)(ii & 511) * 4u; XB2[((tok >> 4) * 32768 + (ch >> 4) * 256 + (tok & 15) * 16 + (ch & 15)) >> 2] = w; } }
  }
  for (size_t i = gt; i < (size_t)MTOK * 2 + 2 * DFF; i += nth) { if (i < (size_t)MTOK * 2) ((float*)(p.ws + WS_ACC))[i] = 0.f; else ((float*)(p.ws + WS_CG))[i - (size_t)MTOK * 2] = 0.f; }
  { float z0, o1; asm volatile("v_mov_b32 %0, 0" : "=v"(z0)); asm volatile("v_mov_b32 %0, 1.0" : "=v"(o1)); for (size_t i = gt; i < (size_t)MTOK; i += nth) ((f32x2*)(p.ws + WS_ONE))[i] = (f32x2){z0, o1}; }
  if (gt < 32768) {
    const int idx = (int)gt;
    const float lr = fminf(p.a_re[idx], -1e-4f), li = p.a_im[idx], dt = expf(p.log_step[idx >> 6]);
    const float er = expf(lr * dt), ang = li * dt; const float lbr = er * cosf(ang), lbi = er * sinf(ang);
    const float nr = lbr - 1.f, ni = lbi, den = lr * lr + li * li; const float cr = (nr * lr + ni * li) / den, ci = (ni * lr - nr * li) / den;
    f32x2* T = (f32x2*)(p.ws + WS_PW) + (size_t)idx * 32;
    float pr = 1.f, pi = 0.f;
#pragma unroll
    for (int d = 0; d <= 16; ++d) {
      if (d >= 1) T[15 + d] = (f32x2){pr, pi};
      if (d < 16) T[d] = (f32x2){pr * cr - pi * ci, pr * ci + pi * cr};
      const float t0 = pr * lbr - pi * lbi, t1 = pr * lbi + pi * lbr; pr = t0; pi = t1;
    }
  } else if (gt < 32768 + 2048) {
    const int e = (int)gt - 32768, pos = e >> 5, f = e & 31;
    const float inv = exp2f(-(float)f * (13.287712379549449f / 32.0f)); const float ang = (float)pos * inv;
    ((f32x2*)(p.ws + WS_ROPE))[e] = (f32x2){cosf(ang), sinf(ang)};
  }
}

__device__ __forceinline__ void cvt_job(const Ctx& cx, float* T, const float* __restrict__ src, bf16_t* __restrict__ dst, int K, int N, int ld_dst, int mode,
                                        const float* rs = nullptr, const float* rb = nullptr, float* cgo = nullptr, float* cbo = nullptr) {
  const int tid = cx.tid_(), nK = K >> 6, cnt = nK * (N >> 8);
  float* RED = T + 64 * 257 + 16;
  for (int t = cx.bid; t < cnt; t += cx.G) {
    const int k0 = (t % nK) << 6, n0 = (t / nK) << 8;
    const int r = tid >> 6, c4 = (tid & 63) * 4;
    f32x4 v[8];
#pragma unroll
    for (int i = 0; i < 8; ++i) v[i] = *(const f32x4*)(src + (size_t)(k0 + r + 8 * i) * N + n0 + c4);
    if (rs) { f32x4 pg = {0.f, 0.f, 0.f, 0.f}, pb = {0.f, 0.f, 0.f, 0.f};
#pragma unroll
      for (int i = 0; i < 8; ++i) { const float gk = rs[k0 + r + 8 * i], bk = rb[k0 + r + 8 * i]; pb += v[i] * bk; v[i] *= gk; pg += v[i]; }
      float* rp = RED + r * 256 + c4; rp[0] = pg[0]; rp[1] = pg[1]; rp[2] = pg[2]; rp[3] = pg[3]; rp += 2048; rp[0] = pb[0]; rp[1] = pb[1]; rp[2] = pb[2]; rp[3] = pb[3]; }
#pragma unroll
    for (int i = 0; i < 8; ++i) { float* tp = T + (r + 8 * i) * 257 + c4; tp[0] = v[i][0]; tp[1] = v[i][1]; tp[2] = v[i][2]; tp[3] = v[i][3]; }
    __syncthreads();
    if (rs) { const int which = tid >> 8, n = tid & 255; float s = 0.f;
#pragma unroll
      for (int rr = 0; rr < 8; ++rr) s += RED[which * 2048 + rr * 256 + n];
      __hip_atomic_fetch_add((which ? cbo : cgo) + n0 + n, s, __ATOMIC_RELAXED, __HIP_MEMORY_SCOPE_AGENT); }
    const int n = tid >> 1, kh = (tid & 1) * 32;
    const int nn = n0 + n; const int row = (mode == 0) ? nn : (((nn >> 7) << 8) + (nn & 127) + (mode == 2 ? 128 : 0));
    bf16_t* dp = dst + (size_t)row * ld_dst + k0 + kh;
#pragma unroll
    for (int q = 0; q < 4; ++q) { float w[8];
#pragma unroll
      for (int jj = 0; jj < 8; ++jj) w[jj] = T[(kh + 8 * q + jj) * 257 + n];
      u32x4 o; o.x = cvt_pk_bf16(w[0], w[1]); o.y = cvt_pk_bf16(w[2], w[3]); o.z = cvt_pk_bf16(w[4], w[5]); o.w = cvt_pk_bf16(w[6], w[7]);
      *(u32x4*)(dp + 8 * q) = o; }
    __syncthreads();
  }
}

__device__ __forceinline__ void s5_prep_item(const Ctx& cx, float* L, const Params& p, int j, int g, int hf) {
  const int tid = cx.tid_();
  f32x2* Cc = (f32x2*)L;
  f32x2* Bb = Cc + 2048;
  f32x2* PWs = Bb + 2048;
  float* Kt = (float*)(PWs + 4096);
  { float cr[4], ci[4], br[4], bi[4]; f32x2 pw[8];
#pragma unroll
    for (int k = 0; k < 4; ++k) { const int e = tid + 512 * k, dir = e >> 10, r = e & 1023; const size_t base = ((size_t)(j * 2 + dir) * 128 + g) * 1024 + r;
      cr[k] = p.c_re[base]; ci[k] = p.c_im[base]; br[k] = p.b_re[base]; bi[k] = p.b_im[base]; }
#pragma unroll
    for (int k = 0; k < 8; ++k) { const int e = tid + 512 * k, dir = e >> 11, r = e & 2047; pw[k] = ((const f32x2*)(p.ws + WS_PW))[(((size_t)(j * 2 + dir) * 128 + g) * 64) * 32 + r]; }
#pragma unroll
    for (int k = 0; k < 4; ++k) { const int e = tid + 512 * k; Cc[e] = (f32x2){cr[k], ci[k]}; Bb[e] = (f32x2){br[k], bi[k]}; }
#pragma unroll
    for (int k = 0; k < 8; ++k) PWs[tid + 512 * k] = pw[k]; }
  __syncthreads();
  { const int dir = tid >> 8, d = (tid >> 4) & 15, pp = tid & 15; float acc[16];
#pragma unroll
    for (int q = 0; q < 16; ++q) acc[q] = 0.f;
    for (int n = 0; n < 64; ++n) { const f32x2 c = Cc[(dir * 16 + pp) * 64 + n], w = PWs[(dir * 64 + n) * 32 + d];
      const float Wr = c.x * w.x - c.y * w.y, Wi = c.x * w.y + c.y * w.x;
#pragma unroll
      for (int q = 0; q < 16; ++q) { const f32x2 b = Bb[(dir * 64 + n) * 16 + q]; acc[q] += Wr * b.x - Wi * b.y; } }
#pragma unroll
    for (int q = 0; q < 16; ++q) Kt[((dir * 16 + d) * 16 + pp) * 16 + q] = acc[q]; }
  __syncthreads();
  bf16_t* Mout = (bf16_t*)(p.ws + WS_MIX + 32 * MiB); bf16_t* Mst = (bf16_t*)(p.ws + WS_MIX + 16 * MiB);
  for (int it = 0; it < 16; ++it) { const int id = it * 512 + tid, row_l = id >> 6, cgp = id & 63, t = 8 * hf + (row_l >> 4), pp = row_l & 15; float v[8];
    if (cgp < 32) { const int tp = cgp >> 1, q0 = (cgp & 1) * 8;
#pragma unroll
      for (int e = 0; e < 8; ++e) { const int q = q0 + e; float x = 0.f;
        if (tp <= t) x += Kt[((0 * 16 + (t - tp)) * 16 + pp) * 16 + q];
        if (tp >= t) x += Kt[((1 * 16 + (tp - t)) * 16 + pp) * 16 + q];
        if (tp == t && pp == q) x += p.s5_d[j * DM + g * 16 + pp];
        v[e] = x; }
    } else { const int kk0 = (cgp - 32) * 8, dir = kk0 >> 7, n0 = (kk0 & 127) >> 1, slot = 15 + (dir == 0 ? t + 1 : 16 - t);
#pragma unroll
      for (int e = 0; e < 8; ++e) { const int n = n0 + (e >> 1), ri = e & 1; const f32x2 c = Cc[(dir * 16 + pp) * 64 + n], w = PWs[(dir * 64 + n) * 32 + slot];
        v[e] = ri == 0 ? (c.x * w.x - c.y * w.y) : -(c.x * w.y + c.y * w.x); } }
    u32x4 w4; w4.x = cvt_pk_bf16(v[0], v[1]); w4.y = cvt_pk_bf16(v[2], v[3]); w4.z = cvt_pk_bf16(v[4], v[5]); w4.w = cvt_pk_bf16(v[6], v[7]);
    *(u32x4*)(Mout + ((size_t)(g * 256 + t * 16 + pp)) * 512 + cgp * 8) = w4; }
  for (int it = 0; it < 8; ++it) { const int id = it * 512 + tid, row_l = id >> 5, cgp = id & 31, dir = hf, ri = row_l & 1, n = row_l >> 1, tp = cgp >> 1, q0 = (cgp & 1) * 8;
    const f32x2 w = PWs[(dir * 64 + n) * 32 + (dir == 0 ? 15 - tp : tp)]; float v[8];
#pragma unroll
    for (int e = 0; e < 8; ++e) { const f32x2 b = Bb[(dir * 64 + n) * 16 + q0 + e]; v[e] = ri == 0 ? (w.x * b.x - w.y * b.y) : (w.x * b.y + w.y * b.x); }
    u32x4 w4; w4.x = cvt_pk_bf16(v[0], v[1]); w4.y = cvt_pk_bf16(v[2], v[3]); w4.z = cvt_pk_bf16(v[4], v[5]); w4.w = cvt_pk_bf16(v[6], v[7]);
    *(u32x4*)(Mst + ((size_t)(g * 256 + dir * 128 + row_l)) * 256 + cgp * 8) = w4; }
  __syncthreads();
}

__device__ __forceinline__ void phase_prep(const Ctx& cx, const Params& p, int layer, float* L) {
  const int kind = layer % 3, j = layer / 3;
  if (kind == 0) { for (int it = cx.bid; it < 256; it += cx.G) s5_prep_item(cx, L, p, j, it >> 1, it & 1); }
  cvt_job(cx, L, p.w1 + (size_t)layer * DM * DFF, (bf16_t*)(p.ws + WS_W1T), DM, DFF, DM, 0, LAZY_SCHED ? p.ln1g + layer * DM : nullptr, p.ln1b + layer * DM, (float*)(p.ws + WS_CG), (float*)(p.ws + WS_CG) + DFF);
  cvt_job(cx, L, p.w2 + (size_t)layer * DFF * DM, (bf16_t*)(p.ws + WS_W2T), DFF, DM, DFF, 0);
  if (kind == 0) {
    cvt_job(cx, L, p.s5_wout + (size_t)j * DM * DM, (bf16_t*)(p.ws + WS_MIX), DM, DM, DM, 1);
    cvt_job(cx, L, p.s5_wgate + (size_t)j * DM * DM, (bf16_t*)(p.ws + WS_MIX), DM, DM, DM, 2);
  } else if (kind == 1) {
    for (int gi = 0; gi < 4; ++gi) cvt_job(cx, L, p.pool_w + (size_t)gi * 512 * 512, (bf16_t*)(p.ws + WS_MIX) + (size_t)gi * 512 * 512, 512, 512, 512, 0);
  } else {
    cvt_job(cx, L, p.wqkv, (bf16_t*)(p.ws + WS_MIX), DM, QKVD, DM, 0);
    cvt_job(cx, L, p.wo, (bf16_t*)(p.ws + WS_MIX + 12 * MiB), DM, DM, DM, 0);
  }
}

__device__ __forceinline__ void phase_scan(const Ctx& cx, const Params& p, int j) {
  const int lane = cx.tid_() & 63, wave = cx.tid_() >> 6;
  const bf16_t* S = (const bf16_t*)(p.ws + WS_R); bf16_t* H = (bf16_t*)(p.ws + WS_R + 320 * MiB);
  for (int item = wave * cx.G + cx.bid; item < NBATCH * 128; item += 8 * cx.G) {
    const int g = item & 127, b = item >> 7;
    const f32x2 lamF = ((const f32x2*)(p.ws + WS_PW))[(((size_t)(j * 2 + 0) * 128 + g) * 64 + lane) * 32 + 31];
    const f32x2 lamB = ((const f32x2*)(p.ws + WS_PW))[(((size_t)(j * 2 + 1) * 128 + g) * 64 + lane) * 32 + 31];
    f32x2 hF = {0.f, 0.f}, hB = {0.f, 0.f};
    const unsigned* Sb = (const unsigned*)(S + (size_t)b * 256 * 32768 + g * 256 + 2 * lane);
    unsigned* Hb = (unsigned*)(H + (size_t)b * 256 * 32768 + g * 256 + 2 * lane);
    unsigned sF[8], sB[8];
#pragma unroll
    for (int e = 0; e < 8; ++e) { sF[e] = Sb[(size_t)e * 16384]; sB[e] = Sb[(size_t)(255 - e) * 16384 + 64]; }
    for (int c0 = 0; c0 < 256; c0 += 8) {
      unsigned nF[8], nB[8]; const int c1 = (c0 + 8 < 256) ? c0 + 8 : c0;
#pragma unroll
      for (int e = 0; e < 8; ++e) { nF[e] = Sb[(size_t)(c1 + e) * 16384]; nB[e] = Sb[(size_t)(255 - c1 - e) * 16384 + 64]; }
#pragma unroll
      for (int e = 0; e < 8; ++e) { const int cF = c0 + e, cB = 255 - c0 - e;
        Hb[(size_t)cF * 16384] = cvt_pk_bf16(hF.x, hF.y); Hb[(size_t)cB * 16384 + 64] = cvt_pk_bf16(hB.x, hB.y);
        const float sfx = __uint_as_float(sF[e] << 16), sfy = __uint_as_float(sF[e] & 0xffff0000u), sbx = __uint_as_float(sB[e] << 16), sby = __uint_as_float(sB[e] & 0xffff0000u);
        const float fr_ = lamF.x * hF.x - lamF.y * hF.y + sfx, fi_ = lamF.x * hF.y + lamF.y * hF.x + sfy; hF.x = fr_; hF.y = fi_;
        const float br_ = lamB.x * hB.x - lamB.y * hB.y + sbx, bi_ = lamB.x * hB.y + lamB.y * hB.x + sby; hB.x = br_; hB.y = bi_; }
#pragma unroll
      for (int e = 0; e < 8; ++e) { sF[e] = nF[e]; sB[e] = nB[e]; }
    }
  }
}

#ifndef LN_REPS
#define LN_REPS 1
#endif
__device__ __forceinline__ void phase_ln(const Ctx& cx, const Params& p, const float* gam, const float* bet, bool final_, bool s5lay, bool dummy_in) {
 for (int rep = 0; rep < LN_REPS; ++rep) { const bool dummy = dummy_in || rep > 0; if (rep > 0) final_ = false;
  const int lane = cx.tid_() & 63, gw = cx.bid * 8 + (cx.tid_() >> 6), nw = cx.G * 8;
  if (!dummy) for (int i = cx.bid * 512 + cx.tid_(); i < 2 * DFF; i += cx.G * 512) ((float*)(p.ws + WS_CG))[i] = 0.f;
  f32x2* ST = (f32x2*)(p.ws + (dummy ? WS_R + 480 * MiB : WS_ST));
  int row = gw; f32x4 v[8], g4[8], b4[8];
#pragma unroll
  for (int k = 0; k < 8; ++k) { g4[k] = ((const f32x4*)gam)[k * 64 + lane]; b4[k] = ((const f32x4*)bet)[k * 64 + lane]; }
  { const f32x4* xr = (const f32x4*)(p.X + (size_t)min(row, MTOK - 1) * DM);
#pragma unroll
    for (int k = 0; k < 8; ++k) v[k] = xr[k * 64 + lane]; }
  while (row < MTOK) {
    const int nrow = row + nw; f32x4 nv[8];
    { const f32x4* xn = (const f32x4*)(p.X + (size_t)min(nrow, MTOK - 1) * DM);
#pragma unroll
      for (int k = 0; k < 8; ++k) nv[k] = xn[k * 64 + lane]; }
    u32x2* xb0 = (u32x2*)(p.ws + (dummy ? WS_R + 320 * MiB : WS_XB)); u32x2* xb = xb0 + (size_t)row * (DM / 4);
    f32x4* xo = dummy ? (f32x4*)(p.ws + WS_R) + (size_t)row * (DM / 4) : (f32x4*)(p.X + (size_t)row * DM);
    float s = 0.f, q = 0.f;
#pragma unroll
    for (int k = 0; k < 8; ++k) { s += (v[k][0] + v[k][1]) + (v[k][2] + v[k][3]); q += (v[k][0] * v[k][0] + v[k][1] * v[k][1]) + (v[k][2] * v[k][2] + v[k][3] * v[k][3]); }
#pragma unroll
    for (int o = 32; o >= 1; o >>= 1) { const float s2 = __int_as_float(__builtin_amdgcn_ds_bpermute((lane ^ o) << 2, __float_as_int(s))), q2 = __int_as_float(__builtin_amdgcn_ds_bpermute((lane ^ o) << 2, __float_as_int(q))); s += s2; q += q2; }
    const float mean = s * (1.0f / DM); const float rstd = rsqrtf(fmaxf(q * (1.0f / DM) - mean * mean, 0.f) + LN_EPS);
    if (lane == 0) { ST[row] = (f32x2){mean, rstd}; if (!dummy) { float z0; asm volatile("v_mov_b32 %0, 0" : "=v"(z0)); ((f32x2*)(p.ws + WS_ACC))[row] = (f32x2){z0, z0}; } }
#pragma unroll
    for (int k = 0; k < 8; ++k) {
      const f32x4 o = ((v[k] - mean) * rstd) * g4[k] + b4[k];
      if (final_) xo[k * 64 + lane] = o;
      else { u32x2 w; w.x = cvt_pk_bf16(o[0], o[1]); w.y = cvt_pk_bf16(o[2], o[3]);
        if (s5lay) { const unsigned ch = (unsigned)(k * 64 + lane) * 4u; xb0[((size_t)(row >> 4) * 32768 + (ch >> 4) * 256 + (row & 15) * 16 + (ch & 15)) >> 2] = w; }
        else xb[k * 64 + lane] = w; } }
#pragma unroll
    for (int k = 0; k < 8; ++k) v[k] = nv[k];
    row = nrow;
  }
 }
}

__device__ __forceinline__ f32x4 ldbf4(const u32x2* p) { const u32x2 u = *p; return (f32x4){__uint_as_float(u.x << 16), __uint_as_float(u.x & 0xffff0000u), __uint_as_float(u.y << 16), __uint_as_float(u.y & 0xffff0000u)}; }
__device__ __forceinline__ void phase_poolpre(const Ctx& cx, const Params& p) {
  const int tid = cx.tid_(); const int gi = tid >> 7, w2 = 1 << gi;
  u32x2* P = (u32x2*)(p.ws + WS_R);
  for (int it = cx.bid; it < NBATCH * 128; it += cx.G) {
    const int b = it >> 7, t0 = (it & 127) * 32;
    const u32x2* xb = (const u32x2*)(p.ws + WS_XB) + (size_t)b * SEQ * (DM / 4) + tid;
    f32x4 s = {0.f, 0.f, 0.f, 0.f};
    for (int k = -w2; k < w2; ++k) { const int tt = t0 + k; const float m = (tt >= 0 && tt < SEQ) ? 1.f : 0.f; const int tc = min(max(tt, 0), SEQ - 1); s += ldbf4(xb + (size_t)tc * (DM / 4)) * m; }
    for (int i0 = 0; i0 < 32; i0 += 8) {
      f32x4 c[8], ad[8], sb[8];
#pragma unroll
      for (int e = 0; e < 8; ++e) { const int t = t0 + i0 + e; c[e] = ldbf4(xb + (size_t)t * (DM / 4));
        const int ta = t + w2, ts = t - w2; const float ma = ta < SEQ ? 1.f : 0.f, ms = ts >= 0 ? 1.f : 0.f;
        ad[e] = ldbf4(xb + (size_t)min(ta, SEQ - 1) * (DM / 4)) * ma; sb[e] = ldbf4(xb + (size_t)max(ts, 0) * (DM / 4)) * ms; }
#pragma unroll
      for (int e = 0; e < 8; ++e) { const int t = t0 + i0 + e; const int lo = max(t - w2, 0), hi = min(t + w2, SEQ); const float inv = 1.0f / (float)(hi - lo);
        const f32x4 o = s * inv - c[e]; u32x2 w; w.x = cvt_pk_bf16(o[0], o[1]); w.y = cvt_pk_bf16(o[2], o[3]); P[((size_t)b * SEQ + t) * (DM / 4) + tid] = w;
        s += ad[e] - sb[e]; }
    }
  }
}

__device__ __forceinline__ void phase_rope(const Ctx& cx, const Params& p, bool dummy) {
  const int lane = cx.tid_() & 63, gw = cx.bid * 8 + (cx.tid_() >> 6), nw = cx.G * 8;
  const int hsel = lane >> 5, li = lane & 31, s = li >> 4, fp = li & 15, e0 = s * 64 + 2 * fp, e1 = e0 + 32;
  const f32x2 qa = *(const f32x2*)(p.qnorm + e0), qb = *(const f32x2*)(p.qnorm + e1), ka = *(const f32x2*)(p.knorm + e0), kb = *(const f32x2*)(p.knorm + e1);
  const f32x4* RT = (const f32x4*)(p.ws + WS_ROPE);
  bf16_t* QKV = (bf16_t*)(p.ws + WS_R);
  for (int tok = gw; tok < MTOK; tok += nw) {
    const int t = tok & (SEQ - 1); const int pos = s == 0 ? (t >> 6) : (t & 63); const f32x4 cs = RT[pos * 16 + fp];
    bf16_t* row = QKV + (size_t)tok * QKVD;
    unsigned ua[10], ub[10];
#pragma unroll
    for (int i = 0; i < 10; ++i) { const int hd = 2 * i + hsel; ua[i] = *(const unsigned*)(row + hd * 128 + e0); ub[i] = *(const unsigned*)(row + hd * 128 + e1); }
#pragma unroll
    for (int i = 0; i < 10; ++i) {
      const int hd = 2 * i + hsel; unsigned* p0 = (unsigned*)(row + hd * 128 + e0); unsigned* p1 = (unsigned*)(row + hd * 128 + e1);
      const unsigned u0 = ua[i], u1 = ub[i];
      const float x1a = __uint_as_float(u0 << 16), x1b = __uint_as_float(u0 & 0xffff0000u), x2a = __uint_as_float(u1 << 16), x2b = __uint_as_float(u1 & 0xffff0000u);
      float ss = (x1a * x1a + x1b * x1b) + (x2a * x2a + x2b * x2b);
#pragma unroll
      for (int o = 16; o >= 1; o >>= 1) ss += __int_as_float(__builtin_amdgcn_ds_bpermute((lane ^ o) << 2, __float_as_int(ss)));
      const float r = rsqrtf(ss * (1.0f / 128.0f) + RMS_EPS); const bool isq = hd < 16;
      const float y1a = x1a * r * (isq ? qa.x : ka.x), y1b = x1b * r * (isq ? qa.y : ka.y), y2a = x2a * r * (isq ? qb.x : kb.x), y2b = x2b * r * (isq ? qb.y : kb.y);
      const float o1a = y1a * cs[0] - y2a * cs[1], o2a = y2a * cs[0] + y1a * cs[1], o1b = y1b * cs[2] - y2b * cs[3], o2b = y2b * cs[2] + y1b * cs[3];
      if (!dummy || o1a == 1.2345e30f) { *p0 = cvt_pk_bf16(o1a, o1b); *p1 = cvt_pk_bf16(o2a, o2b); }
    }
  }
}

__device__ __forceinline__ void phase_attn(const Ctx& cx, const Params& p, char* lds) {
  const bf16_t* QKV = (const bf16_t*)(p.ws + WS_R); bf16_t* O = (bf16_t*)(p.ws + WS_R + 240 * MiB);
  const int G = cx.G, c = cx.bid;
  for (int r = 0;; ++r) {
    int pair, unit;
    if (G == 256) { if (r >= 10) break; const int xcd = c & 7, idx = c >> 3; pair = xcd * 5 + (r >> 1); unit = (r & 1) * 32 + idx; }
    else { const int L = r * G + c; if (L >= 2560) break; pair = L >> 6; unit = L & 63; }
    const int b = pair >> 2, kvh = pair & 3, hq = kvh * 4 + (unit >> 4), qb = unit & 15;
    const bf16_t* Qp = QKV + ((size_t)b * SEQ + qb * 256) * QKVD + hq * 128;
    const bf16_t* Kp = QKV + (size_t)b * SEQ * QKVD + 2048 + kvh * 128;
    const bf16_t* Vp = Kp + 512;
    bf16_t* Op = O + ((size_t)b * SEQ + qb * 256) * DM + hq * 128;
    att::attn_dense_body(Qp, Kp, Vp, Op, SEQ, lds, cx);
    __syncthreads();
  }
}


#define XB_TMO      128
#define XB_XCNT(j)  (256  + 64 * (j))
#define XB_XSUB(j)  (1280 + 64 * (j))
#define XB_XGEN(j)  (2304 + 64 * (j))
#define XB_TOP      3328
#define XB_TOPGEN   3392
#define XCD_BAR_WORDS 3456
#define XB_SPIN_CAP (1u << 22)
__device__ __forceinline__ unsigned xb_ld(unsigned* p)              { return __hip_atomic_load(p, __ATOMIC_RELAXED, __HIP_MEMORY_SCOPE_AGENT); }
__device__ __forceinline__ unsigned xb_add(unsigned* p, unsigned v) { return __hip_atomic_fetch_add(p, v, __ATOMIC_RELAXED, __HIP_MEMORY_SCOPE_AGENT); }
__device__ __forceinline__ unsigned xb_xcc_id() { return (unsigned)__builtin_amdgcn_s_getreg((3 << 11) | 20) & 0xFu; }
#define XB_SPIN(cond, bar) do { unsigned _sp = 0; while (cond) { __builtin_amdgcn_s_sleep(1); \
    if ((++_sp & 255u) == 0u) { if (xb_ld(&(bar)[XB_TMO])) break; if (_sp > XB_SPIN_CAP) { atomicAdd(&(bar)[XB_TMO], 1u); break; } } } } while (0)
__device__ __forceinline__ void xcd_barrier_complete(unsigned* bar, unsigned x, unsigned G, unsigned& nloc, unsigned& nx) {
  unsigned sum, cnt, mine, sp = 0u;
  for (;;) {
    sum = 0u; cnt = 0u; mine = 0u;
#pragma unroll
    for (unsigned j = 0; j < 16; ++j) { const unsigned c = xb_ld(&bar[XB_XCNT(j)]); sum += c; cnt += (c > 0u) ? 1u : 0u; mine = (j == x) ? c : mine; }
    if (sum == G) break;
    __builtin_amdgcn_s_sleep(1);
    if ((++sp & 255u) == 0u) { if (xb_ld(&bar[XB_TMO])) break; if (sp > XB_SPIN_CAP) { atomicAdd(&bar[XB_TMO], 1u); break; } }
  }
  nloc = mine > 0u ? mine : 1u; nx = cnt > 0u ? cnt : 1u;
}
__device__ __forceinline__ void xcd_barrier(const Ctx& cx, unsigned* bar, volatile LAS unsigned* st) {
  asm volatile("s_waitcnt vmcnt(0)" ::: "memory");
  __syncthreads();
  if (cx.tid_() == 0) {
    const unsigned x = xb_xcc_id();
    __builtin_amdgcn_s_waitcnt(0);
    unsigned nloc = st[0], nx = st[1];
    if (nloc == 0u) { xcd_barrier_complete(bar, x, (unsigned)cx.G, nloc, nx); st[0] = nloc; st[1] = nx; }
    const unsigned old = xb_add(&bar[XB_XSUB(x)], 1u);
    const unsigned gen = old / nloc;
    if (old + 1u == (gen + 1u) * nloc) {
      __builtin_amdgcn_fence(__ATOMIC_RELEASE, "agent");
      asm volatile("s_waitcnt vmcnt(0)" ::: "memory");
      const unsigned og = xb_add(&bar[XB_TOP], 1u);
      const unsigned tg = og / nx;
      if (og + 1u == (tg + 1u) * nx) xb_add(&bar[XB_TOPGEN], 1u);
      else XB_SPIN(xb_ld(&bar[XB_TOPGEN]) == tg, bar);
      __builtin_amdgcn_fence(__ATOMIC_ACQUIRE, "agent");
      xb_add(&bar[XB_XGEN(x)], 1u);
      asm volatile("s_waitcnt vmcnt(0)" ::: "memory");
    } else {
      XB_SPIN(xb_ld(&bar[XB_XGEN(x)]) == gen, bar);
      __builtin_amdgcn_fence(__ATOMIC_ACQUIRE, "agent");
      asm volatile("s_waitcnt vmcnt(0)" ::: "memory");
    }
  }
  __syncthreads();
}

enum { T_PRE = 0, T_PREP, T_S5G1, T_SCAN, T_S5G2, T_GLU, T_LN1, T_UP, T_DOWN, T_LN2, T_POOLPRE, T_POOLG, T_QKV, T_ROPE, T_ATT, T_WO };

constexpr int NSTEPS = LAZY_SCHED ? 31 : 32;
#ifndef PROBE_MASK
#define PROBE_MASK 0
#endif


__device__ __forceinline__ void run_step(const Ctx& cx, const Params& p, int type, int layer, unsigned char* lds, bool dummy) {
  using namespace pg8;
  unsigned char* ws = p.ws;
  const int j = layer / 3;
  bool is_gemm = false; pg8::GemmDesc g;
  g.A = nullptr; g.A2 = nullptr; g.Bt = nullptr; g.rowStrideA = DM * 2; g.ldbBytes = DM * 2; g.pnStrideA = 0; g.pnShift = 0; g.chunked = 0; g.ksplit = 1 << 20; g.nt = 32; g.nM = MTOK / 256; g.nN = 8;
  g.mode = 0; g.out = nullptr; g.ldc = DM; g.lnsel = 0; g.flags = 0; g.layer = layer; g.wgm = WGM_OTHER;
  switch (type) {
    case T_PRE: phase_pre(cx, p); break;
    case T_PREP: phase_prep(cx, p, layer, (float*)lds); break;
    case T_S5G1: is_gemm = true; g.A = (const char*)(ws + WS_XB); g.A2 = g.A; g.Bt = (const char*)(ws + WS_MIX + 16 * MiB); g.rowStrideA = 65536; g.ldbBytes = 512; g.pnStrideA = 512;
      g.nt = 4; g.nM = 10; g.nN = 128; g.mode = 0; g.out = ws + WS_R; g.ldc = 32768; break;
    case T_SCAN: phase_scan(cx, p, j); break;
    case T_S5G2: is_gemm = true; g.A = (const char*)(ws + WS_XB); g.A2 = (const char*)(ws + WS_R + 320 * MiB); g.Bt = (const char*)(ws + WS_MIX + 32 * MiB); g.rowStrideA = 65536; g.ldbBytes = 1024; g.pnStrideA = 512;
      g.ksplit = 4; g.nt = 8; g.nM = 10; g.nN = 128; g.mode = 2; g.out = ws + WS_R + 480 * MiB; g.ldc = 32768; break;
    case T_GLU: is_gemm = true; g.A = (const char*)(ws + WS_R + 480 * MiB); g.A2 = g.A; g.Bt = (const char*)(ws + WS_MIX); g.chunked = 1; g.nN = 16; g.mode = 5; g.out = p.X; if (layer > 0) { g.flags = F_LN_STATS | (EMIT_ON ? F_EMIT : 0); g.lnsel = 2; } else g.flags = F_XIN | (EMIT_ON ? F_EMIT : 0); break;
    case T_LN1: phase_ln(cx, p, p.ln1g + layer * DM, p.ln1b + layer * DM, false, false, dummy); break;
    case T_UP: is_gemm = true; g.A = (const char*)(ws + WS_XB); g.A2 = g.A; g.Bt = (const char*)(ws + WS_W1T); g.nN = 32; g.mode = 1; g.out = ws + WS_R; g.ldc = DFF; g.wgm = WGM_UP; g.flags = LAZY_SCHED ? (F_LN_ACC | F_FOLD) : 0; break;
    case T_DOWN: is_gemm = true; g.A = (const char*)(ws + WS_R); g.A2 = g.A; g.Bt = (const char*)(ws + WS_W2T); g.rowStrideA = DFF * 2; g.ldbBytes = DFF * 2; g.nt = 128; g.mode = 3; g.out = p.X; g.wgm = WGM_DOWN; g.flags = LAZY_SCHED ? F_LN_ACC : F_LN_STATS; g.lnsel = 1; break;
    case T_LN2: phase_ln(cx, p, p.ln2g + layer * DM, p.ln2b + layer * DM, layer == 3, layer == 2, dummy);
      if (!LAZY_SCHED && layer < 3) { __syncthreads(); phase_prep(cx, p, layer + 1, (float*)lds); } break;
    case T_POOLPRE: phase_poolpre(cx, p); break;
    case T_POOLG: is_gemm = true; g.A = (const char*)(ws + WS_R); g.A2 = g.A; g.Bt = (const char*)(ws + WS_MIX); g.ldbBytes = 1024; g.pnStrideA = 1024; g.pnShift = 1; g.nt = 8; g.mode = 4; g.out = p.X; g.flags = F_CSCALE | F_LN_STATS | (EMIT_ON ? F_EMIT : 0); g.lnsel = 2; break;
    case T_QKV: is_gemm = true; g.A = (const char*)(ws + WS_XB); g.A2 = g.A; g.Bt = (const char*)(ws + WS_MIX); g.nN = 12; g.mode = 0; g.out = ws + WS_R; g.ldc = QKVD; break;
    case T_ROPE: phase_rope(cx, p, dummy); break;
    case T_ATT: phase_attn(cx, p, (char*)lds); break;
    case T_WO: is_gemm = true; g.A = (const char*)(ws + WS_R + 240 * MiB); g.A2 = g.A; g.Bt = (const char*)(ws + WS_MIX + 12 * MiB); g.mode = 3; g.out = p.X; g.flags = F_LN_STATS | (EMIT_ON ? F_EMIT : 0); g.lnsel = 2; break;
    default: break;
  }
  if (is_gemm) { if (dummy && g.mode >= 3 && g.mode <= 5) g.mode = 7; pg8::gemm_phase(cx, (LAS unsigned char*)lds, g); }
}


__device__ __forceinline__ void step_info(int s, int& type, int& layer) {
  if (s == 0) { type = T_PRE; layer = 0; return; }
  int r;
#if LAZY_SCHED
  if (s < 9) { layer = 0; r = s - 1; } else if (s < 15) { layer = 1; r = s - 9; } else if (s < 23) { layer = 2; r = s - 15; } else { layer = 3; r = s - 23; }
#else
  if (s < 10) { layer = 0; r = s - 1; } else if (s < 16) { layer = 1; r = s - 10 + 1; } else if (s < 24) { layer = 2; r = s - 16 + 1; } else { layer = 3; r = s - 24 + 1; }
#endif
  const int kind = layer % 3;
  if (r == 0) { type = T_PREP; return; }
  const int nmix = kind == 1 ? 2 : 4;
  if (r <= nmix) {
    const int m = r - 1;
    if (kind == 0) type = (m == 0) ? T_S5G1 : (m == 1) ? T_SCAN : (m == 2) ? T_S5G2 : T_GLU;
    else if (kind == 1) type = (m == 0) ? T_POOLPRE : T_POOLG;
    else type = (m == 0) ? T_QKV : (m == 1) ? T_ROPE : (m == 2) ? T_ATT : T_WO;
    return;
  }
  const int q = r - nmix - 1;
#if LAZY_SCHED
  type = (q == 0) ? T_UP : (q == 1) ? T_DOWN : T_LN2;
#else
  type = (q == 0) ? T_LN1 : (q == 1) ? T_UP : (q == 2) ? T_DOWN : T_LN2;
#endif
}
__global__ void __launch_bounds__(512) fwd_megakernel(Params p_unused) {
  extern __shared__ __attribute__((aligned(16))) unsigned char lds[];
  cg::grid_group grid = cg::this_grid();
  const int wave0 = __builtin_amdgcn_readfirstlane((int)threadIdx.x >> 6);
  { volatile LAS unsigned* st0 = (volatile LAS unsigned*)((LAS unsigned char*)lds + 128 * 1024);
    if (threadIdx.x < 4) st0[threadIdx.x] = 0u;
    __syncthreads();
    KargP pq = (KargP)__builtin_amdgcn_kernarg_segment_ptr();
    if (threadIdx.x == 0) (void)xb_add(&((unsigned*)(pq->ws + WS_BAR))[XB_XCNT(xb_xcc_id())], 1u); }
  for (int s = 0; s < NSTEPS; ++s) {
    int type, layer; step_info(s, type, layer);
    KargP pp = (KargP)__builtin_amdgcn_kernarg_segment_ptr();
    asm volatile("" : "+s"(pp));
    Ctx cx; { int b_ = (int)blockIdx.x, g_ = (int)gridDim.x; asm volatile("" : "+s"(b_)); asm volatile("" : "+s"(g_)); cx.wave0 = wave0; cx.bid = b_; cx.G = g_; }
#if defined(__HIP_DEVICE_COMPILE__)
    const Params p = *pp;
#else
    const Params p = p_unused;
#endif
    run_step(cx, p, type, layer, lds, false);
    if (s + 1 < NSTEPS) {
      if (p.ws == nullptr) grid.sync();
      else { xcd_barrier(cx, (unsigned*)(p.ws + WS_BAR), (volatile LAS unsigned*)((LAS unsigned char*)lds + 128 * 1024)); }
    }
  }
}
extern "C" void kernel_launch(void* const* d_in, const int* in_sizes, int n_in, void* d_out, int out_size, void* d_ws, size_t ws_size,
                              hipStream_t stream) {
  static int grid_blocks = 0;
  if (!grid_blocks) {
    int dev = 0, cus = 0, per_cu = 0;
    (void)hipGetDevice(&dev);
    (void)hipDeviceGetAttribute(&cus, hipDeviceAttributeMultiprocessorCount, dev);
    (void)hipFuncSetAttribute((const void*)fwd_megakernel, hipFuncAttributeMaxDynamicSharedMemorySize, LDS_BYTES);
    (void)hipOccupancyMaxActiveBlocksPerMultiprocessor(&per_cu, (const void*)fwd_megakernel, 512, LDS_BYTES);
    if (per_cu != 1) per_cu = 1;
    grid_blocks = cus * per_cu;
    if (ws_size < WS_END) fprintf(stderr, "kernel_launch: workspace too small: %zu < %zu\n", ws_size, (size_t)WS_END);
  }
  Params p{};
  p.xp = (const float*)d_in[0]; p.xs = (const float*)d_in[1];
  p.a_re = (const float*)d_in[2]; p.a_im = (const float*)d_in[3]; p.log_step = (const float*)d_in[4];
  p.b_re = (const float*)d_in[5]; p.b_im = (const float*)d_in[6]; p.c_re = (const float*)d_in[7]; p.c_im = (const float*)d_in[8];
  p.s5_d = (const float*)d_in[9]; p.s5_wout = (const float*)d_in[10]; p.s5_wgate = (const float*)d_in[11];
  p.pool_w = (const float*)d_in[12]; p.pool_scale = (const float*)d_in[13];
  p.wqkv = (const float*)d_in[14]; p.qnorm = (const float*)d_in[15]; p.knorm = (const float*)d_in[16]; p.wo = (const float*)d_in[17];
  p.ln1g = (const float*)d_in[18]; p.ln1b = (const float*)d_in[19]; p.ln2g = (const float*)d_in[20]; p.ln2b = (const float*)d_in[21];
  p.w1 = (const float*)d_in[22]; p.w2 = (const float*)d_in[23];
  p.X = (float*)d_out; p.ws = (unsigned char*)d_ws;
  (void)hipMemsetAsync((char*)d_ws + WS_BAR, 0, XCD_BAR_WORDS * 4, stream);
  void* args[] = {&p};
  hipError_t e = hipLaunchCooperativeKernel((const void*)fwd_megakernel, dim3(grid_blocks), dim3(512), args, LDS_BYTES, stream);
  if (e != hipSuccess) fprintf(stderr, "cooperative launch failed: %s (grid %d)\n", hipGetErrorString(e), grid_blocks);
}
```

```cpp
#include <hip/hip_runtime.h>
#include <hip/hip_cooperative_groups.h>
#include <cstdio>
#include <cstdint>
namespace cg = cooperative_groups;
#ifndef WGM_DOWN
#define WGM_DOWN 4
#endif
#ifndef WGM_UP
#define WGM_UP 8
#endif
#ifndef WGM_OTHER
#define WGM_OTHER 4
#endif
#ifndef LAZY_SCHED
#define LAZY_SCHED 0
#endif
#ifndef EMIT_ON
#define EMIT_ON 0
#endif

#define LAS __attribute__((address_space(3)))
typedef unsigned short bf16_t;
typedef short bf16x8 __attribute__((ext_vector_type(8)));
typedef short s16x4 __attribute__((ext_vector_type(4)));
typedef float f32x2 __attribute__((ext_vector_type(2)));
typedef float f32x4 __attribute__((ext_vector_type(4)));
typedef float f32x16 __attribute__((ext_vector_type(16)));
typedef unsigned u32x2 __attribute__((ext_vector_type(2)));
typedef unsigned u32x4 __attribute__((ext_vector_type(4)));

constexpr int DM = 2048, NBATCH = 10, SEQ = 4096, MTOK = NBATCH * SEQ, DFF = 8192, QKVD = 3072;
constexpr float ALPHA = 1.681792830507429f;
constexpr float LN_EPS = 1e-5f, RMS_EPS = 1e-6f;
constexpr size_t MiB = 1024ull * 1024ull;
constexpr size_t WS_PW = 0;
constexpr size_t WS_ROPE = 8 * MiB;
constexpr size_t WS_BAR = 10 * MiB;
constexpr size_t WS_ACC = 11 * MiB;
constexpr size_t WS_CG = 12 * MiB;
constexpr size_t WS_ONE = 13 * MiB;
constexpr size_t WS_ST = 9 * MiB;
constexpr size_t WS_WB = 16 * MiB;
constexpr size_t WS_W1T = WS_WB, WS_W2T = WS_WB + 32 * MiB, WS_MIX = WS_WB + 64 * MiB;
constexpr size_t WS_XB = 144 * MiB;
constexpr size_t WS_R = 304 * MiB;
constexpr size_t WS_END = WS_R + 640 * MiB;
constexpr int LDS_BYTES = 129 * 1024;

struct Params {
  const float* xp; const float* xs;
  const float* a_re; const float* a_im; const float* log_step; const float* b_re; const float* b_im; const float* c_re; const float* c_im;
  const float* s5_d; const float* s5_wout; const float* s5_wgate; const float* pool_w; const float* pool_scale;
  const float* wqkv; const float* qnorm; const float* knorm; const float* wo;
  const float* ln1g; const float* ln1b; const float* ln2g; const float* ln2b; const float* w1; const float* w2;
  float* X; unsigned char* ws;
};

typedef __attribute__((address_space(4))) const Params* KargP;
struct Ctx { int wave0, bid, G;
  __device__ __forceinline__ int tid_() const { int l_; asm volatile("v_mbcnt_lo_u32_b32 %0, -1, 0\n\tv_mbcnt_hi_u32_b32 %0, -1, %0" : "=v"(l_)); return wave0 * 64 + l_; } };
__device__ __forceinline__ unsigned cvt_pk_bf16(float lo, float hi) { unsigned r; asm volatile("v_cvt_pk_bf16_f32 %0, %1, %2" : "=v"(r) : "v"(lo), "v"(hi)); return r; }
__device__ __forceinline__ float bf2f(bf16_t h) { return __uint_as_float(((unsigned)h) << 16); }
__device__ __forceinline__ float wave_sum(float v, int lane) {
#pragma unroll
  for (int o = 32; o >= 1; o >>= 1) v += __int_as_float(__builtin_amdgcn_ds_bpermute((lane ^ o) << 2, __float_as_int(v)));
  return v;
}
__device__ __forceinline__ float gelu_tanh(float x) {
  const float u = 0.7978845608028654f * (x + 0.044715f * x * x * x);
  return x * __builtin_amdgcn_rcpf(1.0f + __builtin_amdgcn_exp2f(-2.885390081777927f * u));
}
__device__ __forceinline__ float sigmoidf_(float x) { return __builtin_amdgcn_rcpf(1.0f + __builtin_amdgcn_exp2f(-1.4426950408889634f * x)); }

namespace pg8 {
constexpr int BM = 256, BK = 64, HALF = 128, HTB = HALF * BK * 2, STAGE_BYTES = 8 * HTB, NXCD = 8, WGM = 4;
__device__ __forceinline__ int lds_byte(int r, int c) { const int st = (r >> 4) * 2 + (c >> 5), rr = r & 15, cc = c & 31, ob = rr * 64 + cc * 2; return st * 1024 + (ob ^ (((ob >> 9) & 1) << 5)); }
__device__ __forceinline__ void stage_rc(int b, int& R, int& C) { const int st = b / 1024, sb = b % 1024, swz = sb ^ (((sb >> 9) & 1) << 5); R = (st >> 1) * 16 + swz / 64; C = (st & 1) * 32 + (swz % 64) / 2; }
__device__ __forceinline__ int perm32(int rho) { const int n = rho >> 4, i = rho & 15; return 8 * (i >> 2) + 4 * n + (i & 3); }

struct Unit { int pm, pn; };
struct GemmDesc {
  const char* A; const char* A2; const char* Bt;
  unsigned rowStrideA, ldbBytes, pnStrideA; int pnShift, chunked, ksplit, nt, nM, nN;
  int mode; void* out; int ldc;
  int wgm;
  int lnsel, flags, layer;
};
enum { F_LN_STATS = 1, F_LN_ACC = 2, F_EMIT = 4, F_XIN = 8, F_FOLD = 16, F_CSCALE = 32 };
struct StaticOrder {
  int nM, nN, nwg, G, c, wgm;
  __device__ void init(int nM_, int nN_, int G_, int c_, int wgm_) { nM = nM_; nN = nN_; nwg = nM * nN; G = G_; c = c_; wgm = wgm_; }
  __device__ bool next(int i, Unit& u) const {
    const long L = (long)i * G + c; if (L >= nwg) return false;
    int wgid = (int)L; { const int q = nwg / NXCD, r = nwg % NXCD, xcd = wgid % NXCD, off = wgid / NXCD; wgid = (xcd < r ? xcd * (q + 1) : r * (q + 1) + (xcd - r) * q) + off; }
    const int nig = wgm * nN, gid = wgid / nig, fm = gid * wgm, gsz = (nM - fm) < wgm ? (nM - fm) : wgm;
    u.pm = fm + ((wgid % nig) % gsz); u.pn = (wgid % nig) / gsz; return true;
  }
};

__device__ __forceinline__ f32x2 row_stats(const f32x2* stats, const float* accIn, int row) {
  if (accIn) { const f32x2 a = *(const f32x2*)(accIn + 2 * (size_t)row); const float mean = a.x * (1.0f / DM); return (f32x2){mean, rsqrtf(fmaxf(a.y * (1.0f / DM) - mean * mean, 0.f) + LN_EPS)}; }
  return stats ? stats[row] : (f32x2){0.f, 1.f};
}
__device__ __forceinline__ void row_emit(float* accOut, int row, float s, float q, int lane, int fq) {
  s += __int_as_float(__builtin_amdgcn_ds_bpermute((lane ^ 16) << 2, __float_as_int(s))); q += __int_as_float(__builtin_amdgcn_ds_bpermute((lane ^ 16) << 2, __float_as_int(q)));
  s += __int_as_float(__builtin_amdgcn_ds_bpermute((lane ^ 32) << 2, __float_as_int(s))); q += __int_as_float(__builtin_amdgcn_ds_bpermute((lane ^ 32) << 2, __float_as_int(q)));
  if (fq == 0) { __hip_atomic_fetch_add(accOut + 2 * (size_t)row, s, __ATOMIC_RELAXED, __HIP_MEMORY_SCOPE_AGENT); __hip_atomic_fetch_add(accOut + 2 * (size_t)row + 1, q, __ATOMIC_RELAXED, __HIP_MEMORY_SCOPE_AGENT); }
}
__device__ __forceinline__ void gemm_epilogue(const GemmDesc& g, const f32x4 (&acc)[2][2][4][2], const Unit& u, int wr, int wc, int fr, int fq, int lane) {
  const int row0 = u.pm * BM + wr * 64 + fr;
  KargP pp = (KargP)__builtin_amdgcn_kernarg_segment_ptr(); asm volatile("" : "+s"(pp));
  unsigned char* const ws_ = pp->ws;
  const float* e_lng = nullptr; const float* e_lnb = nullptr;
  if (g.lnsel == 1) { e_lng = pp->ln1g + g.layer * DM; e_lnb = pp->ln1b + g.layer * DM; } else if (g.lnsel == 2) { e_lng = pp->ln2g + (g.layer - 1) * DM; e_lnb = pp->ln2b + (g.layer - 1) * DM; }
  const f32x2* const e_stats = (g.flags & F_LN_STATS) ? (const f32x2*)(ws_ + WS_ST) : nullptr;
  const float* const e_accIn = (g.flags & F_LN_ACC) ? (const float*)(ws_ + WS_ACC) : nullptr;
  float* const e_accOut = (g.flags & F_EMIT) ? (float*)(ws_ + WS_ACC) : nullptr; bf16_t* const e_xbOut = (bf16_t*)(ws_ + WS_XB);
  const float* const e_cg = (g.flags & F_FOLD) ? (const float*)(ws_ + WS_CG) : nullptr; const float* const e_cb = (const float*)(ws_ + WS_CG) + DFF;
  const float* const e_cscale = (g.flags & F_CSCALE) ? pp->pool_scale : nullptr;
  const float* const e_xin0 = (g.flags & F_XIN) ? pp->xp : nullptr; const float* const e_xin1 = pp->xs;
  if (g.mode <= 2) {
    bf16_t* O = (bf16_t*)g.out; const int col0 = u.pn * BM + wc * 32 + 8 * fq;
    const bool fold = (g.mode == 1) && (e_cg != nullptr);
    f32x4 fg[2][2], fb[2][2]; f32x2 fst[8];
    if (fold) {
#pragma unroll
      for (int bj = 0; bj < 2; ++bj)
#pragma unroll
        for (int n = 0; n < 2; ++n) { fg[bj][n] = *(const f32x4*)(e_cg + col0 + bj * HALF + 4 * n); fb[bj][n] = *(const f32x4*)(e_cb + col0 + bj * HALF + 4 * n); }
#pragma unroll
      for (int gi = 0; gi < 8; ++gi) fst[gi] = *(const f32x2*)(e_accIn + 2 * (size_t)(row0 + (gi >> 2) * HALF + (gi & 3) * 16));
#pragma unroll
      for (int gi = 0; gi < 8; ++gi) { const float mean = fst[gi].x * (1.0f / DM); fst[gi] = (f32x2){mean, rsqrtf(fmaxf(fst[gi].y * (1.0f / DM) - mean * mean, 0.f) + LN_EPS)}; }
    }
#pragma unroll
    for (int ai = 0; ai < 2; ++ai)
#pragma unroll
      for (int m = 0; m < 4; ++m) { bf16_t* rowp = O + (size_t)(row0 + ai * HALF + m * 16) * g.ldc + col0;
#pragma unroll
        for (int bj = 0; bj < 2; ++bj) { f32x4 v0 = acc[ai][bj][m][0], v1 = acc[ai][bj][m][1];
          if (g.mode == 1) {
            if (fold) { const f32x2 st = fst[ai * 4 + m]; v0 = (v0 - fg[bj][0] * st.x) * st.y + fb[bj][0]; v1 = (v1 - fg[bj][1] * st.x) * st.y + fb[bj][1]; }
#pragma unroll
            for (int j = 0; j < 4; ++j) { const float a = fmaxf(v0[j], 0.f), b = fmaxf(v1[j], 0.f); v0[j] = a * a; v1[j] = b * b; } }
          if (g.mode == 2) {
#pragma unroll
            for (int j = 0; j < 4; ++j) { v0[j] = gelu_tanh(v0[j]); v1[j] = gelu_tanh(v1[j]); } }
          u32x4 w; w.x = cvt_pk_bf16(v0[0], v0[1]); w.y = cvt_pk_bf16(v0[2], v0[3]); w.z = cvt_pk_bf16(v1[0], v1[1]); w.w = cvt_pk_bf16(v1[2], v1[3]);
          *(u32x4*)(rowp + bj * HALF) = w; } }
  } else if (g.mode == 3 || g.mode == 4) {
    float* X = (float*)g.out; const int col0 = u.pn * BM + wc * 32 + 4 * fq; const bool ln = e_stats != nullptr || e_accIn != nullptr;
    f32x4 cs[2][2], lg[2][2], lb[2][2];
#pragma unroll
    for (int bj = 0; bj < 2; ++bj)
#pragma unroll
      for (int n = 0; n < 2; ++n) { cs[bj][n] = (g.mode == 4) ? *(const f32x4*)(e_cscale + col0 + bj * HALF + n * 16) : (f32x4){1.f, 1.f, 1.f, 1.f};
        lg[bj][n] = ln ? *(const f32x4*)(e_lng + col0 + bj * HALF + n * 16) : (f32x4){1.f, 1.f, 1.f, 1.f}; lb[bj][n] = ln ? *(const f32x4*)(e_lnb + col0 + bj * HALF + n * 16) : (f32x4){0.f, 0.f, 0.f, 0.f}; }
    f32x2 st[2]; f32x4 xv[2][4];
    const f32x2* const e_sp = e_accIn ? (const f32x2*)e_accIn : (e_stats ? e_stats : (const f32x2*)(ws_ + WS_ONE));
#define RES_LOAD(GI, BUF) do { const int r_ = row0 + ((GI) >> 2) * HALF + ((GI) & 3) * 16; const float* rp_ = X + (size_t)r_ * DM + col0; \
      st[BUF] = e_sp[r_]; \
      _Pragma("unroll") for (int q_ = 0; q_ < 4; ++q_) xv[BUF][q_] = *(const f32x4*)(rp_ + (q_ >> 1) * HALF + (q_ & 1) * 16); } while (0)
    RES_LOAD(0, 0);
#pragma unroll
    for (int gi = 0; gi < 8; ++gi) { const int ai = gi >> 2, m = gi & 3; const int row = row0 + ai * HALF + m * 16; float* rowp = X + (size_t)row * DM + col0;
      if (gi + 1 < 8) RES_LOAD(gi + 1, (gi + 1) & 1);
      float ssum = 0.f, ssq = 0.f; f32x2 sm = st[gi & 1];
      if (e_accIn) { const float mean = sm.x * (1.0f / DM); sm = (f32x2){mean, rsqrtf(fmaxf(sm.y * (1.0f / DM) - mean * mean, 0.f) + LN_EPS)}; }
#pragma unroll
      for (int bj = 0; bj < 2; ++bj)
#pragma unroll
        for (int n = 0; n < 2; ++n) { f32x4* p = (f32x4*)(rowp + bj * HALF + n * 16); const f32x4 x = ((xv[gi & 1][bj * 2 + n] - sm.x) * sm.y) * lg[bj][n] + lb[bj][n]; const f32x4 o = x * ALPHA + acc[ai][bj][m][n] * cs[bj][n]; *p = o;
          if (e_accOut) { ssum += (o[0] + o[1]) + (o[2] + o[3]); ssq += (o[0] * o[0] + o[1] * o[1]) + (o[2] * o[2] + o[3] * o[3]);
            u32x2 w; w.x = cvt_pk_bf16(o[0], o[1]); w.y = cvt_pk_bf16(o[2], o[3]); *(u32x2*)(e_xbOut + (size_t)row * DM + col0 + bj * HALF + n * 16) = w; } }
      if (e_accOut) row_emit(e_accOut, row, ssum, ssq, lane, fq); }
#undef RES_LOAD
  } else if (g.mode == 5) {
    float* X = (float*)g.out; const int col0 = u.pn * HALF + wc * 32 + 4 * fq; const bool ln = e_stats != nullptr;
    f32x4 lg[2], lb[2];
#pragma unroll
    for (int n = 0; n < 2; ++n) { lg[n] = ln ? *(const f32x4*)(e_lng + col0 + n * 16) : (f32x4){1.f, 1.f, 1.f, 1.f}; lb[n] = ln ? *(const f32x4*)(e_lnb + col0 + n * 16) : (f32x4){0.f, 0.f, 0.f, 0.f}; }
    f32x2 st[2][2]; f32x4 xv[2][4];
    const f32x2* const e_sp = e_stats ? e_stats : (const f32x2*)(ws_ + WS_ONE);
#define GLU_SRC(ROW) (e_xin0 ? (((ROW) < 2 * SEQ) ? e_xin0 + (size_t)(ROW) * DM + col0 : e_xin1 + (size_t)((ROW) - 2 * SEQ) * DM + col0) : X + (size_t)(ROW) * DM + col0)
#define GLU_LOAD(PI, BUF) do { _Pragma("unroll") for (int h_ = 0; h_ < 2; ++h_) { const int g_ = 2 * (PI) + h_; const int r_ = row0 + (g_ >> 2) * HALF + (g_ & 3) * 16; const float* sp_ = GLU_SRC(r_); \
      st[BUF][h_] = e_sp[r_]; xv[BUF][2 * h_] = *(const f32x4*)(sp_); xv[BUF][2 * h_ + 1] = *(const f32x4*)(sp_ + 16); } } while (0)
    GLU_LOAD(0, 0);
#pragma unroll
    for (int pi = 0; pi < 4; ++pi) {
      if (pi + 1 < 4) GLU_LOAD(pi + 1, (pi + 1) & 1);
#pragma unroll
      for (int h2 = 0; h2 < 2; ++h2) { const int gi = 2 * pi + h2, ai = gi >> 2, m = gi & 3; const int row = row0 + ai * HALF + m * 16; float* rowp = X + (size_t)row * DM + col0; float ssum = 0.f, ssq = 0.f;
#pragma unroll
        for (int n = 0; n < 2; ++n) { f32x4* p = (f32x4*)(rowp + n * 16); const f32x4 x = ((xv[pi & 1][2 * h2 + n] - st[pi & 1][h2].x) * st[pi & 1][h2].y) * lg[n] + lb[n]; const f32x4 o = acc[ai][0][m][n], gt = acc[ai][1][m][n]; f32x4 h;
#pragma unroll
          for (int j = 0; j < 4; ++j) h[j] = o[j] * sigmoidf_(gt[j]);
          const f32x4 z = x * ALPHA + h; *p = z;
          if (e_accOut) { ssum += (z[0] + z[1]) + (z[2] + z[3]); ssq += (z[0] * z[0] + z[1] * z[1]) + (z[2] * z[2] + z[3] * z[3]);
            u32x2 w; w.x = cvt_pk_bf16(z[0], z[1]); w.y = cvt_pk_bf16(z[2], z[3]); *(u32x2*)(e_xbOut + (size_t)row * DM + col0 + n * 16) = w; } }
        if (e_accOut) row_emit(e_accOut, row, ssum, ssq, lane, fq); } }
#undef GLU_LOAD
#undef GLU_SRC
  } else if (g.mode == 7) {
    if (acc[0][0][0][0][0] == 1.2345e30f) *(f32x4*)g.out = acc[1][1][3][1];
  } else {
    float* C = (float*)g.out; const int col0 = u.pn * BM + wc * 32 + 4 * fq;
#pragma unroll
    for (int ai = 0; ai < 2; ++ai)
#pragma unroll
      for (int m = 0; m < 4; ++m) { float* rowp = C + (size_t)(row0 + ai * HALF + m * 16) * g.ldc + col0;
#pragma unroll
        for (int bj = 0; bj < 2; ++bj)
#pragma unroll
          for (int n = 0; n < 2; ++n) *(f32x4*)(rowp + bj * HALF + n * 16) = acc[ai][bj][m][n]; }
  }
}

__device__ __forceinline__ const char* ktile_ptr(const char* b1, const char* b2, int kt, int ksplit, size_t kstep) { return kt < ksplit ? b1 + (size_t)kt * kstep : b2 + (size_t)(kt - ksplit) * kstep; }

__device__ __forceinline__ void gemm_phase(const Ctx& cx, LAS unsigned char* lds, const GemmDesc& g) {
  const int tid = cx.tid_(), wid = __builtin_amdgcn_readfirstlane(tid >> 6), lane = tid & 63, wr = wid >> 2, wc = wid & 3, fr = lane & 15, fq = lane >> 4;
  const int nt = g.nt, ksplit = g.ksplit; const bool perm = g.mode <= 2;
  unsigned voffA[2], voffB[2];
#pragma unroll
  for (int i = 0; i < 2; ++i) { int R, C; stage_rc(tid * 16 + i * 8192, R, C); const int Rb = perm ? ((R & ~31) + perm32(R & 31)) : R;
    voffA[i] = g.chunked ? (unsigned)((R >> 4) * 65536 + (R & 15) * 32 + (C >> 4) * 512 + (C & 15) * 2) : ((unsigned)R * g.rowStrideA + (unsigned)(C * 2)); voffB[i] = (unsigned)Rb * g.ldbBytes + (unsigned)(C * 2); }
  const size_t kstepA = g.chunked ? 2048 : 128, kstepB = 128;
  const size_t hstepA = (size_t)HALF * g.rowStrideA, hstepB = (size_t)HALF * g.ldbBytes, tstepA = 2 * hstepA, tstepB = 2 * hstepB;
  const unsigned ldsw = (unsigned)wid * 1024u;
  const int aoff = lds_byte(wr * 64 + fr, fq * 8), boff = lds_byte(wc * 32 + fr, fq * 8);
#define PG8_SA(b, h) (((b) * 2 + (h)) * HTB)
#define PG8_SB(b, h) ((4 + (b) * 2 + (h)) * HTB)
#define PG8_STAGE(bufoff, gbase, voff) do { _Pragma("unroll") for (int _i = 0; _i < 2; ++_i) \
    __builtin_amdgcn_global_load_lds((const unsigned*)((const char*)(gbase) + (voff)[_i]), (LAS unsigned*)(lds + (bufoff) + ldsw + _i * 8192), 16, 0, 0); } while (0)
#define PG8_LDA(dst, b, h) do { _Pragma("unroll") for (int m = 0; m < 4; ++m) _Pragma("unroll") for (int k = 0; k < 2; ++k) dst[m][k] = *(const LAS bf16x8*)(lds + PG8_SA(b, h) + aoff + m * 2048 + k * 1024); } while (0)
#define PG8_LDB(dst, b, h) do { _Pragma("unroll") for (int n = 0; n < 2; ++n) _Pragma("unroll") for (int k = 0; k < 2; ++k) dst[n][k] = *(const LAS bf16x8*)(lds + PG8_SB(b, h) + boff + n * 2048 + k * 1024); } while (0)
#define PG8_MMA(ai, bj, At, Bt) do { __builtin_amdgcn_s_setprio(1); _Pragma("unroll") for (int m = 0; m < 4; ++m) _Pragma("unroll") for (int n = 0; n < 2; ++n) _Pragma("unroll") for (int k = 0; k < 2; ++k) \
    acc[ai][bj][m][n] = __builtin_amdgcn_mfma_f32_16x16x32_bf16(Bt[n][k], At[m][k], acc[ai][bj][m][n], 0, 0, 0); __builtin_amdgcn_s_setprio(0); } while (0)
#define PG8_WAIT_V(n) asm volatile("s_waitcnt vmcnt(" #n ")" ::: "memory")
#define PG8_WAIT_L(n) asm volatile("s_waitcnt lgkmcnt(" #n ")" ::: "memory")
#define PG8_BAR __builtin_amdgcn_s_barrier()
#define PG8_SCHED __builtin_amdgcn_sched_barrier(0)
  StaticOrder S; S.init(g.nM, g.nN, (int)cx.G, (int)cx.bid, g.wgm);
  Unit cur, nxt; int ui = 0;
  if (!S.next(0, cur)) return;
  f32x4 acc[2][2][4][2];
#pragma unroll
  for (int a = 0; a < 2; ++a)
#pragma unroll
    for (int b = 0; b < 2; ++b)
#pragma unroll
      for (int m = 0; m < 4; ++m)
#pragma unroll
        for (int n = 0; n < 2; ++n) acc[a][b][m][n] = (f32x4){0.f, 0.f, 0.f, 0.f};
  bf16x8 At[4][2], B0[2][2], B1[2][2];
  size_t aoffu = (size_t)cur.pm * tstepA + (size_t)(cur.pn >> g.pnShift) * g.pnStrideA;
  const char* cA1 = g.A + aoffu; const char* cA2 = g.A2 + aoffu; const char* cB = g.Bt + (size_t)cur.pn * tstepB;
  {
    const char* a0 = ktile_ptr(cA1, cA2, 0, ksplit, kstepA); const char* a1 = ktile_ptr(cA1, cA2, 1, ksplit, kstepA);
    PG8_STAGE(PG8_SB(0, 0), cB, voffB); PG8_STAGE(PG8_SB(0, 1), cB + hstepB, voffB); PG8_STAGE(PG8_SA(0, 0), a0, voffA); PG8_STAGE(PG8_SA(0, 1), a0 + hstepA, voffA);
    if (wr == 1) PG8_BAR;
    PG8_WAIT_V(2); PG8_BAR;
    PG8_STAGE(PG8_SB(1, 0), cB + kstepB, voffB); PG8_STAGE(PG8_SA(1, 0), a1, voffA); PG8_STAGE(PG8_SB(1, 1), cB + hstepB + kstepB, voffB);
    PG8_WAIT_V(6); PG8_BAR;
  }
  for (;;) {
    const bool has_next = S.next(ui + 1, nxt);
    const size_t naoff = has_next ? (size_t)nxt.pm * tstepA + (size_t)(nxt.pn >> g.pnShift) * g.pnStrideA : aoffu;
    const char* nA1 = g.A + naoff; const char* nA2 = g.A2 + naoff; const char* nB = has_next ? g.Bt + (size_t)nxt.pn * tstepB : cB;
    for (int t = 0; t < nt; t += 2) {
      const bool last = (t == nt - 2);
      const char* a1 = ktile_ptr(cA1, cA2, t + 1, ksplit, kstepA);
      const char* a2 = last ? ktile_ptr(nA1, nA2, 0, ksplit, kstepA) : ktile_ptr(cA1, cA2, t + 2, ksplit, kstepA);
      const char* a3 = last ? ktile_ptr(nA1, nA2, 1, ksplit, kstepA) : ktile_ptr(cA1, cA2, t + 3, ksplit, kstepA);
      const char* b2 = last ? nB : cB + (size_t)(t + 2) * kstepB; const char* b3 = b2 + kstepB;
      PG8_LDB(B0, 0, 0); PG8_LDB(B1, 0, 1); PG8_SCHED; PG8_LDA(At, 0, 0); PG8_STAGE(PG8_SA(1, 1), a1 + hstepA, voffA);
      PG8_WAIT_V(8); PG8_WAIT_L(0); PG8_BAR; PG8_MMA(0, 0, At, B0); PG8_MMA(0, 1, At, B1); PG8_BAR; PG8_SCHED;
      PG8_LDA(At, 0, 1); PG8_STAGE(PG8_SB(0, 0), b2, voffB); PG8_STAGE(PG8_SB(0, 1), b2 + hstepB, voffB); PG8_STAGE(PG8_SA(0, 0), a2, voffA);
      PG8_WAIT_V(8); PG8_WAIT_L(0); PG8_BAR; PG8_MMA(1, 0, At, B0); PG8_MMA(1, 1, At, B1); PG8_BAR; PG8_SCHED;
      PG8_LDB(B0, 1, 0); PG8_LDB(B1, 1, 1); PG8_SCHED; PG8_LDA(At, 1, 0); PG8_STAGE(PG8_SA(0, 1), a2 + hstepA, voffA);
      PG8_WAIT_V(8); PG8_WAIT_L(0); PG8_BAR; PG8_MMA(0, 0, At, B0); PG8_MMA(0, 1, At, B1); PG8_BAR; PG8_SCHED;
      PG8_LDA(At, 1, 1); PG8_STAGE(PG8_SB(1, 0), b3, voffB); PG8_STAGE(PG8_SB(1, 1), b3 + hstepB, voffB); PG8_STAGE(PG8_SA(1, 0), a3, voffA);
      PG8_WAIT_V(8); PG8_WAIT_L(0); PG8_BAR; PG8_MMA(1, 0, At, B0); PG8_MMA(1, 1, At, B1); PG8_BAR; PG8_SCHED;
    }
    if (wr == 0) PG8_BAR;
    gemm_epilogue(g, acc, cur, wr, wc, fr, fq, lane);
    if (!has_next) break;
#pragma unroll
    for (int a = 0; a < 2; ++a)
#pragma unroll
      for (int b = 0; b < 2; ++b)
#pragma unroll
        for (int m = 0; m < 4; ++m)
#pragma unroll
          for (int n = 0; n < 2; ++n) acc[a][b][m][n] = (f32x4){0.f, 0.f, 0.f, 0.f};
    cur = nxt; cA1 = nA1; cA2 = nA2; cB = nB; aoffu = naoff; ++ui;
    if (wr == 1) PG8_BAR;
  }
  PG8_WAIT_V(0);
  PG8_BAR;
#undef PG8_SA
#undef PG8_SB
#undef PG8_STAGE
#undef PG8_LDA
#undef PG8_LDB
#undef PG8_MMA
#undef PG8_WAIT_V
#undef PG8_WAIT_L
#undef PG8_BAR
#undef PG8_SCHED
}
}

namespace att {
constexpr int D = 128, NW = 8, QBLK = 32, KVBLK = 64;
constexpr float SCALE = 0.088388347648318440f, THR = 8.f;
constexpr int LDQ = QKVD, LDK = QKVD, LDO = DM;
constexpr size_t SHM_V = KVBLK * D * 2, SHM_K = KVBLK * D * 2, SHM_ATTN = 2 * SHM_V + 2 * SHM_K + NW * 64 * 4;
#define KSWZ(row, colB) ((row) * 256 + ((colB) ^ (((row) & 7) << 4)))
#define SBAR() __builtin_amdgcn_sched_barrier(0)
__device__ __forceinline__ int crow(int r, int hi) { return (r & 3) + 8 * (r >> 2) + 4 * hi; }
__device__ __forceinline__ bf16x8 ld8(const bf16_t* p) { return *reinterpret_cast<const bf16x8*>(p); }
__device__ __forceinline__ void partialSM(f32x16& p0, f32x16& p1, float& m_reg, float& mn, float& alpha) {
  constexpr float C = SCALE * 1.4426950408889634f;
  float pmax = p0[0];
#pragma unroll
  for (int r = 1; r < 16; ++r) pmax = fmaxf(pmax, p0[r]);
#pragma unroll
  for (int r = 0; r < 16; ++r) pmax = fmaxf(pmax, p1[r]);
  { auto rr = __builtin_amdgcn_permlane32_swap(__float_as_uint(pmax), __float_as_uint(pmax), false, false);
    pmax = fmaxf(__uint_as_float(rr[0]), __uint_as_float(rr[1])); }
  if (__builtin_expect(__all(pmax - m_reg <= THR / SCALE), 1)) { mn = m_reg; alpha = 1.f; }
  else { mn = fmaxf(m_reg, pmax); alpha = __builtin_amdgcn_exp2f((m_reg - mn) * C); m_reg = mn; }
  float mnC = -mn * C;
#pragma unroll
  for (int r = 0; r < 16; ++r) p0[r] = fmaf(p0[r], C, mnC);
#pragma unroll
  for (int r = 0; r < 16; ++r) p1[r] = fmaf(p1[r], C, mnC);
#pragma unroll
  for (int r = 0; r < 16; ++r) p0[r] = __builtin_amdgcn_exp2f(p0[r]);
}
__device__ __forceinline__ void finishSM(f32x16& p0, f32x16& p1, float alpha, float& l_reg, bf16x8& pa0, bf16x8& pa1, bf16x8& pa2, bf16x8& pa3) {
#pragma unroll
  for (int r = 0; r < 16; ++r) p1[r] = __builtin_amdgcn_exp2f(p1[r]);
  float ps = 0;
#pragma unroll
  for (int r = 0; r < 16; ++r) ps += p0[r];
#pragma unroll
  for (int r = 0; r < 16; ++r) ps += p1[r];
  { auto rr = __builtin_amdgcn_permlane32_swap(__float_as_uint(ps), __float_as_uint(ps), false, false);
    ps = __uint_as_float(rr[0]) + __uint_as_float(rr[1]); }
  l_reg = l_reg * alpha + ps;
#define PK4(P, BASE, OUT) do { unsigned a0 = cvt_pk_bf16(P[BASE + 0], P[BASE + 1]), a1 = cvt_pk_bf16(P[BASE + 2], P[BASE + 3]);   \
    unsigned b0 = cvt_pk_bf16(P[BASE + 4], P[BASE + 5]), b1 = cvt_pk_bf16(P[BASE + 6], P[BASE + 7]);                              \
    auto r0 = __builtin_amdgcn_permlane32_swap(a0, b0, false, false); auto r1 = __builtin_amdgcn_permlane32_swap(a1, b1, false, false); \
    u32x4 w = {r0[0], r1[0], r0[1], r1[1]}; OUT = *reinterpret_cast<bf16x8*>(&w); } while (0)
  PK4(p0, 0, pa0); PK4(p0, 8, pa1); PK4(p1, 0, pa2); PK4(p1, 8, pa3);
#undef PK4
}
__device__ __forceinline__ void qkt(f32x16& p0, f32x16& p1, const bf16_t* Ks, const bf16x8* qr, int r32, int hi) {
  p0 = f32x16{}; p1 = f32x16{};
#pragma unroll
  for (int d0 = 0; d0 < 8; ++d0) { int cb = (d0 * 16 + hi * 8) * 2;
    bf16x8 b0 = *reinterpret_cast<const bf16x8*>((const char*)Ks + KSWZ(r32, cb));
    bf16x8 b1 = *reinterpret_cast<const bf16x8*>((const char*)Ks + KSWZ(32 + r32, cb));
    p0 = __builtin_amdgcn_mfma_f32_32x32x16_bf16(b0, qr[d0], p0, 0, 0, 0);
    p1 = __builtin_amdgcn_mfma_f32_32x32x16_bf16(b1, qr[d0], p1, 0, 0, 0); }
}
__device__ __forceinline__ int v_st(int k, int c) { const int kk = (k & ~0xC) | ((k & 4) << 1) | ((k & 8) >> 1); return ((kk >> 3) * 4 + (c >> 5)) * 512 + ((kk & 7) * 32 + (c & 31)) * 2; }
__device__ __forceinline__ int v_rd_base(int lane) { return ((lane & 3) << 3) | (((lane >> 2) & 3) << 6) | (((lane >> 4) & 1) << 5) | (((lane >> 5) & 1) << 8); }
constexpr int v_rd_off(int d0, int ks, int half) { return d0 * 512 + ks * 4096 + half * 2048; }
template <int OFF> __device__ __forceinline__ s16x4 tr_read(int vb) {
  s16x4 r; asm volatile("ds_read_b64_tr_b16 %0, %1 offset:%2" : "=&v"(r) : "v"(vb), "i"(OFF) : "memory"); return r;
}
template <int D0> __device__ __forceinline__ void pv_one(f32x16& od, int vb, bf16x8 pa0, bf16x8 pa1, bf16x8 pa2, bf16x8 pa3) {
  const s16x4 l0 = tr_read<v_rd_off(D0, 0, 0)>(vb), h0 = tr_read<v_rd_off(D0, 0, 1)>(vb), l1 = tr_read<v_rd_off(D0, 1, 0)>(vb), h1 = tr_read<v_rd_off(D0, 1, 1)>(vb);
  const s16x4 l2 = tr_read<v_rd_off(D0, 2, 0)>(vb), h2 = tr_read<v_rd_off(D0, 2, 1)>(vb), l3 = tr_read<v_rd_off(D0, 3, 0)>(vb), h3 = tr_read<v_rd_off(D0, 3, 1)>(vb);
  asm volatile("s_waitcnt lgkmcnt(0)" ::: "memory"); SBAR();
#define PK(L, H) (bf16x8){L[0], L[1], L[2], L[3], H[0], H[1], H[2], H[3]}
  od = __builtin_amdgcn_mfma_f32_32x32x16_bf16(pa0, PK(l0, h0), od, 0, 0, 0);
  od = __builtin_amdgcn_mfma_f32_32x32x16_bf16(pa1, PK(l1, h1), od, 0, 0, 0);
  od = __builtin_amdgcn_mfma_f32_32x32x16_bf16(pa2, PK(l2, h2), od, 0, 0, 0);
  od = __builtin_amdgcn_mfma_f32_32x32x16_bf16(pa3, PK(l3, h3), od, 0, 0, 0);
#undef PK
}
__device__ __forceinline__ void pv_d0(f32x16* o, int vb, bf16x8 pa0, bf16x8 pa1, bf16x8 pa2, bf16x8 pa3) {
  pv_one<0>(o[0], vb, pa0, pa1, pa2, pa3); pv_one<1>(o[1], vb, pa0, pa1, pa2, pa3); pv_one<2>(o[2], vb, pa0, pa1, pa2, pa3); pv_one<3>(o[3], vb, pa0, pa1, pa2, pa3);
}
__device__ __forceinline__ void attn_dense_body(const bf16_t* __restrict__ Qb, const bf16_t* __restrict__ Kh, const bf16_t* __restrict__ Vh,
                                                bf16_t* __restrict__ Ob, int seq, char* lds, const Ctx& cx) {
  const int tid = cx.tid_(), wid = tid >> 6, lane = tid & 63, r32 = lane & 31, hi = lane >> 5;
  bf16_t* V_lds = (bf16_t*)lds; bf16_t* K_lds = (bf16_t*)(lds + 2 * SHM_V);
  float* ws = (float*)(lds + 2 * SHM_V + 2 * SHM_K) + wid * 64; float* li_l = ws; float* al_l = ws + 32;
  float m_reg = -1e30f, l_reg = 0; f32x16 o[4] = {}; bf16x8 qr[8];
  const bf16_t* Qw = Qb + (long)(wid * QBLK + r32) * LDQ + hi * 8;
#pragma unroll
  for (int d0 = 0; d0 < 8; ++d0) qr[d0] = ld8(Qw + d0 * 16);
  const int sr = tid >> 4, sc = (tid & 15) * 8, vst0 = v_st(sr, sc), vst1 = v_st(32 + sr, sc);
  const int vb0 = (int)(uintptr_t)V_lds + v_rd_base(lane);
  struct { bf16x8 vs0, vs1, ks0, ks1; } sr_[2];
#define SLOAD(i, k0) do { sr_[i].vs0 = ld8(&Vh[(long)((k0) + sr) * LDK + sc]); sr_[i].vs1 = ld8(&Vh[(long)((k0) + 32 + sr) * LDK + sc]); \
    sr_[i].ks0 = ld8(&Kh[(long)((k0) + sr) * LDK + sc]); sr_[i].ks1 = ld8(&Kh[(long)((k0) + 32 + sr) * LDK + sc]); } while (0)
#define SWRITE(b, i) do { *(bf16x8*)((char*)V_lds + (b) * SHM_V + vst0) = sr_[i].vs0;          \
    *(bf16x8*)((char*)V_lds + (b) * SHM_V + vst1) = sr_[i].vs1; int kc = sc * 2;               \
    *(bf16x8*)((char*)K_lds + (b) * SHM_K + KSWZ(sr, kc)) = sr_[i].ks0;                       \
    *(bf16x8*)((char*)K_lds + (b) * SHM_K + KSWZ(32 + sr, kc)) = sr_[i].ks1; } while (0)
#define SWAIT() asm volatile("s_waitcnt vmcnt(4)" ::: "memory")
#define RESC(a) do { if (__any((a) < 1.f)) { if (hi == 0) al_l[r32] = (a); asm volatile("s_waitcnt lgkmcnt(0)" ::: "memory"); \
    _Pragma("unroll") for (int d = 0; d < 4; ++d) _Pragma("unroll") for (int r = 0; r < 16; ++r) o[d][r] *= al_l[crow(r, hi)]; } } while (0)
  f32x16 pA0, pA1, pB0, pB1; float mnA, mnB, alA, alB; bf16x8 pa0, pa1, pa2, pa3; const int NT = seq / KVBLK;
  constexpr int SE = 0, SO = 1;
  SLOAD(SE, 0); asm volatile("s_waitcnt vmcnt(0)" ::: "memory"); SWRITE(0, SE); __syncthreads();
  qkt(pA0, pA1, K_lds, qr, r32, hi); partialSM(pA0, pA1, m_reg, mnA, alA);
  SLOAD(SO, KVBLK); if (2 < NT) SLOAD(SE, 2 * KVBLK);
  SWAIT(); SWRITE(1, SO); __syncthreads();
  for (int j = 1; j + 1 < NT; j += 2) {
    SBAR(); qkt(pB0, pB1, (bf16_t*)((char*)K_lds + SHM_K), qr, r32, hi);
    finishSM(pA0, pA1, alA, l_reg, pa0, pa1, pa2, pa3); SBAR();
    SLOAD(SO, (j + 2) * KVBLK); SBAR();
    pv_d0(o, vb0, pa0, pa1, pa2, pa3); partialSM(pB0, pB1, m_reg, mnB, alB);
    __syncthreads(); SWAIT(); SWRITE(0, SE);
    RESC(alB); __syncthreads();
    SBAR(); qkt(pA0, pA1, K_lds, qr, r32, hi);
    finishSM(pB0, pB1, alB, l_reg, pa0, pa1, pa2, pa3); SBAR();
    SLOAD(SE, min(j + 3, NT - 1) * KVBLK); SBAR();
    pv_d0(o, vb0 + (int)SHM_V, pa0, pa1, pa2, pa3); partialSM(pA0, pA1, m_reg, mnA, alA);
    __syncthreads(); SWAIT(); SWRITE(1, SO);
    RESC(alA); __syncthreads();
  }
  SBAR(); qkt(pB0, pB1, (bf16_t*)((char*)K_lds + SHM_K), qr, r32, hi);
  finishSM(pA0, pA1, alA, l_reg, pa0, pa1, pa2, pa3); SBAR();
  pv_d0(o, vb0, pa0, pa1, pa2, pa3); partialSM(pB0, pB1, m_reg, mnB, alB);
  __syncthreads(); RESC(alB);
  finishSM(pB0, pB1, alB, l_reg, pa0, pa1, pa2, pa3); SBAR();
  pv_d0(o, vb0 + (int)SHM_V, pa0, pa1, pa2, pa3);
  if (hi == 0) li_l[r32] = l_reg; asm volatile("s_waitcnt lgkmcnt(0)" ::: "memory");
  float rli[16];
#pragma unroll
  for (int r = 0; r < 16; ++r) rli[r] = __builtin_amdgcn_rcpf(li_l[crow(r, hi)]);
  bf16_t* Ow = Ob + (long)(wid * QBLK) * LDO;
  const int odd = lane & 1;
#pragma unroll
  for (int rp = 0; rp < 8; ++rp) { const int r = 2 * rp; const long orow = crow(r, hi) + odd;
#pragma unroll
    for (int d0 = 0; d0 < 4; ++d0) { const float a = o[d0][r] * rli[r], b = o[d0][r + 1] * rli[r + 1];
      const float send = odd ? a : b;
      const float recv = __int_as_float(__builtin_amdgcn_update_dpp(0, __float_as_int(send), 0xB1, 0xF, 0xF, false));
      const float lo = odd ? recv : a, hi2 = odd ? b : recv;
      *(unsigned*)(Ow + orow * LDO + d0 * 32 + (r32 & ~1)) = cvt_pk_bf16(lo, hi2); } }
#undef SLOAD
#undef SWRITE
#undef SWAIT
#undef RESC
}
}

__device__ __forceinline__ void phase_pre(const Ctx& cx, const Params& p) {
  const size_t gt = (size_t)cx.bid * 512 + cx.tid_(), nth = (size_t)cx.G * 512;
  const size_t n1 = (size_t)2 * SEQ * DM / 4, ntot = (size_t)MTOK * DM / 4;
  f32x4* X4 = (f32x4*)p.X; u32x2* XB2 = (u32x2*)(p.ws + WS_XB);
  for (size_t i = gt; i < ntot; i += 4 * nth) {
    f32x4 v[4];
#pragma unroll
    for (int e = 0; e < 4; ++e) { const size_t ii = i + e * nth; v[e] = (ii < ntot) ? ((ii < n1) ? ((const f32x4*)p.xp)[ii] : ((const f32x4*)p.xs)[ii - n1]) : (f32x4){0.f, 0.f, 0.f, 0.f}; }
#pragma unroll
    for (int e = 0; e < 4; ++e) { const size_t ii = i + e * nth; if (ii < ntot) { u32x2 w; w.x = cvt_pk_bf16(v[e][0], v[e][1]); w.y = cvt_pk_bf16(v[e][2], v[e][3]);
        const size_t tok = ii >> 9; const unsigned ch = (unsigned)(ii & 511) * 4u; XB2[((tok >> 4) * 32768 + (ch >> 4) * 256 + (tok & 15) * 16 + (ch & 15)) >> 2] = w; } }
  }
  for (size_t i = gt; i < (size_t)MTOK * 2 + 2 * DFF; i += nth) { if (i < (size_t)MTOK * 2) ((float*)(p.ws + WS_ACC))[i] = 0.f; else ((float*)(p.ws + WS_CG))[i - (size_t)MTOK * 2] = 0.f; }
  { float z0, o1; asm volatile("v_mov_b32 %0, 0" : "=v"(z0)); asm volatile("v_mov_b32 %0, 1.0" : "=v"(o1)); for (size_t i = gt; i < (size_t)MTOK; i += nth) ((f32x2*)(p.ws + WS_ONE))[i] = (f32x2){z0, o1}; }
  if (gt < 32768) {
    const int idx = (int)gt;
    const float lr = fminf(p.a_re[idx], -1e-4f), li = p.a_im[idx], dt = expf(p.log_step[idx >> 6]);
    const float er = expf(lr * dt), ang = li * dt; const float lbr = er * cosf(ang), lbi = er * sinf(ang);
    const float nr = lbr - 1.f, ni = lbi, den = lr * lr + li * li; const float cr = (nr * lr + ni * li) / den, ci = (ni * lr - nr * li) / den;
    f32x2* T = (f32x2*)(p.ws + WS_PW) + (size_t)idx * 32;
    float pr = 1.f, pi = 0.f;
#pragma unroll
    for (int d = 0; d <= 16; ++d) {
      if (d >= 1) T[15 + d] = (f32x2){pr, pi};
      if (d < 16) T[d] = (f32x2){pr * cr - pi * ci, pr * ci + pi * cr};
      const float t0 = pr * lbr - pi * lbi, t1 = pr * lbi + pi * lbr; pr = t0; pi = t1;
    }
  } else if (gt < 32768 + 2048) {
    const int e = (int)gt - 32768, pos = e >> 5, f = e & 31;
    const float inv = exp2f(-(float)f * (13.287712379549449f / 32.0f)); const float ang = (float)pos * inv;
    ((f32x2*)(p.ws + WS_ROPE))[e] = (f32x2){cosf(ang), sinf(ang)};
  }
}

__device__ __forceinline__ void cvt_job(const Ctx& cx, float* T, const float* __restrict__ src, bf16_t* __restrict__ dst, int K, int N, int ld_dst, int mode,
                                        const float* rs = nullptr, const float* rb = nullptr, float* cgo = nullptr, float* cbo = nullptr) {
  const int tid = cx.tid_(), nK = K >> 6, cnt = nK * (N >> 8);
  float* RED = T + 64 * 257 + 16;
  for (int t = cx.bid; t < cnt; t += cx.G) {
    const int k0 = (t % nK) << 6, n0 = (t / nK) << 8;
    const int r = tid >> 6, c4 = (tid & 63) * 4;
    f32x4 v[8];
#pragma unroll
    for (int i = 0; i < 8; ++i) v[i] = *(const f32x4*)(src + (size_t)(k0 + r + 8 * i) * N + n0 + c4);
    if (rs) { f32x4 pg = {0.f, 0.f, 0.f, 0.f}, pb = {0.f, 0.f, 0.f, 0.f};
#pragma unroll
      for (int i = 0; i < 8; ++i) { const float gk = rs[k0 + r + 8 * i], bk = rb[k0 + r + 8 * i]; pb += v[i] * bk; v[i] *= gk; pg += v[i]; }
      float* rp = RED + r * 256 + c4; rp[0] = pg[0]; rp[1] = pg[1]; rp[2] = pg[2]; rp[3] = pg[3]; rp += 2048; rp[0] = pb[0]; rp[1] = pb[1]; rp[2] = pb[2]; rp[3] = pb[3]; }
#pragma unroll
    for (int i = 0; i < 8; ++i) { float* tp = T + (r + 8 * i) * 257 + c4; tp[0] = v[i][0]; tp[1] = v[i][1]; tp[2] = v[i][2]; tp[3] = v[i][3]; }
    __syncthreads();
    if (rs) { const int which = tid >> 8, n = tid & 255; float s = 0.f;
#pragma unroll
      for (int rr = 0; rr < 8; ++rr) s += RED[which * 2048 + rr * 256 + n];
      __hip_atomic_fetch_add((which ? cbo : cgo) + n0 + n, s, __ATOMIC_RELAXED, __HIP_MEMORY_SCOPE_AGENT); }
    const int n = tid >> 1, kh = (tid & 1) * 32;
    const int nn = n0 + n; const int row = (mode == 0) ? nn : (((nn >> 7) << 8) + (nn & 127) + (mode == 2 ? 128 : 0));
    bf16_t* dp = dst + (size_t)row * ld_dst + k0 + kh;
#pragma unroll
    for (int q = 0; q < 4; ++q) { float w[8];
#pragma unroll
      for (int jj = 0; jj < 8; ++jj) w[jj] = T[(kh + 8 * q + jj) * 257 + n];
      u32x4 o; o.x = cvt_pk_bf16(w[0], w[1]); o.y = cvt_pk_bf16(w[2], w[3]); o.z = cvt_pk_bf16(w[4], w[5]); o.w = cvt_pk_bf16(w[6], w[7]);
      *(u32x4*)(dp + 8 * q) = o; }
    __syncthreads();
  }
}

__device__ __forceinline__ void s5_prep_item(const Ctx& cx, float* L, const Params& p, int j, int g, int hf) {
  const int tid = cx.tid_();
  f32x2* Cc = (f32x2*)L;
  f32x2* Bb = Cc + 2048;
  f32x2* PWs = Bb + 2048;
  float* Kt = (float*)(PWs + 4096);
  { float cr[4], ci[4], br[4], bi[4]; f32x2 pw[8];
#pragma unroll
    for (int k = 0; k < 4; ++k) { const int e = tid + 512 * k, dir = e >> 10, r = e & 1023; const size_t base = ((size_t)(j * 2 + dir) * 128 + g) * 1024 + r;
      cr[k] = p.c_re[base]; ci[k] = p.c_im[base]; br[k] = p.b_re[base]; bi[k] = p.b_im[base]; }
#pragma unroll
    for (int k = 0; k < 8; ++k) { const int e = tid + 512 * k, dir = e >> 11, r = e & 2047; pw[k] = ((const f32x2*)(p.ws + WS_PW))[(((size_t)(j * 2 + dir) * 128 + g) * 64) * 32 + r]; }
#pragma unroll
    for (int k = 0; k < 4; ++k) { const int e = tid + 512 * k; Cc[e] = (f32x2){cr[k], ci[k]}; Bb[e] = (f32x2){br[k], bi[k]}; }
#pragma unroll
    for (int k = 0; k < 8; ++k) PWs[tid + 512 * k] = pw[k]; }
  __syncthreads();
  { const int dir = tid >> 8, d = (tid >> 4) & 15, pp = tid & 15; float acc[16];
#pragma unroll
    for (int q = 0; q < 16; ++q) acc[q] = 0.f;
    for (int n = 0; n < 64; ++n) { const f32x2 c = Cc[(dir * 16 + pp) * 64 + n], w = PWs[(dir * 64 + n) * 32 + d];
      const float Wr = c.x * w.x - c.y * w.y, Wi = c.x * w.y + c.y * w.x;
#pragma unroll
      for (int q = 0; q < 16; ++q) { const f32x2 b = Bb[(dir * 64 + n) * 16 + q]; acc[q] += Wr * b.x - Wi * b.y; } }
#pragma unroll
    for (int q = 0; q < 16; ++q) Kt[((dir * 16 + d) * 16 + pp) * 16 + q] = acc[q]; }
  __syncthreads();
  bf16_t* Mout = (bf16_t*)(p.ws + WS_MIX + 32 * MiB); bf16_t* Mst = (bf16_t*)(p.ws + WS_MIX + 16 * MiB);
  for (int it = 0; it < 16; ++it) { const int id = it * 512 + tid, row_l = id >> 6, cgp = id & 63, t = 8 * hf + (row_l >> 4), pp = row_l & 15; float v[8];
    if (cgp < 32) { const int tp = cgp >> 1, q0 = (cgp & 1) * 8;
#pragma unroll
      for (int e = 0; e < 8; ++e) { const int q = q0 + e; float x = 0.f;
        if (tp <= t) x += Kt[((0 * 16 + (t - tp)) * 16 + pp) * 16 + q];
        if (tp >= t) x += Kt[((1 * 16 + (tp - t)) * 16 + pp) * 16 + q];
        if (tp == t && pp == q) x += p.s5_d[j * DM + g * 16 + pp];
        v[e] = x; }
    } else { const int kk0 = (cgp - 32) * 8, dir = kk0 >> 7, n0 = (kk0 & 127) >> 1, slot = 15 + (dir == 0 ? t + 1 : 16 - t);
#pragma unroll
      for (int e = 0; e < 8; ++e) { const int n = n0 + (e >> 1), ri = e & 1; const f32x2 c = Cc[(dir * 16 + pp) * 64 + n], w = PWs[(dir * 64 + n) * 32 + slot];
        v[e] = ri == 0 ? (c.x * w.x - c.y * w.y) : -(c.x * w.y + c.y * w.x); } }
    u32x4 w4; w4.x = cvt_pk_bf16(v[0], v[1]); w4.y = cvt_pk_bf16(v[2], v[3]); w4.z = cvt_pk_bf16(v[4], v[5]); w4.w = cvt_pk_bf16(v[6], v[7]);
    *(u32x4*)(Mout + ((size_t)(g * 256 + t * 16 + pp)) * 512 + cgp * 8) = w4; }
  for (int it = 0; it < 8; ++it) { const int id = it * 512 + tid, row_l = id >> 5, cgp = id & 31, dir = hf, ri = row_l & 1, n = row_l >> 1, tp = cgp >> 1, q0 = (cgp & 1) * 8;
    const f32x2 w = PWs[(dir * 64 + n) * 32 + (dir == 0 ? 15 - tp : tp)]; float v[8];
#pragma unroll
    for (int e = 0; e < 8; ++e) { const f32x2 b = Bb[(dir * 64 + n) * 16 + q0 + e]; v[e] = ri == 0 ? (w.x * b.x - w.y * b.y) : (w.x * b.y + w.y * b.x); }
    u32x4 w4; w4.x = cvt_pk_bf16(v[0], v[1]); w4.y = cvt_pk_bf16(v[2], v[3]); w4.z = cvt_pk_bf16(v[4], v[5]); w4.w = cvt_pk_bf16(v[6], v[7]);
    *(u32x4*)(Mst + ((size_t)(g * 256 + dir * 128 + row_l)) * 256 + cgp * 8) = w4; }
  __syncthreads();
}

__device__ __forceinline__ void phase_prep(const Ctx& cx, const Params& p, int layer, float* L) {
  const int kind = layer % 3, j = layer / 3;
  if (kind == 0) { for (int it = cx.bid; it < 256; it += cx.G) s5_prep_item(cx, L, p, j, it >> 1, it & 1); }
  cvt_job(cx, L, p.w1 + (size_t)layer * DM * DFF, (bf16_t*)(p.ws + WS_W1T), DM, DFF, DM, 0, LAZY_SCHED ? p.ln1g + layer * DM : nullptr, p.ln1b + layer * DM, (float*)(p.ws + WS_CG), (float*)(p.ws + WS_CG) + DFF);
  cvt_job(cx, L, p.w2 + (size_t)layer * DFF * DM, (bf16_t*)(p.ws + WS_W2T), DFF, DM, DFF, 0);
  if (kind == 0) {
    cvt_job(cx, L, p.s5_wout + (size_t)j * DM * DM, (bf16_t*)(p.ws + WS_MIX), DM, DM, DM, 1);
    cvt_job(cx, L, p.s5_wgate + (size_t)j * DM * DM, (bf16_t*)(p.ws + WS_MIX), DM, DM, DM, 2);
  } else if (kind == 1) {
    for (int gi = 0; gi < 4; ++gi) cvt_job(cx, L, p.pool_w + (size_t)gi * 512 * 512, (bf16_t*)(p.ws + WS_MIX) + (size_t)gi * 512 * 512, 512, 512, 512, 0);
  } else {
    cvt_job(cx, L, p.wqkv, (bf16_t*)(p.ws + WS_MIX), DM, QKVD, DM, 0);
    cvt_job(cx, L, p.wo, (bf16_t*)(p.ws + WS_MIX + 12 * MiB), DM, DM, DM, 0);
  }
}

__device__ __forceinline__ void phase_scan(const Ctx& cx, const Params& p, int j, bool own) {
  const int lane = cx.tid_() & 63, wave = cx.tid_() >> 6;
  pg8::StaticOrder SO; SO.init(10, 128, (int)cx.G, (int)cx.bid, WGM_OTHER);
  const bf16_t* S = (const bf16_t*)(p.ws + WS_R); bf16_t* H = (bf16_t*)(p.ws + WS_R + 320 * MiB);
  for (int it = wave;; it += 8) {
    int g, b;
    if (own) { pg8::Unit u; if (!SO.next(it, u)) break; b = u.pm; g = u.pn; }
    else { const int item = it * cx.G + cx.bid; if (item >= NBATCH * 128) break; g = item & 127; b = item >> 7; }
    const f32x2 lamF = ((const f32x2*)(p.ws + WS_PW))[(((size_t)(j * 2 + 0) * 128 + g) * 64 + lane) * 32 + 31];
    const f32x2 lamB = ((const f32x2*)(p.ws + WS_PW))[(((size_t)(j * 2 + 1) * 128 + g) * 64 + lane) * 32 + 31];
    f32x2 hF = {0.f, 0.f}, hB = {0.f, 0.f};
    const unsigned* Sb = (const unsigned*)(S + (size_t)b * 256 * 32768 + g * 256 + 2 * lane);
    unsigned* Hb = (unsigned*)(H + (size_t)b * 256 * 32768 + g * 256 + 2 * lane);
    unsigned sF[8], sB[8];
#pragma unroll
    for (int e = 0; e < 8; ++e) { sF[e] = Sb[(size_t)e * 16384]; sB[e] = Sb[(size_t)(255 - e) * 16384 + 64]; }
    for (int c0 = 0; c0 < 256; c0 += 8) {
      unsigned nF[8], nB[8]; const int c1 = (c0 + 8 < 256) ? c0 + 8 : c0;
#pragma unroll
      for (int e = 0; e < 8; ++e) { nF[e] = Sb[(size_t)(c1 + e) * 16384]; nB[e] = Sb[(size_t)(255 - c1 - e) * 16384 + 64]; }
#pragma unroll
      for (int e = 0; e < 8; ++e) { const int cF = c0 + e, cB = 255 - c0 - e;
        Hb[(size_t)cF * 16384] = cvt_pk_bf16(hF.x, hF.y); Hb[(size_t)cB * 16384 + 64] = cvt_pk_bf16(hB.x, hB.y);
        const float sfx = __uint_as_float(sF[e] << 16), sfy = __uint_as_float(sF[e] & 0xffff0000u), sbx = __uint_as_float(sB[e] << 16), sby = __uint_as_float(sB[e] & 0xffff0000u);
        const float fr_ = lamF.x * hF.x - lamF.y * hF.y + sfx, fi_ = lamF.x * hF.y + lamF.y * hF.x + sfy; hF.x = fr_; hF.y = fi_;
        const float br_ = lamB.x * hB.x - lamB.y * hB.y + sbx, bi_ = lamB.x * hB.y + lamB.y * hB.x + sby; hB.x = br_; hB.y = bi_; }
#pragma unroll
      for (int e = 0; e < 8; ++e) { sF[e] = nF[e]; sB[e] = nB[e]; }
    }
  }
}

#ifndef LN_REPS
#define LN_REPS 1
#endif
__device__ __forceinline__ void phase_ln(const Ctx& cx, const Params& p, const float* gam, const float* bet, bool final_, bool s5lay, bool dummy_in) {
 for (int rep = 0; rep < LN_REPS; ++rep) { const bool dummy = dummy_in || rep > 0; if (rep > 0) final_ = false;
  const int lane = cx.tid_() & 63, gw = cx.bid * 8 + (cx.tid_() >> 6), nw = cx.G * 8;
  if (!dummy) for (int i = cx.bid * 512 + cx.tid_(); i < 2 * DFF; i += cx.G * 512) ((float*)(p.ws + WS_CG))[i] = 0.f;
  f32x2* ST = (f32x2*)(p.ws + (dummy ? WS_R + 480 * MiB : WS_ST));
  int row = gw; f32x4 v[8], g4[8], b4[8];
#pragma unroll
  for (int k = 0; k < 8; ++k) { g4[k] = ((const f32x4*)gam)[k * 64 + lane]; b4[k] = ((const f32x4*)bet)[k * 64 + lane]; }
  { const f32x4* xr = (const f32x4*)(p.X + (size_t)min(row, MTOK - 1) * DM);
#pragma unroll
    for (int k = 0; k < 8; ++k) v[k] = xr[k * 64 + lane]; }
  while (row < MTOK) {
    const int nrow = row + nw; f32x4 nv[8];
    { const f32x4* xn = (const f32x4*)(p.X + (size_t)min(nrow, MTOK - 1) * DM);
#pragma unroll
      for (int k = 0; k < 8; ++k) nv[k] = xn[k * 64 + lane]; }
    u32x2* xb0 = (u32x2*)(p.ws + (dummy ? WS_R + 320 * MiB : WS_XB)); u32x2* xb = xb0 + (size_t)row * (DM / 4);
    f32x4* xo = dummy ? (f32x4*)(p.ws + WS_R) + (size_t)row * (DM / 4) : (f32x4*)(p.X + (size_t)row * DM);
    float s = 0.f, q = 0.f;
#pragma unroll
    for (int k = 0; k < 8; ++k) { s += (v[k][0] + v[k][1]) + (v[k][2] + v[k][3]); q += (v[k][0] * v[k][0] + v[k][1] * v[k][1]) + (v[k][2] * v[k][2] + v[k][3] * v[k][3]); }
#pragma unroll
    for (int o = 32; o >= 1; o >>= 1) { const float s2 = __int_as_float(__builtin_amdgcn_ds_bpermute((lane ^ o) << 2, __float_as_int(s))), q2 = __int_as_float(__builtin_amdgcn_ds_bpermute((lane ^ o) << 2, __float_as_int(q))); s += s2; q += q2; }
    const float mean = s * (1.0f / DM); const float rstd = rsqrtf(fmaxf(q * (1.0f / DM) - mean * mean, 0.f) + LN_EPS);
    if (lane == 0) { ST[row] = (f32x2){mean, rstd}; if (!dummy) { float z0; asm volatile("v_mov_b32 %0, 0" : "=v"(z0)); ((f32x2*)(p.ws + WS_ACC))[row] = (f32x2){z0, z0}; } }
#pragma unroll
    for (int k = 0; k < 8; ++k) {
      const f32x4 o = ((v[k] - mean) * rstd) * g4[k] + b4[k];
      if (final_) xo[k * 64 + lane] = o;
      else { u32x2 w; w.x = cvt_pk_bf16(o[0], o[1]); w.y = cvt_pk_bf16(o[2], o[3]);
        if (s5lay) { const unsigned ch = (unsigned)(k * 64 + lane) * 4u; xb0[((size_t)(row >> 4) * 32768 + (ch >> 4) * 256 + (row & 15) * 16 + (ch & 15)) >> 2] = w; }
        else xb[k * 64 + lane] = w; } }
#pragma unroll
    for (int k = 0; k < 8; ++k) v[k] = nv[k];
    row = nrow;
  }
 }
}

__device__ __forceinline__ f32x4 ldbf4(const u32x2* p) { const u32x2 u = *p; return (f32x4){__uint_as_float(u.x << 16), __uint_as_float(u.x & 0xffff0000u), __uint_as_float(u.y << 16), __uint_as_float(u.y & 0xffff0000u)}; }
__device__ __forceinline__ void phase_poolpre(const Ctx& cx, const Params& p) {
  const int tid = cx.tid_(); const int gi = tid >> 7, w2 = 1 << gi;
  u32x2* P = (u32x2*)(p.ws + WS_R);
  for (int it = cx.bid; it < NBATCH * 128; it += cx.G) {
    const int b = it >> 7, t0 = (it & 127) * 32;
    const u32x2* xb = (const u32x2*)(p.ws + WS_XB) + (size_t)b * SEQ * (DM / 4) + tid;
    f32x4 s = {0.f, 0.f, 0.f, 0.f};
    for (int k = -w2; k < w2; ++k) { const int tt = t0 + k; const float m = (tt >= 0 && tt < SEQ) ? 1.f : 0.f; const int tc = min(max(tt, 0), SEQ - 1); s += ldbf4(xb + (size_t)tc * (DM / 4)) * m; }
    for (int i0 = 0; i0 < 32; i0 += 8) {
      f32x4 c[8], ad[8], sb[8];
#pragma unroll
      for (int e = 0; e < 8; ++e) { const int t = t0 + i0 + e; c[e] = ldbf4(xb + (size_t)t * (DM / 4));
        const int ta = t + w2, ts = t - w2; const float ma = ta < SEQ ? 1.f : 0.f, ms = ts >= 0 ? 1.f : 0.f;
        ad[e] = ldbf4(xb + (size_t)min(ta, SEQ - 1) * (DM / 4)) * ma; sb[e] = ldbf4(xb + (size_t)max(ts, 0) * (DM / 4)) * ms; }
#pragma unroll
      for (int e = 0; e < 8; ++e) { const int t = t0 + i0 + e; const int lo = max(t - w2, 0), hi = min(t + w2, SEQ); const float inv = 1.0f / (float)(hi - lo);
        const f32x4 o = s * inv - c[e]; u32x2 w; w.x = cvt_pk_bf16(o[0], o[1]); w.y = cvt_pk_bf16(o[2], o[3]); P[((size_t)b * SEQ + t) * (DM / 4) + tid] = w;
        s += ad[e] - sb[e]; }
    }
  }
}

__device__ __forceinline__ void phase_rope(const Ctx& cx, const Params& p, bool dummy) {
  const int lane = cx.tid_() & 63, gw = cx.bid * 8 + (cx.tid_() >> 6), nw = cx.G * 8;
  const int hsel = lane >> 5, li = lane & 31, s = li >> 4, fp = li & 15, e0 = s * 64 + 2 * fp, e1 = e0 + 32;
  const f32x2 qa = *(const f32x2*)(p.qnorm + e0), qb = *(const f32x2*)(p.qnorm + e1), ka = *(const f32x2*)(p.knorm + e0), kb = *(const f32x2*)(p.knorm + e1);
  const f32x4* RT = (const f32x4*)(p.ws + WS_ROPE);
  bf16_t* QKV = (bf16_t*)(p.ws + WS_R);
  for (int tok = gw; tok < MTOK; tok += nw) {
    const int t = tok & (SEQ - 1); const int pos = s == 0 ? (t >> 6) : (t & 63); const f32x4 cs = RT[pos * 16 + fp];
    bf16_t* row = QKV + (size_t)tok * QKVD;
    unsigned ua[10], ub[10];
#pragma unroll
    for (int i = 0; i < 10; ++i) { const int hd = 2 * i + hsel; ua[i] = *(const unsigned*)(row + hd * 128 + e0); ub[i] = *(const unsigned*)(row + hd * 128 + e1); }
#pragma unroll
    for (int i = 0; i < 10; ++i) {
      const int hd = 2 * i + hsel; unsigned* p0 = (unsigned*)(row + hd * 128 + e0); unsigned* p1 = (unsigned*)(row + hd * 128 + e1);
      const unsigned u0 = ua[i], u1 = ub[i];
      const float x1a = __uint_as_float(u0 << 16), x1b = __uint_as_float(u0 & 0xffff0000u), x2a = __uint_as_float(u1 << 16), x2b = __uint_as_float(u1 & 0xffff0000u);
      float ss = (x1a * x1a + x1b * x1b) + (x2a * x2a + x2b * x2b);
#pragma unroll
      for (int o = 16; o >= 1; o >>= 1) ss += __int_as_float(__builtin_amdgcn_ds_bpermute((lane ^ o) << 2, __float_as_int(ss)));
      const float r = rsqrtf(ss * (1.0f / 128.0f) + RMS_EPS); const bool isq = hd < 16;
      const float y1a = x1a * r * (isq ? qa.x : ka.x), y1b = x1b * r * (isq ? qa.y : ka.y), y2a = x2a * r * (isq ? qb.x : kb.x), y2b = x2b * r * (isq ? qb.y : kb.y);
      const float o1a = y1a * cs[0] - y2a * cs[1], o2a = y2a * cs[0] + y1a * cs[1], o1b = y1b * cs[2] - y2b * cs[3], o2b = y2b * cs[2] + y1b * cs[3];
      if (!dummy || o1a == 1.2345e30f) { *p0 = cvt_pk_bf16(o1a, o1b); *p1 = cvt_pk_bf16(o2a, o2b); }
    }
  }
}

__device__ __forceinline__ void phase_attn(const Ctx& cx, const Params& p, char* lds) {
  const bf16_t* QKV = (const bf16_t*)(p.ws + WS_R); bf16_t* O = (bf16_t*)(p.ws + WS_R + 240 * MiB);
  const int G = cx.G, c = cx.bid;
  for (int r = 0;; ++r) {
    int pair, unit;
    if (G == 256) { if (r >= 10) break; const int xcd = c & 7, idx = c >> 3; pair = xcd * 5 + (r >> 1); unit = (r & 1) * 32 + idx; }
    else { const int L = r * G + c; if (L >= 2560) break; pair = L >> 6; unit = L & 63; }
    const int b = pair >> 2, kvh = pair & 3, hq = kvh * 4 + (unit >> 4), qb = unit & 15;
    const bf16_t* Qp = QKV + ((size_t)b * SEQ + qb * 256) * QKVD + hq * 128;
    const bf16_t* Kp = QKV + (size_t)b * SEQ * QKVD + 2048 + kvh * 128;
    const bf16_t* Vp = Kp + 512;
    bf16_t* Op = O + ((size_t)b * SEQ + qb * 256) * DM + hq * 128;
    att::attn_dense_body(Qp, Kp, Vp, Op, SEQ, lds, cx);
    __syncthreads();
  }
}


#define XB_TMO      128
#define XB_XCNT(j)  (256  + 64 * (j))
#define XB_XSUB(j)  (1280 + 64 * (j))
#define XB_XGEN(j)  (2304 + 64 * (j))
#define XB_TOP      3328
#define XB_TOPGEN   3392
#define XCD_BAR_WORDS 3456
#define XB_SPIN_CAP (1u << 22)
__device__ __forceinline__ unsigned xb_ld(unsigned* p)              { return __hip_atomic_load(p, __ATOMIC_RELAXED, __HIP_MEMORY_SCOPE_AGENT); }
__device__ __forceinline__ unsigned xb_add(unsigned* p, unsigned v) { return __hip_atomic_fetch_add(p, v, __ATOMIC_RELAXED, __HIP_MEMORY_SCOPE_AGENT); }
__device__ __forceinline__ unsigned xb_xcc_id() { return (unsigned)__builtin_amdgcn_s_getreg((3 << 11) | 20) & 0xFu; }
#define XB_SPIN(cond, bar) do { unsigned _sp = 0; while (cond) { __builtin_amdgcn_s_sleep(1); \
    if ((++_sp & 255u) == 0u) { if (xb_ld(&(bar)[XB_TMO])) break; if (_sp > XB_SPIN_CAP) { atomicAdd(&(bar)[XB_TMO], 1u); break; } } } } while (0)
__device__ __forceinline__ void xcd_barrier_complete(unsigned* bar, unsigned x, unsigned G, unsigned& nloc, unsigned& nx) {
  unsigned sum, cnt, mine, sp = 0u;
  for (;;) {
    sum = 0u; cnt = 0u; mine = 0u;
#pragma unroll
    for (unsigned j = 0; j < 16; ++j) { const unsigned c = xb_ld(&bar[XB_XCNT(j)]); sum += c; cnt += (c > 0u) ? 1u : 0u; mine = (j == x) ? c : mine; }
    if (sum == G) break;
    __builtin_amdgcn_s_sleep(1);
    if ((++sp & 255u) == 0u) { if (xb_ld(&bar[XB_TMO])) break; if (sp > XB_SPIN_CAP) { atomicAdd(&bar[XB_TMO], 1u); break; } }
  }
  nloc = mine > 0u ? mine : 1u; nx = cnt > 0u ? cnt : 1u;
}
__device__ __forceinline__ void xcd_barrier(const Ctx& cx, unsigned* bar, volatile LAS unsigned* st) {
  asm volatile("s_waitcnt vmcnt(0)" ::: "memory");
  __syncthreads();
  if (cx.tid_() == 0) {
    const unsigned x = xb_xcc_id();
    __builtin_amdgcn_s_waitcnt(0);
    unsigned nloc = st[0], nx = st[1];
    if (nloc == 0u) { xcd_barrier_complete(bar, x, (unsigned)cx.G, nloc, nx); st[0] = nloc; st[1] = nx; }
    const unsigned old = xb_add(&bar[XB_XSUB(x)], 1u);
    const unsigned gen = old / nloc;
    if (old + 1u == (gen + 1u) * nloc) {
      __builtin_amdgcn_fence(__ATOMIC_RELEASE, "agent");
      asm volatile("s_waitcnt vmcnt(0)" ::: "memory");
      const unsigned og = xb_add(&bar[XB_TOP], 1u);
      const unsigned tg = og / nx;
      if (og + 1u == (tg + 1u) * nx) xb_add(&bar[XB_TOPGEN], 1u);
      else XB_SPIN(xb_ld(&bar[XB_TOPGEN]) == tg, bar);
      __builtin_amdgcn_fence(__ATOMIC_ACQUIRE, "agent");
      xb_add(&bar[XB_XGEN(x)], 1u);
      asm volatile("s_waitcnt vmcnt(0)" ::: "memory");
    } else {
      XB_SPIN(xb_ld(&bar[XB_XGEN(x)]) == gen, bar);
      __builtin_amdgcn_fence(__ATOMIC_ACQUIRE, "agent");
      asm volatile("s_waitcnt vmcnt(0)" ::: "memory");
    }
  }
  __syncthreads();
}

enum { T_PRE = 0, T_PREP, T_S5G1, T_SCAN, T_S5G2, T_GLU, T_LN1, T_UP, T_DOWN, T_LN2, T_POOLPRE, T_POOLG, T_QKV, T_ROPE, T_ATT, T_WO };

constexpr int NSTEPS = LAZY_SCHED ? 31 : 30;
#ifndef PROBE_MASK
#define PROBE_MASK 0
#endif


__device__ __forceinline__ void run_step(const Ctx& cx, const Params& p, int type, int layer, unsigned char* lds, bool dummy) {
  using namespace pg8;
  unsigned char* ws = p.ws;
  const int j = layer / 3;
  bool is_gemm = false; pg8::GemmDesc g;
  g.A = nullptr; g.A2 = nullptr; g.Bt = nullptr; g.rowStrideA = DM * 2; g.ldbBytes = DM * 2; g.pnStrideA = 0; g.pnShift = 0; g.chunked = 0; g.ksplit = 1 << 20; g.nt = 32; g.nM = MTOK / 256; g.nN = 8;
  g.mode = 0; g.out = nullptr; g.ldc = DM; g.lnsel = 0; g.flags = 0; g.layer = layer; g.wgm = WGM_OTHER;
  switch (type) {
    case T_PRE: phase_pre(cx, p); break;
    case T_PREP: phase_prep(cx, p, layer, (float*)lds); break;
    case T_S5G1: is_gemm = true; g.A = (const char*)(ws + WS_XB); g.A2 = g.A; g.Bt = (const char*)(ws + WS_MIX + 16 * MiB); g.rowStrideA = 65536; g.ldbBytes = 512; g.pnStrideA = 512;
      g.nt = 4; g.nM = 10; g.nN = 128; g.mode = 0; g.out = ws + WS_R; g.ldc = 32768; break;
    case T_SCAN: phase_scan(cx, p, j, false); break;
    case T_S5G2: is_gemm = true; g.A = (const char*)(ws + WS_XB); g.A2 = (const char*)(ws + WS_R + 320 * MiB); g.Bt = (const char*)(ws + WS_MIX + 32 * MiB); g.rowStrideA = 65536; g.ldbBytes = 1024; g.pnStrideA = 512;
      g.ksplit = 4; g.nt = 8; g.nM = 10; g.nN = 128; g.mode = 2; g.out = ws + WS_R + 480 * MiB; g.ldc = 32768; break;
    case T_GLU: is_gemm = true; g.A = (const char*)(ws + WS_R + 480 * MiB); g.A2 = g.A; g.Bt = (const char*)(ws + WS_MIX); g.chunked = 1; g.nN = 16; g.mode = 5; g.out = p.X; if (layer > 0) { g.flags = F_LN_STATS | (EMIT_ON ? F_EMIT : 0); g.lnsel = 2; } else g.flags = F_XIN | (EMIT_ON ? F_EMIT : 0); break;
    case T_LN1: phase_ln(cx, p, p.ln1g + layer * DM, p.ln1b + layer * DM, false, false, dummy); break;
    case T_UP: is_gemm = true; g.A = (const char*)(ws + WS_XB); g.A2 = g.A; g.Bt = (const char*)(ws + WS_W1T); g.nN = 32; g.mode = 1; g.out = ws + WS_R; g.ldc = DFF; g.wgm = WGM_UP; g.flags = LAZY_SCHED ? (F_LN_ACC | F_FOLD) : 0; break;
    case T_DOWN: is_gemm = true; g.A = (const char*)(ws + WS_R); g.A2 = g.A; g.Bt = (const char*)(ws + WS_W2T); g.rowStrideA = DFF * 2; g.ldbBytes = DFF * 2; g.nt = 128; g.mode = 3; g.out = p.X; g.wgm = WGM_DOWN; g.flags = LAZY_SCHED ? F_LN_ACC : F_LN_STATS; g.lnsel = 1; break;
    case T_LN2: phase_ln(cx, p, p.ln2g + layer * DM, p.ln2b + layer * DM, layer == 3, layer == 2, dummy);
      if (!LAZY_SCHED && layer < 3) { __syncthreads(); phase_prep(cx, p, layer + 1, (float*)lds); } break;
    case T_POOLPRE: phase_poolpre(cx, p); break;
    case T_POOLG: is_gemm = true; g.A = (const char*)(ws + WS_R); g.A2 = g.A; g.Bt = (const char*)(ws + WS_MIX); g.ldbBytes = 1024; g.pnStrideA = 1024; g.pnShift = 1; g.nt = 8; g.mode = 4; g.out = p.X; g.flags = F_CSCALE | F_LN_STATS | (EMIT_ON ? F_EMIT : 0); g.lnsel = 2; break;
    case T_QKV: is_gemm = true; g.A = (const char*)(ws + WS_XB); g.A2 = g.A; g.Bt = (const char*)(ws + WS_MIX); g.nN = 12; g.mode = 0; g.out = ws + WS_R; g.ldc = QKVD; break;
    case T_ROPE: phase_rope(cx, p, dummy); break;
    case T_ATT: phase_attn(cx, p, (char*)lds); break;
    case T_WO: is_gemm = true; g.A = (const char*)(ws + WS_R + 240 * MiB); g.A2 = g.A; g.Bt = (const char*)(ws + WS_MIX + 12 * MiB); g.mode = 3; g.out = p.X; g.flags = F_LN_STATS | (EMIT_ON ? F_EMIT : 0); g.lnsel = 2; break;
    default: break;
  }
  if (is_gemm) { if (dummy && g.mode >= 3 && g.mode <= 5) g.mode = 7; pg8::gemm_phase(cx, (LAS unsigned char*)lds, g);
    if (type == T_S5G1) { __builtin_amdgcn_fence(__ATOMIC_ACQUIRE, "agent"); asm volatile("s_waitcnt vmcnt(0)" ::: "memory"); __syncthreads(); phase_scan(cx, p, j, true); } }
}


__device__ __forceinline__ void step_info(int s, int& type, int& layer) {
  if (s == 0) { type = T_PRE; layer = 0; return; }
  int r;
#if LAZY_SCHED
  if (s < 9) { layer = 0; r = s - 1; } else if (s < 15) { layer = 1; r = s - 9; } else if (s < 23) { layer = 2; r = s - 15; } else { layer = 3; r = s - 23; }
#else
  if (s < 9) { layer = 0; r = s - 1; } else if (s < 15) { layer = 1; r = s - 9 + 1; } else if (s < 23) { layer = 2; r = s - 15 + 1; } else { layer = 3; r = s - 23 + 1; }
#endif
  const int kind = layer % 3;
  if (r == 0) { type = T_PREP; return; }
  const int nmix = kind == 1 ? 2 : (kind == 0 ? 3 : 4);
  if (r <= nmix) {
    const int m = r - 1;
    if (kind == 0) type = (m == 0) ? T_S5G1 : (m == 1) ? T_S5G2 : T_GLU;
    else if (kind == 1) type = (m == 0) ? T_POOLPRE : T_POOLG;
    else type = (m == 0) ? T_QKV : (m == 1) ? T_ROPE : (m == 2) ? T_ATT : T_WO;
    return;
  }
  const int q = r - nmix - 1;
#if LAZY_SCHED
  type = (q == 0) ? T_UP : (q == 1) ? T_DOWN : T_LN2;
#else
  type = (q == 0) ? T_LN1 : (q == 1) ? T_UP : (q == 2) ? T_DOWN : T_LN2;
#endif
}
__global__ void __launch_bounds__(512) fwd_megakernel(Params p_unused) {
  extern __shared__ __attribute__((aligned(16))) unsigned char lds[];
  cg::grid_group grid = cg::this_grid();
  const int wave0 = __builtin_amdgcn_readfirstlane((int)threadIdx.x >> 6);
  { volatile LAS unsigned* st0 = (volatile LAS unsigned*)((LAS unsigned char*)lds + 128 * 1024);
    if (threadIdx.x < 4) st0[threadIdx.x] = 0u;
    __syncthreads();
    KargP pq = (KargP)__builtin_amdgcn_kernarg_segment_ptr();
    if (threadIdx.x == 0) (void)xb_add(&((unsigned*)(pq->ws + WS_BAR))[XB_XCNT(xb_xcc_id())], 1u); }
  for (int s = 0; s < NSTEPS; ++s) {
    int type, layer; step_info(s, type, layer);
    KargP pp = (KargP)__builtin_amdgcn_kernarg_segment_ptr();
    asm volatile("" : "+s"(pp));
    Ctx cx; { int b_ = (int)blockIdx.x, g_ = (int)gridDim.x; asm volatile("" : "+s"(b_)); asm volatile("" : "+s"(g_)); cx.wave0 = wave0; cx.bid = b_; cx.G = g_; }
#if defined(__HIP_DEVICE_COMPILE__)
    const Params p = *pp;
#else
    const Params p = p_unused;
#endif
    run_step(cx, p, type, layer, lds, false);
    if (s + 1 < NSTEPS) {
      if (p.ws == nullptr) grid.sync();
      else { xcd_barrier(cx, (unsigned*)(p.ws + WS_BAR), (volatile LAS unsigned*)((LAS unsigned char*)lds + 128 * 1024)); }
    }
  }
}
extern "C" void kernel_launch(void* const* d_in, const int* in_sizes, int n_in, void* d_out, int out_size, void* d_ws, size_t ws_size,
                              hipStream_t stream) {
  static int grid_blocks = 0;
  if (!grid_blocks) {
    int dev = 0, cus = 0, per_cu = 0;
    (void)hipGetDevice(&dev);
    (void)hipDeviceGetAttribute(&cus, hipDeviceAttributeMultiprocessorCount, dev);
    (void)hipFuncSetAttribute((const void*)fwd_megakernel, hipFuncAttributeMaxDynamicSharedMemorySize, LDS_BYTES);
    (void)hipOccupancyMaxActiveBlocksPerMultiprocessor(&per_cu, (const void*)fwd_megakernel, 512, LDS_BYTES);
    if (per_cu != 1) per_cu = 1;
    grid_blocks = cus * per_cu;
    if (ws_size < WS_END) fprintf(stderr, "kernel_launch: workspace too small: %zu < %zu\n", ws_size, (size_t)WS_END);
  }
  Params p{};
  p.xp = (const float*)d_in[0]; p.xs = (const float*)d_in[1];
  p.a_re = (const float*)d_in[2]; p.a_im = (const float*)d_in[3]; p.log_step = (const float*)d_in[4];
  p.b_re = (const float*)d_in[5]; p.b_im = (const float*)d_in[6]; p.c_re = (const float*)d_in[7]; p.c_im = (const float*)d_in[8];
  p.s5_d = (const float*)d_in[9]; p.s5_wout = (const float*)d_in[10]; p.s5_wgate = (const float*)d_in[11];
  p.pool_w = (const float*)d_in[12]; p.pool_scale = (const float*)d_in[13];
  p.wqkv = (const float*)d_in[14]; p.qnorm = (const float*)d_in[15]; p.knorm = (const float*)d_in[16]; p.wo = (const float*)d_in[17];
  p.ln1g = (const float*)d_in[18]; p.ln1b = (const float*)d_in[19]; p.ln2g = (const float*)d_in[20]; p.ln2b = (const float*)d_in[21];
  p.w1 = (const float*)d_in[22]; p.w2 = (const float*)d_in[23];
  p.X = (float*)d_out; p.ws = (unsigned char*)d_ws;
  (void)hipMemsetAsync((char*)d_ws + WS_BAR, 0, XCD_BAR_WORDS * 4, stream);
  void* args[] = {&p};
  hipError_t e = hipLaunchCooperativeKernel((const void*)fwd_megakernel, dim3(grid_blocks), dim3(512), args, LDS_BYTES, stream);
  if (e != hipSuccess) fprintf(stderr, "cooperative launch failed: %s (grid %d)\n", hipGetErrorString(e), grid_blocks);
}
```

```cpp
#include <hip/hip_runtime.h>
#include <hip/hip_cooperative_groups.h>
#include <cstdio>
#include <cstdint>
namespace cg = cooperative_groups;
#ifndef WGM_DOWN
#define WGM_DOWN 4
#endif
#ifndef WGM_UP
#define WGM_UP 8
#endif
#ifndef WGM_OTHER
#define WGM_OTHER 4
#endif
#ifndef LAZY_SCHED
#define LAZY_SCHED 0
#endif
#ifndef EMIT_ON
#define EMIT_ON 0
#endif

#define LAS __attribute__((address_space(3)))
typedef unsigned short bf16_t;
typedef short bf16x8 __attribute__((ext_vector_type(8)));
typedef short s16x4 __attribute__((ext_vector_type(4)));
typedef float f32x2 __attribute__((ext_vector_type(2)));
typedef float f32x4 __attribute__((ext_vector_type(4)));
typedef float f32x16 __attribute__((ext_vector_type(16)));
typedef unsigned u32x2 __attribute__((ext_vector_type(2)));
typedef unsigned u32x4 __attribute__((ext_vector_type(4)));

constexpr int DM = 2048, NBATCH = 10, SEQ = 4096, MTOK = NBATCH * SEQ, DFF = 8192, QKVD = 3072;
constexpr float ALPHA = 1.681792830507429f;
constexpr float LN_EPS = 1e-5f, RMS_EPS = 1e-6f;
constexpr size_t MiB = 1024ull * 1024ull;
constexpr size_t WS_PW = 0;
constexpr size_t WS_ROPE = 8 * MiB;
constexpr size_t WS_BAR = 10 * MiB;
constexpr size_t WS_ACC = 11 * MiB;
constexpr size_t WS_CG = 12 * MiB;
constexpr size_t WS_ONE = 13 * MiB;
constexpr size_t WS_ST = 9 * MiB;
constexpr size_t WS_WB = 16 * MiB;
constexpr size_t WS_W1T = WS_WB, WS_W2T = WS_WB + 32 * MiB, WS_MIX = WS_WB + 64 * MiB;
constexpr size_t WS_XB = 144 * MiB;
constexpr size_t WS_R = 304 * MiB;
constexpr size_t WS_END = WS_R + 640 * MiB;
constexpr int LDS_BYTES = 129 * 1024;

struct Params {
  const float* xp; const float* xs;
  const float* a_re; const float* a_im; const float* log_step; const float* b_re; const float* b_im; const float* c_re; const float* c_im;
  const float* s5_d; const float* s5_wout; const float* s5_wgate; const float* pool_w; const float* pool_scale;
  const float* wqkv; const float* qnorm; const float* knorm; const float* wo;
  const float* ln1g; const float* ln1b; const float* ln2g; const float* ln2b; const float* w1; const float* w2;
  float* X; unsigned char* ws;
};

typedef __attribute__((address_space(4))) const Params* KargP;
struct Ctx { int wave0, bid, G;
  __device__ __forceinline__ int tid_() const { int l_; asm volatile("v_mbcnt_lo_u32_b32 %0, -1, 0\n\tv_mbcnt_hi_u32_b32 %0, -1, %0" : "=v"(l_)); return wave0 * 64 + l_; } };
__device__ __forceinline__ unsigned cvt_pk_bf16(float lo, float hi) { unsigned r; asm volatile("v_cvt_pk_bf16_f32 %0, %1, %2" : "=v"(r) : "v"(lo), "v"(hi)); return r; }
__device__ __forceinline__ float bf2f(bf16_t h) { return __uint_as_float(((unsigned)h) << 16); }
__device__ __forceinline__ float wave_sum(float v, int lane) {
#pragma unroll
  for (int o = 32; o >= 1; o >>= 1) v += __int_as_float(__builtin_amdgcn_ds_bpermute((lane ^ o) << 2, __float_as_int(v)));
  return v;
}
__device__ __forceinline__ float gelu_tanh(float x) {
  const float u = 0.7978845608028654f * (x + 0.044715f * x * x * x);
  return x * __builtin_amdgcn_rcpf(1.0f + __builtin_amdgcn_exp2f(-2.885390081777927f * u));
}
__device__ __forceinline__ float sigmoidf_(float x) { return __builtin_amdgcn_rcpf(1.0f + __builtin_amdgcn_exp2f(-1.4426950408889634f * x)); }

namespace pg8 {
constexpr int BM = 256, BK = 64, HALF = 128, HTB = HALF * BK * 2, STAGE_BYTES = 8 * HTB, NXCD = 8, WGM = 4;
__device__ __forceinline__ int lds_byte(int r, int c) { const int st = (r >> 4) * 2 + (c >> 5), rr = r & 15, cc = c & 31, ob = rr * 64 + cc * 2; return st * 1024 + (ob ^ (((ob >> 9) & 1) << 5)); }
__device__ __forceinline__ void stage_rc(int b, int& R, int& C) { const int st = b / 1024, sb = b % 1024, swz = sb ^ (((sb >> 9) & 1) << 5); R = (st >> 1) * 16 + swz / 64; C = (st & 1) * 32 + (swz % 64) / 2; }
__device__ __forceinline__ int perm32(int rho) { const int n = rho >> 4, i = rho & 15; return 8 * (i >> 2) + 4 * n + (i & 3); }

struct Unit { int pm, pn; };
struct GemmDesc {
  const char* A; const char* A2; const char* Bt;
  unsigned rowStrideA, ldbBytes, pnStrideA; int pnShift, chunked, ksplit, nt, nM, nN;
  int mode; void* out; int ldc;
  int wgm;
  int lnsel, flags, layer;
};
enum { F_LN_STATS = 1, F_LN_ACC = 2, F_EMIT = 4, F_XIN = 8, F_FOLD = 16, F_CSCALE = 32 };
struct StaticOrder {
  int nM, nN, nwg, G, c, wgm;
  __device__ void init(int nM_, int nN_, int G_, int c_, int wgm_) { nM = nM_; nN = nN_; nwg = nM * nN; G = G_; c = c_; wgm = wgm_; }
  __device__ bool next(int i, Unit& u) const {
    const long L = (long)i * G + c; if (L >= nwg) return false;
    int wgid = (int)L; { const int q = nwg / NXCD, r = nwg % NXCD, xcd = wgid % NXCD, off = wgid / NXCD; wgid = (xcd < r ? xcd * (q + 1) : r * (q + 1) + (xcd - r) * q) + off; }
    const int nig = wgm * nN, gid = wgid / nig, fm = gid * wgm, gsz = (nM - fm) < wgm ? (nM - fm) : wgm;
    u.pm = fm + ((wgid % nig) % gsz); u.pn = (wgid % nig) / gsz; return true;
  }
};

__device__ __forceinline__ f32x2 row_stats(const f32x2* stats, const float* accIn, int row) {
  if (accIn) { const f32x2 a = *(const f32x2*)(accIn + 2 * (size_t)row); const float mean = a.x * (1.0f / DM); return (f32x2){mean, rsqrtf(fmaxf(a.y * (1.0f / DM) - mean * mean, 0.f) + LN_EPS)}; }
  return stats ? stats[row] : (f32x2){0.f, 1.f};
}
__device__ __forceinline__ void row_emit(float* accOut, int row, float s, float q, int lane, int fq) {
  s += __int_as_float(__builtin_amdgcn_ds_bpermute((lane ^ 16) << 2, __float_as_int(s))); q += __int_as_float(__builtin_amdgcn_ds_bpermute((lane ^ 16) << 2, __float_as_int(q)));
  s += __int_as_float(__builtin_amdgcn_ds_bpermute((lane ^ 32) << 2, __float_as_int(s))); q += __int_as_float(__builtin_amdgcn_ds_bpermute((lane ^ 32) << 2, __float_as_int(q)));
  if (fq == 0) { __hip_atomic_fetch_add(accOut + 2 * (size_t)row, s, __ATOMIC_RELAXED, __HIP_MEMORY_SCOPE_AGENT); __hip_atomic_fetch_add(accOut + 2 * (size_t)row + 1, q, __ATOMIC_RELAXED, __HIP_MEMORY_SCOPE_AGENT); }
}
__device__ __forceinline__ void gemm_epilogue(const GemmDesc& g, const f32x4 (&acc)[2][2][4][2], const Unit& u, int wr, int wc, int fr, int fq, int lane) {
  const int row0 = u.pm * BM + wr * 64 + fr;
  KargP pp = (KargP)__builtin_amdgcn_kernarg_segment_ptr(); asm volatile("" : "+s"(pp));
  unsigned char* const ws_ = pp->ws;
  const float* e_lng = nullptr; const float* e_lnb = nullptr;
  if (g.lnsel == 1) { e_lng = pp->ln1g + g.layer * DM; e_lnb = pp->ln1b + g.layer * DM; } else if (g.lnsel == 2) { e_lng = pp->ln2g + (g.layer - 1) * DM; e_lnb = pp->ln2b + (g.layer - 1) * DM; }
  const f32x2* const e_stats = (g.flags & F_LN_STATS) ? (const f32x2*)(ws_ + WS_ST) : nullptr;
  const float* const e_accIn = (g.flags & F_LN_ACC) ? (const float*)(ws_ + WS_ACC) : nullptr;
  float* const e_accOut = (g.flags & F_EMIT) ? (float*)(ws_ + WS_ACC) : nullptr; bf16_t* const e_xbOut = (bf16_t*)(ws_ + WS_XB);
  const float* const e_cg = (g.flags & F_FOLD) ? (const float*)(ws_ + WS_CG) : nullptr; const float* const e_cb = (const float*)(ws_ + WS_CG) + DFF;
  const float* const e_cscale = (g.flags & F_CSCALE) ? pp->pool_scale : nullptr;
  const float* const e_xin0 = (g.flags & F_XIN) ? pp->xp : nullptr; const float* const e_xin1 = pp->xs;
  if (g.mode <= 2) {
    bf16_t* O = (bf16_t*)g.out; const int col0 = u.pn * BM + wc * 32 + 8 * fq;
    const bool fold = (g.mode == 1) && (e_cg != nullptr);
    f32x4 fg[2][2], fb[2][2]; f32x2 fst[8];
    if (fold) {
#pragma unroll
      for (int bj = 0; bj < 2; ++bj)
#pragma unroll
        for (int n = 0; n < 2; ++n) { fg[bj][n] = *(const f32x4*)(e_cg + col0 + bj * HALF + 4 * n); fb[bj][n] = *(const f32x4*)(e_cb + col0 + bj * HALF + 4 * n); }
#pragma unroll
      for (int gi = 0; gi < 8; ++gi) fst[gi] = *(const f32x2*)(e_accIn + 2 * (size_t)(row0 + (gi >> 2) * HALF + (gi & 3) * 16));
#pragma unroll
      for (int gi = 0; gi < 8; ++gi) { const float mean = fst[gi].x * (1.0f / DM); fst[gi] = (f32x2){mean, rsqrtf(fmaxf(fst[gi].y * (1.0f / DM) - mean * mean, 0.f) + LN_EPS)}; }
    }
#pragma unroll
    for (int ai = 0; ai < 2; ++ai)
#pragma unroll
      for (int m = 0; m < 4; ++m) { bf16_t* rowp = O + (size_t)(row0 + ai * HALF + m * 16) * g.ldc + col0;
#pragma unroll
        for (int bj = 0; bj < 2; ++bj) { f32x4 v0 = acc[ai][bj][m][0], v1 = acc[ai][bj][m][1];
          if (g.mode == 1) {
            if (fold) { const f32x2 st = fst[ai * 4 + m]; v0 = (v0 - fg[bj][0] * st.x) * st.y + fb[bj][0]; v1 = (v1 - fg[bj][1] * st.x) * st.y + fb[bj][1]; }
#pragma unroll
            for (int j = 0; j < 4; ++j) { const float a = fmaxf(v0[j], 0.f), b = fmaxf(v1[j], 0.f); v0[j] = a * a; v1[j] = b * b; } }
          if (g.mode == 2) {
#pragma unroll
            for (int j = 0; j < 4; ++j) { v0[j] = gelu_tanh(v0[j]); v1[j] = gelu_tanh(v1[j]); } }
          u32x4 w; w.x = cvt_pk_bf16(v0[0], v0[1]); w.y = cvt_pk_bf16(v0[2], v0[3]); w.z = cvt_pk_bf16(v1[0], v1[1]); w.w = cvt_pk_bf16(v1[2], v1[3]);
          *(u32x4*)(rowp + bj * HALF) = w; } }
  } else if (g.mode == 3 || g.mode == 4) {
    float* X = (float*)g.out; const int col0 = u.pn * BM + wc * 32 + 4 * fq; const bool ln = e_stats != nullptr || e_accIn != nullptr;
    f32x4 cs[2][2], lg[2][2], lb[2][2];
#pragma unroll
    for (int bj = 0; bj < 2; ++bj)
#pragma unroll
      for (int n = 0; n < 2; ++n) { cs[bj][n] = (g.mode == 4) ? *(const f32x4*)(e_cscale + col0 + bj * HALF + n * 16) : (f32x4){1.f, 1.f, 1.f, 1.f};
        lg[bj][n] = ln ? *(const f32x4*)(e_lng + col0 + bj * HALF + n * 16) : (f32x4){1.f, 1.f, 1.f, 1.f}; lb[bj][n] = ln ? *(const f32x4*)(e_lnb + col0 + bj * HALF + n * 16) : (f32x4){0.f, 0.f, 0.f, 0.f}; }
    f32x2 st[2]; f32x4 xv[2][4];
    const f32x2* const e_sp = e_accIn ? (const f32x2*)e_accIn : (e_stats ? e_stats : (const f32x2*)(ws_ + WS_ONE));
#define RES_LOAD(GI, BUF) do { const int r_ = row0 + ((GI) >> 2) * HALF + ((GI) & 3) * 16; const float* rp_ = X + (size_t)r_ * DM + col0; \
      st[BUF] = e_sp[r_]; \
      _Pragma("unroll") for (int q_ = 0; q_ < 4; ++q_) xv[BUF][q_] = *(const f32x4*)(rp_ + (q_ >> 1) * HALF + (q_ & 1) * 16); } while (0)
    RES_LOAD(0, 0);
#pragma unroll
    for (int gi = 0; gi < 8; ++gi) { const int ai = gi >> 2, m = gi & 3; const int row = row0 + ai * HALF + m * 16; float* rowp = X + (size_t)row * DM + col0;
      if (gi + 1 < 8) RES_LOAD(gi + 1, (gi + 1) & 1);
      float ssum = 0.f, ssq = 0.f; f32x2 sm = st[gi & 1];
      if (e_accIn) { const float mean = sm.x * (1.0f / DM); sm = (f32x2){mean, rsqrtf(fmaxf(sm.y * (1.0f / DM) - mean * mean, 0.f) + LN_EPS)}; }
#pragma unroll
      for (int bj = 0; bj < 2; ++bj)
#pragma unroll
        for (int n = 0; n < 2; ++n) { f32x4* p = (f32x4*)(rowp + bj * HALF + n * 16); const f32x4 x = ((xv[gi & 1][bj * 2 + n] - sm.x) * sm.y) * lg[bj][n] + lb[bj][n]; const f32x4 o = x * ALPHA + acc[ai][bj][m][n] * cs[bj][n]; *p = o;
          if (e_accOut) { ssum += (o[0] + o[1]) + (o[2] + o[3]); ssq += (o[0] * o[0] + o[1] * o[1]) + (o[2] * o[2] + o[3] * o[3]);
            u32x2 w; w.x = cvt_pk_bf16(o[0], o[1]); w.y = cvt_pk_bf16(o[2], o[3]); *(u32x2*)(e_xbOut + (size_t)row * DM + col0 + bj * HALF + n * 16) = w; } }
      if (e_accOut) row_emit(e_accOut, row, ssum, ssq, lane, fq); }
#undef RES_LOAD
  } else if (g.mode == 5) {
    float* X = (float*)g.out; const int col0 = u.pn * HALF + wc * 32 + 4 * fq; const bool ln = e_stats != nullptr;
    f32x4 lg[2], lb[2];
#pragma unroll
    for (int n = 0; n < 2; ++n) { lg[n] = ln ? *(const f32x4*)(e_lng + col0 + n * 16) : (f32x4){1.f, 1.f, 1.f, 1.f}; lb[n] = ln ? *(const f32x4*)(e_lnb + col0 + n * 16) : (f32x4){0.f, 0.f, 0.f, 0.f}; }
    f32x2 st[2][2]; f32x4 xv[2][4];
    const f32x2* const e_sp = e_stats ? e_stats : (const f32x2*)(ws_ + WS_ONE);
#define GLU_SRC(ROW) (e_xin0 ? (((ROW) < 2 * SEQ) ? e_xin0 + (size_t)(ROW) * DM + col0 : e_xin1 + (size_t)((ROW) - 2 * SEQ) * DM + col0) : X + (size_t)(ROW) * DM + col0)
#define GLU_LOAD(PI, BUF) do { _Pragma("unroll") for (int h_ = 0; h_ < 2; ++h_) { const int g_ = 2 * (PI) + h_; const int r_ = row0 + (g_ >> 2) * HALF + (g_ & 3) * 16; const float* sp_ = GLU_SRC(r_); \
      st[BUF][h_] = e_sp[r_]; xv[BUF][2 * h_] = *(const f32x4*)(sp_); xv[BUF][2 * h_ + 1] = *(const f32x4*)(sp_ + 16); } } while (0)
    GLU_LOAD(0, 0);
#pragma unroll
    for (int pi = 0; pi < 4; ++pi) {
      if (pi + 1 < 4) GLU_LOAD(pi + 1, (pi + 1) & 1);
#pragma unroll
      for (int h2 = 0; h2 < 2; ++h2) { const int gi = 2 * pi + h2, ai = gi >> 2, m = gi & 3; const int row = row0 + ai * HALF + m * 16; float* rowp = X + (size_t)row * DM + col0; float ssum = 0.f, ssq = 0.f;
#pragma unroll
        for (int n = 0; n < 2; ++n) { f32x4* p = (f32x4*)(rowp + n * 16); const f32x4 x = ((xv[pi & 1][2 * h2 + n] - st[pi & 1][h2].x) * st[pi & 1][h2].y) * lg[n] + lb[n]; const f32x4 o = acc[ai][0][m][n], gt = acc[ai][1][m][n]; f32x4 h;
#pragma unroll
          for (int j = 0; j < 4; ++j) h[j] = o[j] * sigmoidf_(gt[j]);
          const f32x4 z = x * ALPHA + h; *p = z;
          if (e_accOut) { ssum += (z[0] + z[1]) + (z[2] + z[3]); ssq += (z[0] * z[0] + z[1] * z[1]) + (z[2] * z[2] + z[3] * z[3]);
            u32x2 w; w.x = cvt_pk_bf16(z[0], z[1]); w.y = cvt_pk_bf16(z[2], z[3]); *(u32x2*)(e_xbOut + (size_t)row * DM + col0 + n * 16) = w; } }
        if (e_accOut) row_emit(e_accOut, row, ssum, ssq, lane, fq); } }
#undef GLU_LOAD
#undef GLU_SRC
  } else if (g.mode == 7) {
    if (acc[0][0][0][0][0] == 1.2345e30f) *(f32x4*)g.out = acc[1][1][3][1];
  } else {
    float* C = (float*)g.out; const int col0 = u.pn * BM + wc * 32 + 4 * fq;
#pragma unroll
    for (int ai = 0; ai < 2; ++ai)
#pragma unroll
      for (int m = 0; m < 4; ++m) { float* rowp = C + (size_t)(row0 + ai * HALF + m * 16) * g.ldc + col0;
#pragma unroll
        for (int bj = 0; bj < 2; ++bj)
#pragma unroll
          for (int n = 0; n < 2; ++n) *(f32x4*)(rowp + bj * HALF + n * 16) = acc[ai][bj][m][n]; }
  }
}

__device__ __forceinline__ const char* ktile_ptr(const char* b1, const char* b2, int kt, int ksplit, size_t kstep) { return kt < ksplit ? b1 + (size_t)kt * kstep : b2 + (size_t)(kt - ksplit) * kstep; }

__device__ __forceinline__ void gemm_phase(const Ctx& cx, LAS unsigned char* lds, const GemmDesc& g) {
  const int tid = cx.tid_(), wid = __builtin_amdgcn_readfirstlane(tid >> 6), lane = tid & 63, wr = wid >> 2, wc = wid & 3, fr = lane & 15, fq = lane >> 4;
  const int nt = g.nt, ksplit = g.ksplit; const bool perm = g.mode <= 2;
  unsigned voffA[2], voffB[2];
#pragma unroll
  for (int i = 0; i < 2; ++i) { int R, C; stage_rc(tid * 16 + i * 8192, R, C); const int Rb = perm ? ((R & ~31) + perm32(R & 31)) : R;
    voffA[i] = g.chunked ? (unsigned)((R >> 4) * 65536 + (R & 15) * 32 + (C >> 4) * 512 + (C & 15) * 2) : ((unsigned)R * g.rowStrideA + (unsigned)(C * 2)); voffB[i] = (unsigned)Rb * g.ldbBytes + (unsigned)(C * 2); }
  const size_t kstepA = g.chunked ? 2048 : 128, kstepB = 128;
  const size_t hstepA = (size_t)HALF * g.rowStrideA, hstepB = (size_t)HALF * g.ldbBytes, tstepA = 2 * hstepA, tstepB = 2 * hstepB;
  const unsigned ldsw = (unsigned)wid * 1024u;
  const int aoff = lds_byte(wr * 64 + fr, fq * 8), boff = lds_byte(wc * 32 + fr, fq * 8);
#define PG8_SA(b, h) (((b) * 2 + (h)) * HTB)
#define PG8_SB(b, h) ((4 + (b) * 2 + (h)) * HTB)
#define PG8_STAGE(bufoff, gbase, voff) do { _Pragma("unroll") for (int _i = 0; _i < 2; ++_i) \
    __builtin_amdgcn_global_load_lds((const unsigned*)((const char*)(gbase) + (voff)[_i]), (LAS unsigned*)(lds + (bufoff) + ldsw + _i * 8192), 16, 0, 0); } while (0)
#define PG8_LDA(dst, b, h) do { _Pragma("unroll") for (int m = 0; m < 4; ++m) _Pragma("unroll") for (int k = 0; k < 2; ++k) dst[m][k] = *(const LAS bf16x8*)(lds + PG8_SA(b, h) + aoff + m * 2048 + k * 1024); } while (0)
#define PG8_LDB(dst, b, h) do { _Pragma("unroll") for (int n = 0; n < 2; ++n) _Pragma("unroll") for (int k = 0; k < 2; ++k) dst[n][k] = *(const LAS bf16x8*)(lds + PG8_SB(b, h) + boff + n * 2048 + k * 1024); } while (0)
#define PG8_MMA(ai, bj, At, Bt) do { __builtin_amdgcn_s_setprio(1); _Pragma("unroll") for (int m = 0; m < 4; ++m) _Pragma("unroll") for (int n = 0; n < 2; ++n) _Pragma("unroll") for (int k = 0; k < 2; ++k) \
    acc[ai][bj][m][n] = __builtin_amdgcn_mfma_f32_16x16x32_bf16(Bt[n][k], At[m][k], acc[ai][bj][m][n], 0, 0, 0); __builtin_amdgcn_s_setprio(0); } while (0)
#define PG8_WAIT_V(n) asm volatile("s_waitcnt vmcnt(" #n ")" ::: "memory")
#define PG8_WAIT_L(n) asm volatile("s_waitcnt lgkmcnt(" #n ")" ::: "memory")
#define PG8_BAR __builtin_amdgcn_s_barrier()
#define PG8_SCHED __builtin_amdgcn_sched_barrier(0)
  StaticOrder S; S.init(g.nM, g.nN, (int)cx.G, (int)cx.bid, g.wgm);
  Unit cur, nxt; int ui = 0;
  if (!S.next(0, cur)) return;
  f32x4 acc[2][2][4][2];
#pragma unroll
  for (int a = 0; a < 2; ++a)
#pragma unroll
    for (int b = 0; b < 2; ++b)
#pragma unroll
      for (int m = 0; m < 4; ++m)
#pragma unroll
        for (int n = 0; n < 2; ++n) acc[a][b][m][n] = (f32x4){0.f, 0.f, 0.f, 0.f};
  bf16x8 At[4][2], B0[2][2], B1[2][2];
  size_t aoffu = (size_t)cur.pm * tstepA + (size_t)(cur.pn >> g.pnShift) * g.pnStrideA;
  const char* cA1 = g.A + aoffu; const char* cA2 = g.A2 + aoffu; const char* cB = g.Bt + (size_t)cur.pn * tstepB;
  {
    const char* a0 = ktile_ptr(cA1, cA2, 0, ksplit, kstepA); const char* a1 = ktile_ptr(cA1, cA2, 1, ksplit, kstepA);
    PG8_STAGE(PG8_SB(0, 0), cB, voffB); PG8_STAGE(PG8_SB(0, 1), cB + hstepB, voffB); PG8_STAGE(PG8_SA(0, 0), a0, voffA); PG8_STAGE(PG8_SA(0, 1), a0 + hstepA, voffA);
    if (wr == 1) PG8_BAR;
    PG8_WAIT_V(2); PG8_BAR;
    PG8_STAGE(PG8_SB(1, 0), cB + kstepB, voffB); PG8_STAGE(PG8_SA(1, 0), a1, voffA); PG8_STAGE(PG8_SB(1, 1), cB + hstepB + kstepB, voffB);
    PG8_WAIT_V(6); PG8_BAR;
  }
  for (;;) {
    const bool has_next = S.next(ui + 1, nxt);
    const size_t naoff = has_next ? (size_t)nxt.pm * tstepA + (size_t)(nxt.pn >> g.pnShift) * g.pnStrideA : aoffu;
    const char* nA1 = g.A + naoff; const char* nA2 = g.A2 + naoff; const char* nB = has_next ? g.Bt + (size_t)nxt.pn * tstepB : cB;
    for (int t = 0; t < nt; t += 2) {
      const bool last = (t == nt - 2);
      const char* a1 = ktile_ptr(cA1, cA2, t + 1, ksplit, kstepA);
      const char* a2 = last ? ktile_ptr(nA1, nA2, 0, ksplit, kstepA) : ktile_ptr(cA1, cA2, t + 2, ksplit, kstepA);
      const char* a3 = last ? ktile_ptr(nA1, nA2, 1, ksplit, kstepA) : ktile_ptr(cA1, cA2, t + 3, ksplit, kstepA);
      const char* b2 = last ? nB : cB + (size_t)(t + 2) * kstepB; const char* b3 = b2 + kstepB;
      PG8_LDB(B0, 0, 0); PG8_LDB(B1, 0, 1); PG8_SCHED; PG8_LDA(At, 0, 0); PG8_STAGE(PG8_SA(1, 1), a1 + hstepA, voffA);
      PG8_WAIT_V(8); PG8_WAIT_L(0); PG8_BAR; PG8_MMA(0, 0, At, B0); PG8_MMA(0, 1, At, B1); PG8_BAR; PG8_SCHED;
      PG8_LDA(At, 0, 1); PG8_STAGE(PG8_SB(0, 0), b2, voffB); PG8_STAGE(PG8_SB(0, 1), b2 + hstepB, voffB); PG8_STAGE(PG8_SA(0, 0), a2, voffA);
      PG8_WAIT_V(8); PG8_WAIT_L(0); PG8_BAR; PG8_MMA(1, 0, At, B0); PG8_MMA(1, 1, At, B1); PG8_BAR; PG8_SCHED;
      PG8_LDB(B0, 1, 0); PG8_LDB(B1, 1, 1); PG8_SCHED; PG8_LDA(At, 1, 0); PG8_STAGE(PG8_SA(0, 1), a2 + hstepA, voffA);
      PG8_WAIT_V(8); PG8_WAIT_L(0); PG8_BAR; PG8_MMA(0, 0, At, B0); PG8_MMA(0, 1, At, B1); PG8_BAR; PG8_SCHED;
      PG8_LDA(At, 1, 1); PG8_STAGE(PG8_SB(1, 0), b3, voffB); PG8_STAGE(PG8_SB(1, 1), b3 + hstepB, voffB); PG8_STAGE(PG8_SA(1, 0), a3, voffA);
      PG8_WAIT_V(8); PG8_WAIT_L(0); PG8_BAR; PG8_MMA(1, 0, At, B0); PG8_MMA(1, 1, At, B1); PG8_BAR; PG8_SCHED;
    }
    if (wr == 0) PG8_BAR;
    gemm_epilogue(g, acc, cur, wr, wc, fr, fq, lane);
    if (!has_next) break;
#pragma unroll
    for (int a = 0; a < 2; ++a)
#pragma unroll
      for (int b = 0; b < 2; ++b)
#pragma unroll
        for (int m = 0; m < 4; ++m)
#pragma unroll
          for (int n = 0; n < 2; ++n) acc[a][b][m][n] = (f32x4){0.f, 0.f, 0.f, 0.f};
    cur = nxt; cA1 = nA1; cA2 = nA2; cB = nB; aoffu = naoff; ++ui;
    if (wr == 1) PG8_BAR;
  }
  PG8_WAIT_V(0);
  PG8_BAR;
#undef PG8_SA
#undef PG8_SB
#undef PG8_STAGE
#undef PG8_LDA
#undef PG8_LDB
#undef PG8_MMA
#undef PG8_WAIT_V
#undef PG8_WAIT_L
#undef PG8_BAR
#undef PG8_SCHED
}
}

namespace att {
constexpr int D = 128, NW = 8, QBLK = 32, KVBLK = 64;
constexpr float SCALE = 0.088388347648318440f, THR = 8.f;
constexpr int LDQ = QKVD, LDK = QKVD, LDO = DM;
constexpr size_t SHM_V = KVBLK * D * 2, SHM_K = KVBLK * D * 2, SHM_ATTN = 2 * SHM_V + 2 * SHM_K + NW * 64 * 4;
#define KSWZ(row, colB) ((row) * 256 + ((colB) ^ (((row) & 7) << 4)))
#define SBAR() __builtin_amdgcn_sched_barrier(0)
__device__ __forceinline__ int crow(int r, int hi) { return (r & 3) + 8 * (r >> 2) + 4 * hi; }
__device__ __forceinline__ bf16x8 ld8(const bf16_t* p) { return *reinterpret_cast<const bf16x8*>(p); }
__device__ __forceinline__ void partialSM(f32x16& p0, f32x16& p1, float& m_reg, float& mn, float& alpha) {
  constexpr float C = SCALE * 1.4426950408889634f;
  float pmax = p0[0];
#pragma unroll
  for (int r = 1; r < 16; ++r) pmax = fmaxf(pmax, p0[r]);
#pragma unroll
  for (int r = 0; r < 16; ++r) pmax = fmaxf(pmax, p1[r]);
  { auto rr = __builtin_amdgcn_permlane32_swap(__float_as_uint(pmax), __float_as_uint(pmax), false, false);
    pmax = fmaxf(__uint_as_float(rr[0]), __uint_as_float(rr[1])); }
  if (__builtin_expect(__all(pmax - m_reg <= THR / SCALE), 1)) { mn = m_reg; alpha = 1.f; }
  else { mn = fmaxf(m_reg, pmax); alpha = __builtin_amdgcn_exp2f((m_reg - mn) * C); m_reg = mn; }
  float mnC = -mn * C;
#pragma unroll
  for (int r = 0; r < 16; ++r) p0[r] = fmaf(p0[r], C, mnC);
#pragma unroll
  for (int r = 0; r < 16; ++r) p1[r] = fmaf(p1[r], C, mnC);
#pragma unroll
  for (int r = 0; r < 16; ++r) p0[r] = __builtin_amdgcn_exp2f(p0[r]);
}
__device__ __forceinline__ void finishSM(f32x16& p0, f32x16& p1, float alpha, float& l_reg, bf16x8& pa0, bf16x8& pa1, bf16x8& pa2, bf16x8& pa3) {
#pragma unroll
  for (int r = 0; r < 16; ++r) p1[r] = __builtin_amdgcn_exp2f(p1[r]);
  float ps = 0;
#pragma unroll
  for (int r = 0; r < 16; ++r) ps += p0[r];
#pragma unroll
  for (int r = 0; r < 16; ++r) ps += p1[r];
  { auto rr = __builtin_amdgcn_permlane32_swap(__float_as_uint(ps), __float_as_uint(ps), false, false);
    ps = __uint_as_float(rr[0]) + __uint_as_float(rr[1]); }
  l_reg = l_reg * alpha + ps;
#define PK4(P, BASE, OUT) do { unsigned a0 = cvt_pk_bf16(P[BASE + 0], P[BASE + 1]), a1 = cvt_pk_bf16(P[BASE + 2], P[BASE + 3]);   \
    unsigned b0 = cvt_pk_bf16(P[BASE + 4], P[BASE + 5]), b1 = cvt_pk_bf16(P[BASE + 6], P[BASE + 7]);                              \
    auto r0 = __builtin_amdgcn_permlane32_swap(a0, b0, false, false); auto r1 = __builtin_amdgcn_permlane32_swap(a1, b1, false, false); \
    u32x4 w = {r0[0], r1[0], r0[1], r1[1]}; OUT = *reinterpret_cast<bf16x8*>(&w); } while (0)
  PK4(p0, 0, pa0); PK4(p0, 8, pa1); PK4(p1, 0, pa2); PK4(p1, 8, pa3);
#undef PK4
}
__device__ __forceinline__ void qkt(f32x16& p0, f32x16& p1, const bf16_t* Ks, const bf16x8* qr, int r32, int hi) {
  p0 = f32x16{}; p1 = f32x16{};
#pragma unroll
  for (int d0 = 0; d0 < 8; ++d0) { int cb = (d0 * 16 + hi * 8) * 2;
    bf16x8 b0 = *reinterpret_cast<const bf16x8*>((const char*)Ks + KSWZ(r32, cb));
    bf16x8 b1 = *reinterpret_cast<const bf16x8*>((const char*)Ks + KSWZ(32 + r32, cb));
    p0 = __builtin_amdgcn_mfma_f32_32x32x16_bf16(b0, qr[d0], p0, 0, 0, 0);
    p1 = __builtin_amdgcn_mfma_f32_32x32x16_bf16(b1, qr[d0], p1, 0, 0, 0); }
}
__device__ __forceinline__ int v_st(int k, int c) { const int kk = (k & ~0xC) | ((k & 4) << 1) | ((k & 8) >> 1); return ((kk >> 3) * 4 + (c >> 5)) * 512 + ((kk & 7) * 32 + (c & 31)) * 2; }
__device__ __forceinline__ int v_rd_base(int lane) { return ((lane & 3) << 3) | (((lane >> 2) & 3) << 6) | (((lane >> 4) & 1) << 5) | (((lane >> 5) & 1) << 8); }
constexpr int v_rd_off(int d0, int ks, int half) { return d0 * 512 + ks * 4096 + half * 2048; }
template <int OFF> __device__ __forceinline__ s16x4 tr_read(int vb) {
  s16x4 r; asm volatile("ds_read_b64_tr_b16 %0, %1 offset:%2" : "=&v"(r) : "v"(vb), "i"(OFF) : "memory"); return r;
}
template <int D0> __device__ __forceinline__ void pv_one(f32x16& od, int vb, bf16x8 pa0, bf16x8 pa1, bf16x8 pa2, bf16x8 pa3) {
  const s16x4 l0 = tr_read<v_rd_off(D0, 0, 0)>(vb), h0 = tr_read<v_rd_off(D0, 0, 1)>(vb), l1 = tr_read<v_rd_off(D0, 1, 0)>(vb), h1 = tr_read<v_rd_off(D0, 1, 1)>(vb);
  const s16x4 l2 = tr_read<v_rd_off(D0, 2, 0)>(vb), h2 = tr_read<v_rd_off(D0, 2, 1)>(vb), l3 = tr_read<v_rd_off(D0, 3, 0)>(vb), h3 = tr_read<v_rd_off(D0, 3, 1)>(vb);
  asm volatile("s_waitcnt lgkmcnt(0)" ::: "memory"); SBAR();
#define PK(L, H) (bf16x8){L[0], L[1], L[2], L[3], H[0], H[1], H[2], H[3]}
  od = __builtin_amdgcn_mfma_f32_32x32x16_bf16(pa0, PK(l0, h0), od, 0, 0, 0);
  od = __builtin_amdgcn_mfma_f32_32x32x16_bf16(pa1, PK(l1, h1), od, 0, 0, 0);
  od = __builtin_amdgcn_mfma_f32_32x32x16_bf16(pa2, PK(l2, h2), od, 0, 0, 0);
  od = __builtin_amdgcn_mfma_f32_32x32x16_bf16(pa3, PK(l3, h3), od, 0, 0, 0);
#undef PK
}
__device__ __forceinline__ void pv_d0(f32x16* o, int vb, bf16x8 pa0, bf16x8 pa1, bf16x8 pa2, bf16x8 pa3) {
  pv_one<0>(o[0], vb, pa0, pa1, pa2, pa3); pv_one<1>(o[1], vb, pa0, pa1, pa2, pa3); pv_one<2>(o[2], vb, pa0, pa1, pa2, pa3); pv_one<3>(o[3], vb, pa0, pa1, pa2, pa3);
}
__device__ __forceinline__ void attn_dense_body(const bf16_t* __restrict__ Qb, const bf16_t* __restrict__ Kh, const bf16_t* __restrict__ Vh,
                                                bf16_t* __restrict__ Ob, int seq, char* lds, const Ctx& cx) {
  const int tid = cx.tid_(), wid = tid >> 6, lane = tid & 63, r32 = lane & 31, hi = lane >> 5;
  bf16_t* V_lds = (bf16_t*)lds; bf16_t* K_lds = (bf16_t*)(lds + 2 * SHM_V);
  float* ws = (float*)(lds + 2 * SHM_V + 2 * SHM_K) + wid * 64; float* li_l = ws; float* al_l = ws + 32;
  float m_reg = -1e30f, l_reg = 0; f32x16 o[4] = {}; bf16x8 qr[8];
  const bf16_t* Qw = Qb + (long)(wid * QBLK + r32) * LDQ + hi * 8;
#pragma unroll
  for (int d0 = 0; d0 < 8; ++d0) qr[d0] = ld8(Qw + d0 * 16);
  const int sr = tid >> 4, sc = (tid & 15) * 8, vst0 = v_st(sr, sc), vst1 = v_st(32 + sr, sc);
  const int vb0 = (int)(uintptr_t)V_lds + v_rd_base(lane);
  struct { bf16x8 vs0, vs1, ks0, ks1; } sr_[2];
#define SLOAD(i, k0) do { sr_[i].vs0 = ld8(&Vh[(long)((k0) + sr) * LDK + sc]); sr_[i].vs1 = ld8(&Vh[(long)((k0) + 32 + sr) * LDK + sc]); \
    sr_[i].ks0 = ld8(&Kh[(long)((k0) + sr) * LDK + sc]); sr_[i].ks1 = ld8(&Kh[(long)((k0) + 32 + sr) * LDK + sc]); } while (0)
#define SWRITE(b, i) do { *(bf16x8*)((char*)V_lds + (b) * SHM_V + vst0) = sr_[i].vs0;          \
    *(bf16x8*)((char*)V_lds + (b) * SHM_V + vst1) = sr_[i].vs1; int kc = sc * 2;               \
    *(bf16x8*)((char*)K_lds + (b) * SHM_K + KSWZ(sr, kc)) = sr_[i].ks0;                       \
    *(bf16x8*)((char*)K_lds + (b) * SHM_K + KSWZ(32 + sr, kc)) = sr_[i].ks1; } while (0)
#define SWAIT() asm volatile("s_waitcnt vmcnt(4)" ::: "memory")
#define RESC(a) do { if (__any((a) < 1.f)) { if (hi == 0) al_l[r32] = (a); asm volatile("s_waitcnt lgkmcnt(0)" ::: "memory"); \
    _Pragma("unroll") for (int d = 0; d < 4; ++d) _Pragma("unroll") for (int r = 0; r < 16; ++r) o[d][r] *= al_l[crow(r, hi)]; } } while (0)
  f32x16 pA0, pA1, pB0, pB1; float mnA, mnB, alA, alB; bf16x8 pa0, pa1, pa2, pa3; const int NT = seq / KVBLK;
  constexpr int SE = 0, SO = 1;
  SLOAD(SE, 0); asm volatile("s_waitcnt vmcnt(0)" ::: "memory"); SWRITE(0, SE); __syncthreads();
  qkt(pA0, pA1, K_lds, qr, r32, hi); partialSM(pA0, pA1, m_reg, mnA, alA);
  SLOAD(SO, KVBLK); if (2 < NT) SLOAD(SE, 2 * KVBLK);
  SWAIT(); SWRITE(1, SO); __syncthreads();
  for (int j = 1; j + 1 < NT; j += 2) {
    SBAR(); qkt(pB0, pB1, (bf16_t*)((char*)K_lds + SHM_K), qr, r32, hi);
    finishSM(pA0, pA1, alA, l_reg, pa0, pa1, pa2, pa3); SBAR();
    SLOAD(SO, (j + 2) * KVBLK); SBAR();
    pv_d0(o, vb0, pa0, pa1, pa2, pa3); partialSM(pB0, pB1, m_reg, mnB, alB);
    __syncthreads(); SWAIT(); SWRITE(0, SE);
    RESC(alB); __syncthreads();
    SBAR(); qkt(pA0, pA1, K_lds, qr, r32, hi);
    finishSM(pB0, pB1, alB, l_reg, pa0, pa1, pa2, pa3); SBAR();
    SLOAD(SE, min(j + 3, NT - 1) * KVBLK); SBAR();
    pv_d0(o, vb0 + (int)SHM_V, pa0, pa1, pa2, pa3); partialSM(pA0, pA1, m_reg, mnA, alA);
    __syncthreads(); SWAIT(); SWRITE(1, SO);
    RESC(alA); __syncthreads();
  }
  SBAR(); qkt(pB0, pB1, (bf16_t*)((char*)K_lds + SHM_K), qr, r32, hi);
  finishSM(pA0, pA1, alA, l_reg, pa0, pa1, pa2, pa3); SBAR();
  pv_d0(o, vb0, pa0, pa1, pa2, pa3); partialSM(pB0, pB1, m_reg, mnB, alB);
  __syncthreads(); RESC(alB);
  finishSM(pB0, pB1, alB, l_reg, pa0, pa1, pa2, pa3); SBAR();
  pv_d0(o, vb0 + (int)SHM_V, pa0, pa1, pa2, pa3);
  if (hi == 0) li_l[r32] = l_reg; asm volatile("s_waitcnt lgkmcnt(0)" ::: "memory");
  float rli[16];
#pragma unroll
  for (int r = 0; r < 16; ++r) rli[r] = __builtin_amdgcn_rcpf(li_l[crow(r, hi)]);
  bf16_t* Ow = Ob + (long)(wid * QBLK) * LDO;
#pragma unroll
  for (int r = 0; r < 16; ++r) { int orow = crow(r, hi);
#pragma unroll
    for (int d0 = 0; d0 < 4; ++d0) Ow[(long)orow * LDO + d0 * 32 + r32] = (bf16_t)(cvt_pk_bf16(o[d0][r] * rli[r], 0.f) & 0xffffu); }
#undef SLOAD
#undef SWRITE
#undef SWAIT
#undef RESC
}
}

__device__ __forceinline__ void phase_pre(const Ctx& cx, const Params& p) {
  const size_t gt = (size_t)cx.bid * 512 + cx.tid_(), nth = (size_t)cx.G * 512;
  const size_t n1 = (size_t)2 * SEQ * DM / 4, ntot = (size_t)MTOK * DM / 4;
  f32x4* X4 = (f32x4*)p.X; u32x2* XB2 = (u32x2*)(p.ws + WS_XB);
  for (size_t i = gt; i < ntot; i += 4 * nth) {
    f32x4 v[4];
#pragma unroll
    for (int e = 0; e < 4; ++e) { const size_t ii = i + e * nth; v[e] = (ii < ntot) ? ((ii < n1) ? __builtin_nontemporal_load(&((const f32x4*)p.xp)[ii]) : __builtin_nontemporal_load(&((const f32x4*)p.xs)[ii - n1])) : (f32x4){0.f, 0.f, 0.f, 0.f}; }
#pragma unroll
    for (int e = 0; e < 4; ++e) { const size_t ii = i + e * nth; if (ii < ntot) { u32x2 w; w.x = cvt_pk_bf16(v[e][0], v[e][1]); w.y = cvt_pk_bf16(v[e][2], v[e][3]);
        const size_t tok = ii >> 9; const unsigned ch = (unsigned)(ii & 511) * 4u; XB2[((tok >> 4) * 32768 + (ch >> 4) * 256 + (tok & 15) * 16 + (ch & 15)) >> 2] = w; } }
  }
  for (size_t i = gt; i < (size_t)MTOK * 2 + 2 * DFF; i += nth) { if (i < (size_t)MTOK * 2) ((float*)(p.ws + WS_ACC))[i] = 0.f; else ((float*)(p.ws + WS_CG))[i - (size_t)MTOK * 2] = 0.f; }
  { float z0, o1; asm volatile("v_mov_b32 %0, 0" : "=v"(z0)); asm volatile("v_mov_b32 %0, 1.0" : "=v"(o1)); for (size_t i = gt; i < (size_t)MTOK; i += nth) ((f32x2*)(p.ws + WS_ONE))[i] = (f32x2){z0, o1}; }
  if (gt < 32768) {
    const int idx = (int)gt;
    const float lr = fminf(p.a_re[idx], -1e-4f), li = p.a_im[idx], dt = expf(p.log_step[idx >> 6]);
    const float er = expf(lr * dt), ang = li * dt; const float lbr = er * cosf(ang), lbi = er * sinf(ang);
    const float nr = lbr - 1.f, ni = lbi, den = lr * lr + li * li; const float cr = (nr * lr + ni * li) / den, ci = (ni * lr - nr * li) / den;
    f32x2* T = (f32x2*)(p.ws + WS_PW) + (size_t)idx * 32;
    float pr = 1.f, pi = 0.f;
#pragma unroll
    for (int d = 0; d <= 16; ++d) {
      if (d >= 1) T[15 + d] = (f32x2){pr, pi};
      if (d < 16) T[d] = (f32x2){pr * cr - pi * ci, pr * ci + pi * cr};
      const float t0 = pr * lbr - pi * lbi, t1 = pr * lbi + pi * lbr; pr = t0; pi = t1;
    }
  } else if (gt < 32768 + 2048) {
    const int e = (int)gt - 32768, pos = e >> 5, f = e & 31;
    const float inv = exp2f(-(float)f * (13.287712379549449f / 32.0f)); const float ang = (float)pos * inv;
    ((f32x2*)(p.ws + WS_ROPE))[e] = (f32x2){cosf(ang), sinf(ang)};
  }
}

__device__ __forceinline__ void cvt_job(const Ctx& cx, float* T, const float* __restrict__ src, bf16_t* __restrict__ dst, int K, int N, int ld_dst, int mode,
                                        const float* rs = nullptr, const float* rb = nullptr, float* cgo = nullptr, float* cbo = nullptr) {
  const int tid = cx.tid_(), nK = K >> 6, cnt = nK * (N >> 8);
  float* RED = T + 64 * 257 + 16;
  for (int t = cx.bid; t < cnt; t += cx.G) {
    const int k0 = (t % nK) << 6, n0 = (t / nK) << 8;
    const int r = tid >> 6, c4 = (tid & 63) * 4;
    f32x4 v[8];
#pragma unroll
    for (int i = 0; i < 8; ++i) v[i] = __builtin_nontemporal_load((const f32x4*)(src + (size_t)(k0 + r + 8 * i) * N + n0 + c4));
    if (rs) { f32x4 pg = {0.f, 0.f, 0.f, 0.f}, pb = {0.f, 0.f, 0.f, 0.f};
#pragma unroll
      for (int i = 0; i < 8; ++i) { const float gk = rs[k0 + r + 8 * i], bk = rb[k0 + r + 8 * i]; pb += v[i] * bk; v[i] *= gk; pg += v[i]; }
      float* rp = RED + r * 256 + c4; rp[0] = pg[0]; rp[1] = pg[1]; rp[2] = pg[2]; rp[3] = pg[3]; rp += 2048; rp[0] = pb[0]; rp[1] = pb[1]; rp[2] = pb[2]; rp[3] = pb[3]; }
#pragma unroll
    for (int i = 0; i < 8; ++i) { float* tp = T + (r + 8 * i) * 257 + c4; tp[0] = v[i][0]; tp[1] = v[i][1]; tp[2] = v[i][2]; tp[3] = v[i][3]; }
    __syncthreads();
    if (rs) { const int which = tid >> 8, n = tid & 255; float s = 0.f;
#pragma unroll
      for (int rr = 0; rr < 8; ++rr) s += RED[which * 2048 + rr * 256 + n];
      __hip_atomic_fetch_add((which ? cbo : cgo) + n0 + n, s, __ATOMIC_RELAXED, __HIP_MEMORY_SCOPE_AGENT); }
    const int n = tid >> 1, kh = (tid & 1) * 32;
    const int nn = n0 + n; const int row = (mode == 0) ? nn : (((nn >> 7) << 8) + (nn & 127) + (mode == 2 ? 128 : 0));
    bf16_t* dp = dst + (size_t)row * ld_dst + k0 + kh;
#pragma unroll
    for (int q = 0; q < 4; ++q) { float w[8];
#pragma unroll
      for (int jj = 0; jj < 8; ++jj) w[jj] = T[(kh + 8 * q + jj) * 257 + n];
      u32x4 o; o.x = cvt_pk_bf16(w[0], w[1]); o.y = cvt_pk_bf16(w[2], w[3]); o.z = cvt_pk_bf16(w[4], w[5]); o.w = cvt_pk_bf16(w[6], w[7]);
      *(u32x4*)(dp + 8 * q) = o; }
    __syncthreads();
  }
}

__device__ __forceinline__ void s5_prep_item(const Ctx& cx, float* L, const Params& p, int j, int g, int hf) {
  const int tid = cx.tid_();
  f32x2* Cc = (f32x2*)L;
  f32x2* Bb = Cc + 2048;
  f32x2* PWs = Bb + 2048;
  float* Kt = (float*)(PWs + 4096);
  { float cr[4], ci[4], br[4], bi[4]; f32x2 pw[8];
#pragma unroll
    for (int k = 0; k < 4; ++k) { const int e = tid + 512 * k, dir = e >> 10, r = e & 1023; const size_t base = ((size_t)(j * 2 + dir) * 128 + g) * 1024 + r;
      cr[k] = p.c_re[base]; ci[k] = p.c_im[base]; br[k] = p.b_re[base]; bi[k] = p.b_im[base]; }
#pragma unroll
    for (int k = 0; k < 8; ++k) { const int e = tid + 512 * k, dir = e >> 11, r = e & 2047; pw[k] = ((const f32x2*)(p.ws + WS_PW))[(((size_t)(j * 2 + dir) * 128 + g) * 64) * 32 + r]; }
#pragma unroll
    for (int k = 0; k < 4; ++k) { const int e = tid + 512 * k; Cc[e] = (f32x2){cr[k], ci[k]}; Bb[e] = (f32x2){br[k], bi[k]}; }
#pragma unroll
    for (int k = 0; k < 8; ++k) PWs[tid + 512 * k] = pw[k]; }
  __syncthreads();
  { const int dir = tid >> 8, d = (tid >> 4) & 15, pp = tid & 15; float acc[16];
#pragma unroll
    for (int q = 0; q < 16; ++q) acc[q] = 0.f;
    for (int n = 0; n < 64; ++n) { const f32x2 c = Cc[(dir * 16 + pp) * 64 + n], w = PWs[(dir * 64 + n) * 32 + d];
      const float Wr = c.x * w.x - c.y * w.y, Wi = c.x * w.y + c.y * w.x;
#pragma unroll
      for (int q = 0; q < 16; ++q) { const f32x2 b = Bb[(dir * 64 + n) * 16 + q]; acc[q] += Wr * b.x - Wi * b.y; } }
#pragma unroll
    for (int q = 0; q < 16; ++q) Kt[((dir * 16 + d) * 16 + pp) * 16 + q] = acc[q]; }
  __syncthreads();
  bf16_t* Mout = (bf16_t*)(p.ws + WS_MIX + 32 * MiB); bf16_t* Mst = (bf16_t*)(p.ws + WS_MIX + 16 * MiB);
  for (int it = 0; it < 16; ++it) { const int id = it * 512 + tid, row_l = id >> 6, cgp = id & 63, t = 8 * hf + (row_l >> 4), pp = row_l & 15; float v[8];
    if (cgp < 32) { const int tp = cgp >> 1, q0 = (cgp & 1) * 8;
#pragma unroll
      for (int e = 0; e < 8; ++e) { const int q = q0 + e; float x = 0.f;
        if (tp <= t) x += Kt[((0 * 16 + (t - tp)) * 16 + pp) * 16 + q];
        if (tp >= t) x += Kt[((1 * 16 + (tp - t)) * 16 + pp) * 16 + q];
        if (tp == t && pp == q) x += p.s5_d[j * DM + g * 16 + pp];
        v[e] = x; }
    } else { const int kk0 = (cgp - 32) * 8, dir = kk0 >> 7, n0 = (kk0 & 127) >> 1, slot = 15 + (dir == 0 ? t + 1 : 16 - t);
#pragma unroll
      for (int e = 0; e < 8; ++e) { const int n = n0 + (e >> 1), ri = e & 1; const f32x2 c = Cc[(dir * 16 + pp) * 64 + n], w = PWs[(dir * 64 + n) * 32 + slot];
        v[e] = ri == 0 ? (c.x * w.x - c.y * w.y) : -(c.x * w.y + c.y * w.x); } }
    u32x4 w4; w4.x = cvt_pk_bf16(v[0], v[1]); w4.y = cvt_pk_bf16(v[2], v[3]); w4.z = cvt_pk_bf16(v[4], v[5]); w4.w = cvt_pk_bf16(v[6], v[7]);
    *(u32x4*)(Mout + ((size_t)(g * 256 + t * 16 + pp)) * 512 + cgp * 8) = w4; }
  for (int it = 0; it < 8; ++it) { const int id = it * 512 + tid, row_l = id >> 5, cgp = id & 31, dir = hf, ri = row_l & 1, n = row_l >> 1, tp = cgp >> 1, q0 = (cgp & 1) * 8;
    const f32x2 w = PWs[(dir * 64 + n) * 32 + (dir == 0 ? 15 - tp : tp)]; float v[8];
#pragma unroll
    for (int e = 0; e < 8; ++e) { const f32x2 b = Bb[(dir * 64 + n) * 16 + q0 + e]; v[e] = ri == 0 ? (w.x * b.x - w.y * b.y) : (w.x * b.y + w.y * b.x); }
    u32x4 w4; w4.x = cvt_pk_bf16(v[0], v[1]); w4.y = cvt_pk_bf16(v[2], v[3]); w4.z = cvt_pk_bf16(v[4], v[5]); w4.w = cvt_pk_bf16(v[6], v[7]);
    *(u32x4*)(Mst + ((size_t)(g * 256 + dir * 128 + row_l)) * 256 + cgp * 8) = w4; }
  __syncthreads();
}

__device__ __forceinline__ void phase_prep(const Ctx& cx, const Params& p, int layer, float* L) {
  const int kind = layer % 3, j = layer / 3;
  if (kind == 0) { for (int it = cx.bid; it < 256; it += cx.G) s5_prep_item(cx, L, p, j, it >> 1, it & 1); }
  cvt_job(cx, L, p.w1 + (size_t)layer * DM * DFF, (bf16_t*)(p.ws + WS_W1T), DM, DFF, DM, 0, LAZY_SCHED ? p.ln1g + layer * DM : nullptr, p.ln1b + layer * DM, (float*)(p.ws + WS_CG), (float*)(p.ws + WS_CG) + DFF);
  cvt_job(cx, L, p.w2 + (size_t)layer * DFF * DM, (bf16_t*)(p.ws + WS_W2T), DFF, DM, DFF, 0);
  if (kind == 0) {
    cvt_job(cx, L, p.s5_wout + (size_t)j * DM * DM, (bf16_t*)(p.ws + WS_MIX), DM, DM, DM, 1);
    cvt_job(cx, L, p.s5_wgate + (size_t)j * DM * DM, (bf16_t*)(p.ws + WS_MIX), DM, DM, DM, 2);
  } else if (kind == 1) {
    for (int gi = 0; gi < 4; ++gi) cvt_job(cx, L, p.pool_w + (size_t)gi * 512 * 512, (bf16_t*)(p.ws + WS_MIX) + (size_t)gi * 512 * 512, 512, 512, 512, 0);
  } else {
    cvt_job(cx, L, p.wqkv, (bf16_t*)(p.ws + WS_MIX), DM, QKVD, DM, 0);
    cvt_job(cx, L, p.wo, (bf16_t*)(p.ws + WS_MIX + 12 * MiB), DM, DM, DM, 0);
  }
}

__device__ __forceinline__ void phase_scan(const Ctx& cx, const Params& p, int j) {
  const int lane = cx.tid_() & 63, wave = cx.tid_() >> 6;
  const bf16_t* S = (const bf16_t*)(p.ws + WS_R); bf16_t* H = (bf16_t*)(p.ws + WS_R + 320 * MiB);
  for (int item = wave * cx.G + cx.bid; item < NBATCH * 128; item += 8 * cx.G) {
    const int g = item & 127, b = item >> 7;
    const f32x2 lamF = ((const f32x2*)(p.ws + WS_PW))[(((size_t)(j * 2 + 0) * 128 + g) * 64 + lane) * 32 + 31];
    const f32x2 lamB = ((const f32x2*)(p.ws + WS_PW))[(((size_t)(j * 2 + 1) * 128 + g) * 64 + lane) * 32 + 31];
    f32x2 hF = {0.f, 0.f}, hB = {0.f, 0.f};
    const unsigned* Sb = (const unsigned*)(S + (size_t)b * 256 * 32768 + g * 256 + 2 * lane);
    unsigned* Hb = (unsigned*)(H + (size_t)b * 256 * 32768 + g * 256 + 2 * lane);
    unsigned sF[8], sB[8];
#pragma unroll
    for (int e = 0; e < 8; ++e) { sF[e] = Sb[(size_t)e * 16384]; sB[e] = Sb[(size_t)(255 - e) * 16384 + 64]; }
    for (int c0 = 0; c0 < 256; c0 += 8) {
      unsigned nF[8], nB[8]; const int c1 = (c0 + 8 < 256) ? c0 + 8 : c0;
#pragma unroll
      for (int e = 0; e < 8; ++e) { nF[e] = Sb[(size_t)(c1 + e) * 16384]; nB[e] = Sb[(size_t)(255 - c1 - e) * 16384 + 64]; }
#pragma unroll
      for (int e = 0; e < 8; ++e) { const int cF = c0 + e, cB = 255 - c0 - e;
        Hb[(size_t)cF * 16384] = cvt_pk_bf16(hF.x, hF.y); Hb[(size_t)cB * 16384 + 64] = cvt_pk_bf16(hB.x, hB.y);
        const float sfx = __uint_as_float(sF[e] << 16), sfy = __uint_as_float(sF[e] & 0xffff0000u), sbx = __uint_as_float(sB[e] << 16), sby = __uint_as_float(sB[e] & 0xffff0000u);
        const float fr_ = lamF.x * hF.x - lamF.y * hF.y + sfx, fi_ = lamF.x * hF.y + lamF.y * hF.x + sfy; hF.x = fr_; hF.y = fi_;
        const float br_ = lamB.x * hB.x - lamB.y * hB.y + sbx, bi_ = lamB.x * hB.y + lamB.y * hB.x + sby; hB.x = br_; hB.y = bi_; }
#pragma unroll
      for (int e = 0; e < 8; ++e) { sF[e] = nF[e]; sB[e] = nB[e]; }
    }
  }
}

#ifndef LN_REPS
#define LN_REPS 1
#endif
__device__ __forceinline__ void phase_ln(const Ctx& cx, const Params& p, const float* gam, const float* bet, bool final_, bool s5lay, bool dummy_in) {
 for (int rep = 0; rep < LN_REPS; ++rep) { const bool dummy = dummy_in || rep > 0; if (rep > 0) final_ = false;
  const int lane = cx.tid_() & 63, gw = cx.bid * 8 + (cx.tid_() >> 6), nw = cx.G * 8;
  if (!dummy) for (int i = cx.bid * 512 + cx.tid_(); i < 2 * DFF; i += cx.G * 512) ((float*)(p.ws + WS_CG))[i] = 0.f;
  f32x2* ST = (f32x2*)(p.ws + (dummy ? WS_R + 480 * MiB : WS_ST));
  int row = gw; f32x4 v[8], g4[8], b4[8];
#pragma unroll
  for (int k = 0; k < 8; ++k) { g4[k] = ((const f32x4*)gam)[k * 64 + lane]; b4[k] = ((const f32x4*)bet)[k * 64 + lane]; }
  { const f32x4* xr = (const f32x4*)(p.X + (size_t)min(row, MTOK - 1) * DM);
#pragma unroll
    for (int k = 0; k < 8; ++k) v[k] = xr[k * 64 + lane]; }
  while (row < MTOK) {
    const int nrow = row + nw; f32x4 nv[8];
    { const f32x4* xn = (const f32x4*)(p.X + (size_t)min(nrow, MTOK - 1) * DM);
#pragma unroll
      for (int k = 0; k < 8; ++k) nv[k] = xn[k * 64 + lane]; }
    u32x2* xb0 = (u32x2*)(p.ws + (dummy ? WS_R + 320 * MiB : WS_XB)); u32x2* xb = xb0 + (size_t)row * (DM / 4);
    f32x4* xo = dummy ? (f32x4*)(p.ws + WS_R) + (size_t)row * (DM / 4) : (f32x4*)(p.X + (size_t)row * DM);
    float s = 0.f, q = 0.f;
#pragma unroll
    for (int k = 0; k < 8; ++k) { s += (v[k][0] + v[k][1]) + (v[k][2] + v[k][3]); q += (v[k][0] * v[k][0] + v[k][1] * v[k][1]) + (v[k][2] * v[k][2] + v[k][3] * v[k][3]); }
#pragma unroll
    for (int o = 32; o >= 1; o >>= 1) { const float s2 = __int_as_float(__builtin_amdgcn_ds_bpermute((lane ^ o) << 2, __float_as_int(s))), q2 = __int_as_float(__builtin_amdgcn_ds_bpermute((lane ^ o) << 2, __float_as_int(q))); s += s2; q += q2; }
    const float mean = s * (1.0f / DM); const float rstd = rsqrtf(fmaxf(q * (1.0f / DM) - mean * mean, 0.f) + LN_EPS);
    if (lane == 0) { ST[row] = (f32x2){mean, rstd}; if (!dummy) { float z0; asm volatile("v_mov_b32 %0, 0" : "=v"(z0)); ((f32x2*)(p.ws + WS_ACC))[row] = (f32x2){z0, z0}; } }
#pragma unroll
    for (int k = 0; k < 8; ++k) {
      const f32x4 o = ((v[k] - mean) * rstd) * g4[k] + b4[k];
      if (final_) xo[k * 64 + lane] = o;
      else { u32x2 w; w.x = cvt_pk_bf16(o[0], o[1]); w.y = cvt_pk_bf16(o[2], o[3]);
        if (s5lay) { const unsigned ch = (unsigned)(k * 64 + lane) * 4u; xb0[((size_t)(row >> 4) * 32768 + (ch >> 4) * 256 + (row & 15) * 16 + (ch & 15)) >> 2] = w; }
        else xb[k * 64 + lane] = w; } }
#pragma unroll
    for (int k = 0; k < 8; ++k) v[k] = nv[k];
    row = nrow;
  }
 }
}

__device__ __forceinline__ f32x4 ldbf4(const u32x2* p) { const u32x2 u = *p; return (f32x4){__uint_as_float(u.x << 16), __uint_as_float(u.x & 0xffff0000u), __uint_as_float(u.y << 16), __uint_as_float(u.y & 0xffff0000u)}; }
__device__ __forceinline__ void phase_poolpre(const Ctx& cx, const Params& p) {
  const int tid = cx.tid_(); const int gi = tid >> 7, w2 = 1 << gi;
  u32x2* P = (u32x2*)(p.ws + WS_R);
  for (int it = cx.bid; it < NBATCH * 128; it += cx.G) {
    const int b = it >> 7, t0 = (it & 127) * 32;
    const u32x2* xb = (const u32x2*)(p.ws + WS_XB) + (size_t)b * SEQ * (DM / 4) + tid;
    f32x4 s = {0.f, 0.f, 0.f, 0.f};
    for (int k = -w2; k < w2; ++k) { const int tt = t0 + k; const float m = (tt >= 0 && tt < SEQ) ? 1.f : 0.f; const int tc = min(max(tt, 0), SEQ - 1); s += ldbf4(xb + (size_t)tc * (DM / 4)) * m; }
    for (int i0 = 0; i0 < 32; i0 += 8) {
      f32x4 c[8], ad[8], sb[8];
#pragma unroll
      for (int e = 0; e < 8; ++e) { const int t = t0 + i0 + e; c[e] = ldbf4(xb + (size_t)t * (DM / 4));
        const int ta = t + w2, ts = t - w2; const float ma = ta < SEQ ? 1.f : 0.f, ms = ts >= 0 ? 1.f : 0.f;
        ad[e] = ldbf4(xb + (size_t)min(ta, SEQ - 1) * (DM / 4)) * ma; sb[e] = ldbf4(xb + (size_t)max(ts, 0) * (DM / 4)) * ms; }
#pragma unroll
      for (int e = 0; e < 8; ++e) { const int t = t0 + i0 + e; const int lo = max(t - w2, 0), hi = min(t + w2, SEQ); const float inv = 1.0f / (float)(hi - lo);
        const f32x4 o = s * inv - c[e]; u32x2 w; w.x = cvt_pk_bf16(o[0], o[1]); w.y = cvt_pk_bf16(o[2], o[3]); P[((size_t)b * SEQ + t) * (DM / 4) + tid] = w;
        s += ad[e] - sb[e]; }
    }
  }
}

__device__ __forceinline__ void phase_rope(const Ctx& cx, const Params& p, bool dummy) {
  const int lane = cx.tid_() & 63, gw = cx.bid * 8 + (cx.tid_() >> 6), nw = cx.G * 8;
  const int hsel = lane >> 5, li = lane & 31, s = li >> 4, fp = li & 15, e0 = s * 64 + 2 * fp, e1 = e0 + 32;
  const f32x2 qa = *(const f32x2*)(p.qnorm + e0), qb = *(const f32x2*)(p.qnorm + e1), ka = *(const f32x2*)(p.knorm + e0), kb = *(const f32x2*)(p.knorm + e1);
  const f32x4* RT = (const f32x4*)(p.ws + WS_ROPE);
  bf16_t* QKV = (bf16_t*)(p.ws + WS_R);
  for (int tok = gw; tok < MTOK; tok += nw) {
    const int t = tok & (SEQ - 1); const int pos = s == 0 ? (t >> 6) : (t & 63); const f32x4 cs = RT[pos * 16 + fp];
    bf16_t* row = QKV + (size_t)tok * QKVD;
    unsigned ua[10], ub[10];
#pragma unroll
    for (int i = 0; i < 10; ++i) { const int hd = 2 * i + hsel; ua[i] = *(const unsigned*)(row + hd * 128 + e0); ub[i] = *(const unsigned*)(row + hd * 128 + e1); }
#pragma unroll
    for (int i = 0; i < 10; ++i) {
      const int hd = 2 * i + hsel; unsigned* p0 = (unsigned*)(row + hd * 128 + e0); unsigned* p1 = (unsigned*)(row + hd * 128 + e1);
      const unsigned u0 = ua[i], u1 = ub[i];
      const float x1a = __uint_as_float(u0 << 16), x1b = __uint_as_float(u0 & 0xffff0000u), x2a = __uint_as_float(u1 << 16), x2b = __uint_as_float(u1 & 0xffff0000u);
      float ss = (x1a * x1a + x1b * x1b) + (x2a * x2a + x2b * x2b);
#pragma unroll
      for (int o = 16; o >= 1; o >>= 1) ss += __int_as_float(__builtin_amdgcn_ds_bpermute((lane ^ o) << 2, __float_as_int(ss)));
      const float r = rsqrtf(ss * (1.0f / 128.0f) + RMS_EPS); const bool isq = hd < 16;
      const float y1a = x1a * r * (isq ? qa.x : ka.x), y1b = x1b * r * (isq ? qa.y : ka.y), y2a = x2a * r * (isq ? qb.x : kb.x), y2b = x2b * r * (isq ? qb.y : kb.y);
      const float o1a = y1a * cs[0] - y2a * cs[1], o2a = y2a * cs[0] + y1a * cs[1], o1b = y1b * cs[2] - y2b * cs[3], o2b = y2b * cs[2] + y1b * cs[3];
      if (!dummy || o1a == 1.2345e30f) { *p0 = cvt_pk_bf16(o1a, o1b); *p1 = cvt_pk_bf16(o2a, o2b); }
    }
  }
}

__device__ __forceinline__ void phase_attn(const Ctx& cx, const Params& p, char* lds) {
  const bf16_t* QKV = (const bf16_t*)(p.ws + WS_R); bf16_t* O = (bf16_t*)(p.ws + WS_R + 240 * MiB);
  const int G = cx.G, c = cx.bid;
  for (int r = 0;; ++r) {
    int pair, unit;
    if (G == 256) { if (r >= 10) break; const int xcd = c & 7, idx = c >> 3; pair = xcd * 5 + (r >> 1); unit = (r & 1) * 32 + idx; }
    else { const int L = r * G + c; if (L >= 2560) break; pair = L >> 6; unit = L & 63; }
    const int b = pair >> 2, kvh = pair & 3, hq = kvh * 4 + (unit >> 4), qb = unit & 15;
    const bf16_t* Qp = QKV + ((size_t)b * SEQ + qb * 256) * QKVD + hq * 128;
    const bf16_t* Kp = QKV + (size_t)b * SEQ * QKVD + 2048 + kvh * 128;
    const bf16_t* Vp = Kp + 512;
    bf16_t* Op = O + ((size_t)b * SEQ + qb * 256) * DM + hq * 128;
    att::attn_dense_body(Qp, Kp, Vp, Op, SEQ, lds, cx);
    __syncthreads();
  }
}


#define XB_TMO      128
#define XB_XCNT(j)  (256  + 64 * (j))
#define XB_XSUB(j)  (1280 + 64 * (j))
#define XB_XGEN(j)  (2304 + 64 * (j))
#define XB_TOP      3328
#define XB_TOPGEN   3392
#define XCD_BAR_WORDS 3456
#define XB_SPIN_CAP (1u << 22)
__device__ __forceinline__ unsigned xb_ld(unsigned* p)              { return __hip_atomic_load(p, __ATOMIC_RELAXED, __HIP_MEMORY_SCOPE_AGENT); }
__device__ __forceinline__ unsigned xb_add(unsigned* p, unsigned v) { return __hip_atomic_fetch_add(p, v, __ATOMIC_RELAXED, __HIP_MEMORY_SCOPE_AGENT); }
__device__ __forceinline__ unsigned xb_xcc_id() { return (unsigned)__builtin_amdgcn_s_getreg((3 << 11) | 20) & 0xFu; }
#define XB_SPIN(cond, bar) do { unsigned _sp = 0; while (cond) { __builtin_amdgcn_s_sleep(1); \
    if ((++_sp & 255u) == 0u) { if (xb_ld(&(bar)[XB_TMO])) break; if (_sp > XB_SPIN_CAP) { atomicAdd(&(bar)[XB_TMO], 1u); break; } } } } while (0)
__device__ __forceinline__ void xcd_barrier_complete(unsigned* bar, unsigned x, unsigned G, unsigned& nloc, unsigned& nx) {
  unsigned sum, cnt, mine, sp = 0u;
  for (;;) {
    sum = 0u; cnt = 0u; mine = 0u;
#pragma unroll
    for (unsigned j = 0; j < 16; ++j) { const unsigned c = xb_ld(&bar[XB_XCNT(j)]); sum += c; cnt += (c > 0u) ? 1u : 0u; mine = (j == x) ? c : mine; }
    if (sum == G) break;
    __builtin_amdgcn_s_sleep(1);
    if ((++sp & 255u) == 0u) { if (xb_ld(&bar[XB_TMO])) break; if (sp > XB_SPIN_CAP) { atomicAdd(&bar[XB_TMO], 1u); break; } }
  }
  nloc = mine > 0u ? mine : 1u; nx = cnt > 0u ? cnt : 1u;
}
__device__ __forceinline__ void xcd_barrier(const Ctx& cx, unsigned* bar, volatile LAS unsigned* st) {
  asm volatile("s_waitcnt vmcnt(0)" ::: "memory");
  __syncthreads();
  if (cx.tid_() == 0) {
    const unsigned x = xb_xcc_id();
    __builtin_amdgcn_s_waitcnt(0);
    unsigned nloc = st[0], nx = st[1];
    if (nloc == 0u) { xcd_barrier_complete(bar, x, (unsigned)cx.G, nloc, nx); st[0] = nloc; st[1] = nx; }
    const unsigned old = xb_add(&bar[XB_XSUB(x)], 1u);
    const unsigned gen = old / nloc;
    if (old + 1u == (gen + 1u) * nloc) {
      __builtin_amdgcn_fence(__ATOMIC_RELEASE, "agent");
      asm volatile("s_waitcnt vmcnt(0)" ::: "memory");
      const unsigned og = xb_add(&bar[XB_TOP], 1u);
      const unsigned tg = og / nx;
      if (og + 1u == (tg + 1u) * nx) xb_add(&bar[XB_TOPGEN], 1u);
      else XB_SPIN(xb_ld(&bar[XB_TOPGEN]) == tg, bar);
      __builtin_amdgcn_fence(__ATOMIC_ACQUIRE, "agent");
      xb_add(&bar[XB_XGEN(x)], 1u);
      asm volatile("s_waitcnt vmcnt(0)" ::: "memory");
    } else {
      XB_SPIN(xb_ld(&bar[XB_XGEN(x)]) == gen, bar);
      __builtin_amdgcn_fence(__ATOMIC_ACQUIRE, "agent");
      asm volatile("s_waitcnt vmcnt(0)" ::: "memory");
    }
  }
  __syncthreads();
}

enum { T_PRE = 0, T_PREP, T_S5G1, T_SCAN, T_S5G2, T_GLU, T_LN1, T_UP, T_DOWN, T_LN2, T_POOLPRE, T_POOLG, T_QKV, T_ROPE, T_ATT, T_WO };

constexpr int NSTEPS = LAZY_SCHED ? 31 : 32;
#ifndef PROBE_MASK
#define PROBE_MASK 0
#endif


__device__ __forceinline__ void run_step(const Ctx& cx, const Params& p, int type, int layer, unsigned char* lds, bool dummy) {
  using namespace pg8;
  unsigned char* ws = p.ws;
  const int j = layer / 3;
  bool is_gemm = false; pg8::GemmDesc g;
  g.A = nullptr; g.A2 = nullptr; g.Bt = nullptr; g.rowStrideA = DM * 2; g.ldbBytes = DM * 2; g.pnStrideA = 0; g.pnShift = 0; g.chunked = 0; g.ksplit = 1 << 20; g.nt = 32; g.nM = MTOK / 256; g.nN = 8;
  g.mode = 0; g.out = nullptr; g.ldc = DM; g.lnsel = 0; g.flags = 0; g.layer = layer; g.wgm = WGM_OTHER;
  switch (type) {
    case T_PRE: phase_pre(cx, p); break;
    case T_PREP: phase_prep(cx, p, layer, (float*)lds); break;
    case T_S5G1: is_gemm = true; g.A = (const char*)(ws + WS_XB); g.A2 = g.A; g.Bt = (const char*)(ws + WS_MIX + 16 * MiB); g.rowStrideA = 65536; g.ldbBytes = 512; g.pnStrideA = 512;
      g.nt = 4; g.nM = 10; g.nN = 128; g.mode = 0; g.out = ws + WS_R; g.ldc = 32768; break;
    case T_SCAN: phase_scan(cx, p, j); break;
    case T_S5G2: is_gemm = true; g.A = (const char*)(ws + WS_XB); g.A2 = (const char*)(ws + WS_R + 320 * MiB); g.Bt = (const char*)(ws + WS_MIX + 32 * MiB); g.rowStrideA = 65536; g.ldbBytes = 1024; g.pnStrideA = 512;
      g.ksplit = 4; g.nt = 8; g.nM = 10; g.nN = 128; g.mode = 2; g.out = ws + WS_R + 480 * MiB; g.ldc = 32768; break;
    case T_GLU: is_gemm = true; g.A = (const char*)(ws + WS_R + 480 * MiB); g.A2 = g.A; g.Bt = (const char*)(ws + WS_MIX); g.chunked = 1; g.nN = 16; g.mode = 5; g.out = p.X; if (layer > 0) { g.flags = F_LN_STATS | (EMIT_ON ? F_EMIT : 0); g.lnsel = 2; } else g.flags = F_XIN | (EMIT_ON ? F_EMIT : 0); break;
    case T_LN1: phase_ln(cx, p, p.ln1g + layer * DM, p.ln1b + layer * DM, false, false, dummy); break;
    case T_UP: is_gemm = true; g.A = (const char*)(ws + WS_XB); g.A2 = g.A; g.Bt = (const char*)(ws + WS_W1T); g.nN = 32; g.mode = 1; g.out = ws + WS_R; g.ldc = DFF; g.wgm = WGM_UP; g.flags = LAZY_SCHED ? (F_LN_ACC | F_FOLD) : 0; break;
    case T_DOWN: is_gemm = true; g.A = (const char*)(ws + WS_R); g.A2 = g.A; g.Bt = (const char*)(ws + WS_W2T); g.rowStrideA = DFF * 2; g.ldbBytes = DFF * 2; g.nt = 128; g.mode = 3; g.out = p.X; g.wgm = WGM_DOWN; g.flags = LAZY_SCHED ? F_LN_ACC : F_LN_STATS; g.lnsel = 1; break;
    case T_LN2: phase_ln(cx, p, p.ln2g + layer * DM, p.ln2b + layer * DM, layer == 3, layer == 2, dummy);
      if (!LAZY_SCHED && layer < 3) { __syncthreads(); phase_prep(cx, p, layer + 1, (float*)lds); } break;
    case T_POOLPRE: phase_poolpre(cx, p); break;
    case T_POOLG: is_gemm = true; g.A = (const char*)(ws + WS_R); g.A2 = g.A; g.Bt = (const char*)(ws + WS_MIX); g.ldbBytes = 1024; g.pnStrideA = 1024; g.pnShift = 1; g.nt = 8; g.mode = 4; g.out = p.X; g.flags = F_CSCALE | F_LN_STATS | (EMIT_ON ? F_EMIT : 0); g.lnsel = 2; break;
    case T_QKV: is_gemm = true; g.A = (const char*)(ws + WS_XB); g.A2 = g.A; g.Bt = (const char*)(ws + WS_MIX); g.nN = 12; g.mode = 0; g.out = ws + WS_R; g.ldc = QKVD; break;
    case T_ROPE: phase_rope(cx, p, dummy); break;
    case T_ATT: phase_attn(cx, p, (char*)lds); break;
    case T_WO: is_gemm = true; g.A = (const char*)(ws + WS_R + 240 * MiB); g.A2 = g.A; g.Bt = (const char*)(ws + WS_MIX + 12 * MiB); g.mode = 3; g.out = p.X; g.flags = F_LN_STATS | (EMIT_ON ? F_EMIT : 0); g.lnsel = 2; break;
    default: break;
  }
  if (is_gemm) { if (dummy && g.mode >= 3 && g.mode <= 5) g.mode = 7; pg8::gemm_phase(cx, (LAS unsigned char*)lds, g); }
}


__device__ __forceinline__ void step_info(int s, int& type, int& layer) {
  if (s == 0) { type = T_PRE; layer = 0; return; }
  int r;
#if LAZY_SCHED
  if (s < 9) { layer = 0; r = s - 1; } else if (s < 15) { layer = 1; r = s - 9; } else if (s < 23) { layer = 2; r = s - 15; } else { layer = 3; r = s - 23; }
#else
  if (s < 10) { layer = 0; r = s - 1; } else if (s < 16) { layer = 1; r = s - 10 + 1; } else if (s < 24) { layer = 2; r = s - 16 + 1; } else { layer = 3; r = s - 24 + 1; }
#endif
  const int kind = layer % 3;
  if (r == 0) { type = T_PREP; return; }
  const int nmix = kind == 1 ? 2 : 4;
  if (r <= nmix) {
    const int m = r - 1;
    if (kind == 0) type = (m == 0) ? T_S5G1 : (m == 1) ? T_SCAN : (m == 2) ? T_S5G2 : T_GLU;
    else if (kind == 1) type = (m == 0) ? T_POOLPRE : T_POOLG;
    else type = (m == 0) ? T_QKV : (m == 1) ? T_ROPE : (m == 2) ? T_ATT : T_WO;
    return;
  }
  const int q = r - nmix - 1;
#if LAZY_SCHED
  type = (q == 0) ? T_UP : (q == 1) ? T_DOWN : T_LN2;
#else
  type = (q == 0) ? T_LN1 : (q == 1) ? T_UP : (q == 2) ? T_DOWN : T_LN2;
#endif
}
__global__ void __launch_bounds__(512) fwd_megakernel(Params p_unused) {
  extern __shared__ __attribute__((aligned(16))) unsigned char lds[];
  cg::grid_group grid = cg::this_grid();
  const int wave0 = __builtin_amdgcn_readfirstlane((int)threadIdx.x >> 6);
  { volatile LAS unsigned* st0 = (volatile LAS unsigned*)((LAS unsigned char*)lds + 128 * 1024);
    if (threadIdx.x < 4) st0[threadIdx.x] = 0u;
    __syncthreads();
    KargP pq = (KargP)__builtin_amdgcn_kernarg_segment_ptr();
    if (threadIdx.x == 0) (void)xb_add(&((unsigned*)(pq->ws + WS_BAR))[XB_XCNT(xb_xcc_id())], 1u); }
  for (int s = 0; s < NSTEPS; ++s) {
    int type, layer; step_info(s, type, layer);
    KargP pp = (KargP)__builtin_amdgcn_kernarg_segment_ptr();
    asm volatile("" : "+s"(pp));
    Ctx cx; { int b_ = (int)blockIdx.x, g_ = (int)gridDim.x; asm volatile("" : "+s"(b_)); asm volatile("" : "+s"(g_)); cx.wave0 = wave0; cx.bid = b_; cx.G = g_; }
#if defined(__HIP_DEVICE_COMPILE__)
    const Params p = *pp;
#else
    const Params p = p_unused;
#endif
    run_step(cx, p, type, layer, lds, false);
    if (s + 1 < NSTEPS) {
      if (s == 0) grid.sync();
      else { xcd_barrier(cx, (unsigned*)(p.ws + WS_BAR), (volatile LAS unsigned*)((LAS unsigned char*)lds + 128 * 1024)); }
    }
  }
}
extern "C" void kernel_launch(void* const* d_in, const int* in_sizes, int n_in, void* d_out, int out_size, void* d_ws, size_t ws_size,
                              hipStream_t stream) {
  static int grid_blocks = 0;
  if (!grid_blocks) {
    int dev = 0, cus = 0, per_cu = 0;
    (void)hipGetDevice(&dev);
    (void)hipDeviceGetAttribute(&cus, hipDeviceAttributeMultiprocessorCount, dev);
    (void)hipFuncSetAttribute((const void*)fwd_megakernel, hipFuncAttributeMaxDynamicSharedMemorySize, LDS_BYTES);
    (void)hipOccupancyMaxActiveBlocksPerMultiprocessor(&per_cu, (const void*)fwd_megakernel, 512, LDS_BYTES);
    if (per_cu != 1) per_cu = 1;
    grid_blocks = cus * per_cu;
    if (ws_size < WS_END) fprintf(stderr, "kernel_launch: workspace too small: %zu < %zu\n", ws_size, (size_t)WS_END);
  }
  Params p{};
  p.xp = (const float*)d_in[0]; p.xs = (const float*)d_in[1];
  p.a_re = (const float*)d_in[2]; p.a_im = (const float*)d_in[3]; p.log_step = (const float*)d_in[4];
  p.b_re = (const float*)d_in[5]; p.b_im = (const float*)d_in[6]; p.c_re = (const float*)d_in[7]; p.c_im = (const float*)d_in[8];
  p.s5_d = (const float*)d_in[9]; p.s5_wout = (const float*)d_in[10]; p.s5_wgate = (const float*)d_in[11];
  p.pool_w = (const float*)d_in[12]; p.pool_scale = (const float*)d_in[13];
  p.wqkv = (const float*)d_in[14]; p.qnorm = (const float*)d_in[15]; p.knorm = (const float*)d_in[16]; p.wo = (const float*)d_in[17];
  p.ln1g = (const float*)d_in[18]; p.ln1b = (const float*)d_in[19]; p.ln2g = (const float*)d_in[20]; p.ln2b = (const float*)d_in[21];
  p.w1 = (const float*)d_in[22]; p.w2 = (const float*)d_in[23];
  p.X = (float*)d_out; p.ws = (unsigned char*)d_ws;
  (void)hipMemsetAsync((char*)d_ws + WS_BAR, 0, XCD_BAR_WORDS * 4, stream);
  void* args[] = {&p};
  hipError_t e = hipLaunchCooperativeKernel((const void*)fwd_megakernel, dim3(grid_blocks), dim3(512), args, LDS_BYTES, stream);
  if (e != hipSuccess) fprintf(stderr, "cooperative launch failed: %s (grid %d)\n", hipGetErrorString(e), grid_blocks);
}
```

```cpp
#include <hip/hip_runtime.h>
#include <hip/hip_cooperative_groups.h>
#include <cstdio>
#include <cstdint>
namespace cg = cooperative_groups;
#ifndef WGM_DOWN
#define WGM_DOWN 4
#endif
#ifndef WGM_UP
#define WGM_UP 8
#endif
#ifndef WGM_OTHER
#define WGM_OTHER 4
#endif
#ifndef LAZY_SCHED
#define LAZY_SCHED 0
#endif
#ifndef EMIT_ON
#define EMIT_ON 0
#endif

#define LAS __attribute__((address_space(3)))
typedef unsigned short bf16_t;
typedef short bf16x8 __attribute__((ext_vector_type(8)));
typedef short s16x4 __attribute__((ext_vector_type(4)));
typedef float f32x2 __attribute__((ext_vector_type(2)));
typedef float f32x4 __attribute__((ext_vector_type(4)));
typedef float f32x16 __attribute__((ext_vector_type(16)));
typedef unsigned u32x2 __attribute__((ext_vector_type(2)));
typedef unsigned u32x4 __attribute__((ext_vector_type(4)));

constexpr int DM = 2048, NBATCH = 10, SEQ = 4096, MTOK = NBATCH * SEQ, DFF = 8192, QKVD = 3072;
constexpr float ALPHA = 1.681792830507429f;
constexpr float LN_EPS = 1e-5f, RMS_EPS = 1e-6f;
constexpr size_t MiB = 1024ull * 1024ull;
constexpr size_t WS_PW = 0;
constexpr size_t WS_ROPE = 8 * MiB;
constexpr size_t WS_BAR = 10 * MiB;
constexpr size_t WS_ACC = 11 * MiB;
constexpr size_t WS_CG = 12 * MiB;
constexpr size_t WS_ONE = 13 * MiB;
constexpr size_t WS_ST = 9 * MiB;
constexpr size_t WS_WB = 16 * MiB;
constexpr size_t WS_W1T = WS_WB, WS_W2T = WS_WB + 32 * MiB, WS_MIX = WS_WB + 64 * MiB;
constexpr size_t WS_XB = 144 * MiB;
constexpr size_t WS_R = 304 * MiB;
constexpr size_t WS_END = WS_R + 640 * MiB;
constexpr int LDS_BYTES = 129 * 1024;

struct Params {
  const float* xp; const float* xs;
  const float* a_re; const float* a_im; const float* log_step; const float* b_re; const float* b_im; const float* c_re; const float* c_im;
  const float* s5_d; const float* s5_wout; const float* s5_wgate; const float* pool_w; const float* pool_scale;
  const float* wqkv; const float* qnorm; const float* knorm; const float* wo;
  const float* ln1g; const float* ln1b; const float* ln2g; const float* ln2b; const float* w1; const float* w2;
  float* X; unsigned char* ws;
};

typedef __attribute__((address_space(4))) const Params* KargP;
struct Ctx { int wave0, bid, G;
  __device__ __forceinline__ int tid_() const { int l_; asm volatile("v_mbcnt_lo_u32_b32 %0, -1, 0\n\tv_mbcnt_hi_u32_b32 %0, -1, %0" : "=v"(l_)); return wave0 * 64 + l_; } };
__device__ __forceinline__ unsigned cvt_pk_bf16(float lo, float hi) { unsigned r; asm volatile("v_cvt_pk_bf16_f32 %0, %1, %2" : "=v"(r) : "v"(lo), "v"(hi)); return r; }
__device__ __forceinline__ float bf2f(bf16_t h) { return __uint_as_float(((unsigned)h) << 16); }
__device__ __forceinline__ float wave_sum(float v, int lane) {
#pragma unroll
  for (int o = 32; o >= 1; o >>= 1) v += __int_as_float(__builtin_amdgcn_ds_bpermute((lane ^ o) << 2, __float_as_int(v)));
  return v;
}
__device__ __forceinline__ float gelu_tanh(float x) {
  const float u = 0.7978845608028654f * (x + 0.044715f * x * x * x);
  return x * __builtin_amdgcn_rcpf(1.0f + __builtin_amdgcn_exp2f(-2.885390081777927f * u));
}
__device__ __forceinline__ float sigmoidf_(float x) { return __builtin_amdgcn_rcpf(1.0f + __builtin_amdgcn_exp2f(-1.4426950408889634f * x)); }

namespace pg8 {
constexpr int BM = 256, BK = 64, HALF = 128, HTB = HALF * BK * 2, STAGE_BYTES = 8 * HTB, NXCD = 8, WGM = 4;
__device__ __forceinline__ int lds_byte(int r, int c) { const int st = (r >> 4) * 2 + (c >> 5), rr = r & 15, cc = c & 31, ob = rr * 64 + cc * 2; return st * 1024 + (ob ^ (((ob >> 9) & 1) << 5)); }
__device__ __forceinline__ void stage_rc(int b, int& R, int& C) { const int st = b / 1024, sb = b % 1024, swz = sb ^ (((sb >> 9) & 1) << 5); R = (st >> 1) * 16 + swz / 64; C = (st & 1) * 32 + (swz % 64) / 2; }
__device__ __forceinline__ int perm32(int rho) { const int n = rho >> 4, i = rho & 15; return 8 * (i >> 2) + 4 * n + (i & 3); }

struct Unit { int pm, pn; };
struct GemmDesc {
  const char* A; const char* A2; const char* Bt;
  unsigned rowStrideA, ldbBytes, pnStrideA; int pnShift, chunked, ksplit, nt, nM, nN;
  int mode; void* out; int ldc;
  int wgm;
  int lnsel, flags, layer;
};
enum { F_LN_STATS = 1, F_LN_ACC = 2, F_EMIT = 4, F_XIN = 8, F_FOLD = 16, F_CSCALE = 32 };
struct StaticOrder {
  int nM, nN, nwg, G, c, wgm;
  __device__ void init(int nM_, int nN_, int G_, int c_, int wgm_) { nM = nM_; nN = nN_; nwg = nM * nN; G = G_; c = c_; wgm = wgm_; }
  __device__ bool next(int i, Unit& u) const {
    const long L = (long)i * G + c; if (L >= nwg) return false;
    int wgid = (int)L; { const int q = nwg / NXCD, r = nwg % NXCD, xcd = wgid % NXCD, off = wgid / NXCD; wgid = (xcd < r ? xcd * (q + 1) : r * (q + 1) + (xcd - r) * q) + off; }
    const int nig = wgm * nN, gid = wgid / nig, fm = gid * wgm, gsz = (nM - fm) < wgm ? (nM - fm) : wgm;
    u.pm = fm + ((wgid % nig) % gsz); u.pn = (wgid % nig) / gsz; return true;
  }
};

__device__ __forceinline__ f32x2 row_stats(const f32x2* stats, const float* accIn, int row) {
  if (accIn) { const f32x2 a = *(const f32x2*)(accIn + 2 * (size_t)row); const float mean = a.x * (1.0f / DM); return (f32x2){mean, rsqrtf(fmaxf(a.y * (1.0f / DM) - mean * mean, 0.f) + LN_EPS)}; }
  return stats ? stats[row] : (f32x2){0.f, 1.f};
}
__device__ __forceinline__ void row_emit(float* accOut, int row, float s, float q, int lane, int fq) {
  s += __int_as_float(__builtin_amdgcn_ds_bpermute((lane ^ 16) << 2, __float_as_int(s))); q += __int_as_float(__builtin_amdgcn_ds_bpermute((lane ^ 16) << 2, __float_as_int(q)));
  s += __int_as_float(__builtin_amdgcn_ds_bpermute((lane ^ 32) << 2, __float_as_int(s))); q += __int_as_float(__builtin_amdgcn_ds_bpermute((lane ^ 32) << 2, __float_as_int(q)));
  if (fq == 0) { __hip_atomic_fetch_add(accOut + 2 * (size_t)row, s, __ATOMIC_RELAXED, __HIP_MEMORY_SCOPE_AGENT); __hip_atomic_fetch_add(accOut + 2 * (size_t)row + 1, q, __ATOMIC_RELAXED, __HIP_MEMORY_SCOPE_AGENT); }
}
__device__ __forceinline__ void gemm_epilogue(const GemmDesc& g, const f32x4 (&acc)[2][2][4][2], const Unit& u, int wr, int wc, int fr, int fq, int lane) {
  const int row0 = u.pm * BM + wr * 64 + fr;
  KargP pp = (KargP)__builtin_amdgcn_kernarg_segment_ptr(); asm volatile("" : "+s"(pp));
  unsigned char* const ws_ = pp->ws;
  const float* e_lng = nullptr; const float* e_lnb = nullptr;
  if (g.lnsel == 1) { e_lng = pp->ln1g + g.layer * DM; e_lnb = pp->ln1b + g.layer * DM; } else if (g.lnsel == 2) { e_lng = pp->ln2g + (g.layer - 1) * DM; e_lnb = pp->ln2b + (g.layer - 1) * DM; }
  const f32x2* const e_stats = (g.flags & F_LN_STATS) ? (const f32x2*)(ws_ + WS_ST) : nullptr;
  const float* const e_accIn = (g.flags & F_LN_ACC) ? (const float*)(ws_ + WS_ACC) : nullptr;
  float* const e_accOut = (g.flags & F_EMIT) ? (float*)(ws_ + WS_ACC) : nullptr; bf16_t* const e_xbOut = (bf16_t*)(ws_ + WS_XB);
  const float* const e_cg = (g.flags & F_FOLD) ? (const float*)(ws_ + WS_CG) : nullptr; const float* const e_cb = (const float*)(ws_ + WS_CG) + DFF;
  const float* const e_cscale = (g.flags & F_CSCALE) ? pp->pool_scale : nullptr;
  const float* const e_xin0 = (g.flags & F_XIN) ? pp->xp : nullptr; const float* const e_xin1 = pp->xs;
  if (g.mode <= 2) {
    bf16_t* O = (bf16_t*)g.out; const int col0 = u.pn * BM + wc * 32 + 8 * fq;
    const bool fold = (g.mode == 1) && (e_cg != nullptr);
    f32x4 fg[2][2], fb[2][2]; f32x2 fst[8];
    if (fold) {
#pragma unroll
      for (int bj = 0; bj < 2; ++bj)
#pragma unroll
        for (int n = 0; n < 2; ++n) { fg[bj][n] = *(const f32x4*)(e_cg + col0 + bj * HALF + 4 * n); fb[bj][n] = *(const f32x4*)(e_cb + col0 + bj * HALF + 4 * n); }
#pragma unroll
      for (int gi = 0; gi < 8; ++gi) fst[gi] = *(const f32x2*)(e_accIn + 2 * (size_t)(row0 + (gi >> 2) * HALF + (gi & 3) * 16));
#pragma unroll
      for (int gi = 0; gi < 8; ++gi) { const float mean = fst[gi].x * (1.0f / DM); fst[gi] = (f32x2){mean, rsqrtf(fmaxf(fst[gi].y * (1.0f / DM) - mean * mean, 0.f) + LN_EPS)}; }
    }
#pragma unroll
    for (int ai = 0; ai < 2; ++ai)
#pragma unroll
      for (int m = 0; m < 4; ++m) { bf16_t* rowp = O + (size_t)(row0 + ai * HALF + m * 16) * g.ldc + col0;
#pragma unroll
        for (int bj = 0; bj < 2; ++bj) { f32x4 v0 = acc[ai][bj][m][0], v1 = acc[ai][bj][m][1];
          if (g.mode == 1) {
            if (fold) { const f32x2 st = fst[ai * 4 + m]; v0 = (v0 - fg[bj][0] * st.x) * st.y + fb[bj][0]; v1 = (v1 - fg[bj][1] * st.x) * st.y + fb[bj][1]; }
#pragma unroll
            for (int j = 0; j < 4; ++j) { const float a = fmaxf(v0[j], 0.f), b = fmaxf(v1[j], 0.f); v0[j] = a * a; v1[j] = b * b; } }
          if (g.mode == 2) {
#pragma unroll
            for (int j = 0; j < 4; ++j) { v0[j] = gelu_tanh(v0[j]); v1[j] = gelu_tanh(v1[j]); } }
          u32x4 w; w.x = cvt_pk_bf16(v0[0], v0[1]); w.y = cvt_pk_bf16(v0[2], v0[3]); w.z = cvt_pk_bf16(v1[0], v1[1]); w.w = cvt_pk_bf16(v1[2], v1[3]);
          *(u32x4*)(rowp + bj * HALF) = w; } }
  } else if (g.mode == 3 || g.mode == 4) {
    float* X = (float*)g.out; const int col0 = u.pn * BM + wc * 32 + 4 * fq; const bool ln = e_stats != nullptr || e_accIn != nullptr;
    f32x4 cs[2][2], lg[2][2], lb[2][2];
#pragma unroll
    for (int bj = 0; bj < 2; ++bj)
#pragma unroll
      for (int n = 0; n < 2; ++n) { cs[bj][n] = (g.mode == 4) ? *(const f32x4*)(e_cscale + col0 + bj * HALF + n * 16) : (f32x4){1.f, 1.f, 1.f, 1.f};
        lg[bj][n] = ln ? *(const f32x4*)(e_lng + col0 + bj * HALF + n * 16) : (f32x4){1.f, 1.f, 1.f, 1.f}; lb[bj][n] = ln ? *(const f32x4*)(e_lnb + col0 + bj * HALF + n * 16) : (f32x4){0.f, 0.f, 0.f, 0.f}; }
    f32x2 st[2]; f32x4 xv[2][4];
    const f32x2* const e_sp = e_accIn ? (const f32x2*)e_accIn : (e_stats ? e_stats : (const f32x2*)(ws_ + WS_ONE));
#define RES_LOAD(GI, BUF) do { const int r_ = row0 + ((GI) >> 2) * HALF + ((GI) & 3) * 16; const float* rp_ = X + (size_t)r_ * DM + col0; \
      st[BUF] = e_sp[r_]; \
      _Pragma("unroll") for (int q_ = 0; q_ < 4; ++q_) xv[BUF][q_] = *(const f32x4*)(rp_ + (q_ >> 1) * HALF + (q_ & 1) * 16); } while (0)
    RES_LOAD(0, 0);
#pragma unroll
    for (int gi = 0; gi < 8; ++gi) { const int ai = gi >> 2, m = gi & 3; const int row = row0 + ai * HALF + m * 16; float* rowp = X + (size_t)row * DM + col0;
      if (gi + 1 < 8) RES_LOAD(gi + 1, (gi + 1) & 1);
      float ssum = 0.f, ssq = 0.f; f32x2 sm = st[gi & 1];
      if (e_accIn) { const float mean = sm.x * (1.0f / DM); sm = (f32x2){mean, rsqrtf(fmaxf(sm.y * (1.0f / DM) - mean * mean, 0.f) + LN_EPS)}; }
#pragma unroll
      for (int bj = 0; bj < 2; ++bj)
#pragma unroll
        for (int n = 0; n < 2; ++n) { f32x4* p = (f32x4*)(rowp + bj * HALF + n * 16); const f32x4 x = ((xv[gi & 1][bj * 2 + n] - sm.x) * sm.y) * lg[bj][n] + lb[bj][n]; const f32x4 o = x * ALPHA + acc[ai][bj][m][n] * cs[bj][n]; *p = o;
          if (e_accOut) { ssum += (o[0] + o[1]) + (o[2] + o[3]); ssq += (o[0] * o[0] + o[1] * o[1]) + (o[2] * o[2] + o[3] * o[3]);
            u32x2 w; w.x = cvt_pk_bf16(o[0], o[1]); w.y = cvt_pk_bf16(o[2], o[3]); *(u32x2*)(e_xbOut + (size_t)row * DM + col0 + bj * HALF + n * 16) = w; } }
      if (e_accOut) row_emit(e_accOut, row, ssum, ssq, lane, fq); }
#undef RES_LOAD
  } else if (g.mode == 5) {
    float* X = (float*)g.out; const int col0 = u.pn * HALF + wc * 32 + 4 * fq; const bool ln = e_stats != nullptr;
    f32x4 lg[2], lb[2];
#pragma unroll
    for (int n = 0; n < 2; ++n) { lg[n] = ln ? *(const f32x4*)(e_lng + col0 + n * 16) : (f32x4){1.f, 1.f, 1.f, 1.f}; lb[n] = ln ? *(const f32x4*)(e_lnb + col0 + n * 16) : (f32x4){0.f, 0.f, 0.f, 0.f}; }
    f32x2 st[2][2]; f32x4 xv[2][4];
    const f32x2* const e_sp = e_stats ? e_stats : (const f32x2*)(ws_ + WS_ONE);
#define GLU_SRC(ROW) (e_xin0 ? (((ROW) < 2 * SEQ) ? e_xin0 + (size_t)(ROW) * DM + col0 : e_xin1 + (size_t)((ROW) - 2 * SEQ) * DM + col0) : X + (size_t)(ROW) * DM + col0)
#define GLU_LOAD(PI, BUF) do { _Pragma("unroll") for (int h_ = 0; h_ < 2; ++h_) { const int g_ = 2 * (PI) + h_; const int r_ = row0 + (g_ >> 2) * HALF + (g_ & 3) * 16; const float* sp_ = GLU_SRC(r_); \
      st[BUF][h_] = e_sp[r_]; xv[BUF][2 * h_] = *(const f32x4*)(sp_); xv[BUF][2 * h_ + 1] = *(const f32x4*)(sp_ + 16); } } while (0)
    GLU_LOAD(0, 0);
#pragma unroll
    for (int pi = 0; pi < 4; ++pi) {
      if (pi + 1 < 4) GLU_LOAD(pi + 1, (pi + 1) & 1);
#pragma unroll
      for (int h2 = 0; h2 < 2; ++h2) { const int gi = 2 * pi + h2, ai = gi >> 2, m = gi & 3; const int row = row0 + ai * HALF + m * 16; float* rowp = X + (size_t)row * DM + col0; float ssum = 0.f, ssq = 0.f;
#pragma unroll
        for (int n = 0; n < 2; ++n) { f32x4* p = (f32x4*)(rowp + n * 16); const f32x4 x = ((xv[pi & 1][2 * h2 + n] - st[pi & 1][h2].x) * st[pi & 1][h2].y) * lg[n] + lb[n]; const f32x4 o = acc[ai][0][m][n], gt = acc[ai][1][m][n]; f32x4 h;
#pragma unroll
          for (int j = 0; j < 4; ++j) h[j] = o[j] * sigmoidf_(gt[j]);
          const f32x4 z = x * ALPHA + h; *p = z;
          if (e_accOut) { ssum += (z[0] + z[1]) + (z[2] + z[3]); ssq += (z[0] * z[0] + z[1] * z[1]) + (z[2] * z[2] + z[3] * z[3]);
            u32x2 w; w.x = cvt_pk_bf16(z[0], z[1]); w.y = cvt_pk_bf16(z[2], z[3]); *(u32x2*)(e_xbOut + (size_t)row * DM + col0 + n * 16) = w; } }
        if (e_accOut) row_emit(e_accOut, row, ssum, ssq, lane, fq); } }
#undef GLU_LOAD
#undef GLU_SRC
  } else if (g.mode == 7) {
    if (acc[0][0][0][0][0] == 1.2345e30f) *(f32x4*)g.out = acc[1][1][3][1];
  } else {
    float* C = (float*)g.out; const int col0 = u.pn * BM + wc * 32 + 4 * fq;
#pragma unroll
    for (int ai = 0; ai < 2; ++ai)
#pragma unroll
      for (int m = 0; m < 4; ++m) { float* rowp = C + (size_t)(row0 + ai * HALF + m * 16) * g.ldc + col0;
#pragma unroll
        for (int bj = 0; bj < 2; ++bj)
#pragma unroll
          for (int n = 0; n < 2; ++n) *(f32x4*)(rowp + bj * HALF + n * 16) = acc[ai][bj][m][n]; }
  }
}

__device__ __forceinline__ const char* ktile_ptr(const char* b1, const char* b2, int kt, int ksplit, size_t kstep) { return kt < ksplit ? b1 + (size_t)kt * kstep : b2 + (size_t)(kt - ksplit) * kstep; }

__device__ __forceinline__ void gemm_phase(const Ctx& cx, LAS unsigned char* lds, const GemmDesc& g) {
  const int tid = cx.tid_(), wid = __builtin_amdgcn_readfirstlane(tid >> 6), lane = tid & 63, wr = wid >> 2, wc = wid & 3, fr = lane & 15, fq = lane >> 4;
  const int nt = g.nt, ksplit = g.ksplit; const bool perm = g.mode <= 2;
  unsigned voffA[2], voffB[2];
#pragma unroll
  for (int i = 0; i < 2; ++i) { int R, C; stage_rc(tid * 16 + i * 8192, R, C); const int Rb = perm ? ((R & ~31) + perm32(R & 31)) : R;
    voffA[i] = g.chunked ? (unsigned)((R >> 4) * 65536 + (R & 15) * 32 + (C >> 4) * 512 + (C & 15) * 2) : ((unsigned)R * g.rowStrideA + (unsigned)(C * 2)); voffB[i] = (unsigned)Rb * g.ldbBytes + (unsigned)(C * 2); }
  const size_t kstepA = g.chunked ? 2048 : 128, kstepB = 128;
  const size_t hstepA = (size_t)HALF * g.rowStrideA, hstepB = (size_t)HALF * g.ldbBytes, tstepA = 2 * hstepA, tstepB = 2 * hstepB;
  const unsigned ldsw = (unsigned)wid * 1024u;
  const int aoff = lds_byte(wr * 64 + fr, fq * 8), boff = lds_byte(wc * 32 + fr, fq * 8);
#define PG8_SA(b, h) (((b) * 2 + (h)) * HTB)
#define PG8_SB(b, h) ((4 + (b) * 2 + (h)) * HTB)
#define PG8_STAGE(bufoff, gbase, voff) do { _Pragma("unroll") for (int _i = 0; _i < 2; ++_i) \
    __builtin_amdgcn_global_load_lds((const unsigned*)((const char*)(gbase) + (voff)[_i]), (LAS unsigned*)(lds + (bufoff) + ldsw + _i * 8192), 16, 0, 0); } while (0)
#define PG8_LDA(dst, b, h) do { _Pragma("unroll") for (int m = 0; m < 4; ++m) _Pragma("unroll") for (int k = 0; k < 2; ++k) dst[m][k] = *(const LAS bf16x8*)(lds + PG8_SA(b, h) + aoff + m * 2048 + k * 1024); } while (0)
#define PG8_LDB(dst, b, h) do { _Pragma("unroll") for (int n = 0; n < 2; ++n) _Pragma("unroll") for (int k = 0; k < 2; ++k) dst[n][k] = *(const LAS bf16x8*)(lds + PG8_SB(b, h) + boff + n * 2048 + k * 1024); } while (0)
#define PG8_MMA(ai, bj, At, Bt) do { __builtin_amdgcn_s_setprio(1); _Pragma("unroll") for (int m = 0; m < 4; ++m) _Pragma("unroll") for (int n = 0; n < 2; ++n) _Pragma("unroll") for (int k = 0; k < 2; ++k) \
    acc[ai][bj][m][n] = __builtin_amdgcn_mfma_f32_16x16x32_bf16(Bt[n][k], At[m][k], acc[ai][bj][m][n], 0, 0, 0); __builtin_amdgcn_s_setprio(0); } while (0)
#define PG8_WAIT_V(n) asm volatile("s_waitcnt vmcnt(" #n ")" ::: "memory")
#define PG8_WAIT_L(n) asm volatile("s_waitcnt lgkmcnt(" #n ")" ::: "memory")
#define PG8_BAR __builtin_amdgcn_s_barrier()
#define PG8_SCHED __builtin_amdgcn_sched_barrier(0)
  StaticOrder S; S.init(g.nM, g.nN, (int)cx.G, (int)cx.bid, g.wgm);
  Unit cur, nxt; int ui = 0;
  if (!S.next(0, cur)) return;
  f32x4 acc[2][2][4][2];
#pragma unroll
  for (int a = 0; a < 2; ++a)
#pragma unroll
    for (int b = 0; b < 2; ++b)
#pragma unroll
      for (int m = 0; m < 4; ++m)
#pragma unroll
        for (int n = 0; n < 2; ++n) acc[a][b][m][n] = (f32x4){0.f, 0.f, 0.f, 0.f};
  bf16x8 At[4][2], B0[2][2], B1[2][2];
  size_t aoffu = (size_t)cur.pm * tstepA + (size_t)(cur.pn >> g.pnShift) * g.pnStrideA;
  const char* cA1 = g.A + aoffu; const char* cA2 = g.A2 + aoffu; const char* cB = g.Bt + (size_t)cur.pn * tstepB;
  {
    const char* a0 = ktile_ptr(cA1, cA2, 0, ksplit, kstepA); const char* a1 = ktile_ptr(cA1, cA2, 1, ksplit, kstepA);
    PG8_STAGE(PG8_SB(0, 0), cB, voffB); PG8_STAGE(PG8_SB(0, 1), cB + hstepB, voffB); PG8_STAGE(PG8_SA(0, 0), a0, voffA); PG8_STAGE(PG8_SA(0, 1), a0 + hstepA, voffA);
    if (wr == 1) PG8_BAR;
    PG8_WAIT_V(2); PG8_BAR;
    PG8_STAGE(PG8_SB(1, 0), cB + kstepB, voffB); PG8_STAGE(PG8_SA(1, 0), a1, voffA); PG8_STAGE(PG8_SB(1, 1), cB + hstepB + kstepB, voffB);
    PG8_WAIT_V(6); PG8_BAR;
  }
  for (;;) {
    const bool has_next = S.next(ui + 1, nxt);
    const size_t naoff = has_next ? (size_t)nxt.pm * tstepA + (size_t)(nxt.pn >> g.pnShift) * g.pnStrideA : aoffu;
    const char* nA1 = g.A + naoff; const char* nA2 = g.A2 + naoff; const char* nB = has_next ? g.Bt + (size_t)nxt.pn * tstepB : cB;
    for (int t = 0; t < nt; t += 2) {
      const bool last = (t == nt - 2);
      const char* a1 = ktile_ptr(cA1, cA2, t + 1, ksplit, kstepA);
      const char* a2 = last ? ktile_ptr(nA1, nA2, 0, ksplit, kstepA) : ktile_ptr(cA1, cA2, t + 2, ksplit, kstepA);
      const char* a3 = last ? ktile_ptr(nA1, nA2, 1, ksplit, kstepA) : ktile_ptr(cA1, cA2, t + 3, ksplit, kstepA);
      const char* b2 = last ? nB : cB + (size_t)(t + 2) * kstepB; const char* b3 = b2 + kstepB;
      PG8_LDB(B0, 0, 0); PG8_LDB(B1, 0, 1); PG8_SCHED; PG8_LDA(At, 0, 0); PG8_STAGE(PG8_SA(1, 1), a1 + hstepA, voffA);
      PG8_WAIT_V(8); PG8_WAIT_L(0); PG8_BAR; PG8_MMA(0, 0, At, B0); PG8_MMA(0, 1, At, B1); PG8_BAR; PG8_SCHED;
      PG8_LDA(At, 0, 1); PG8_STAGE(PG8_SB(0, 0), b2, voffB); PG8_STAGE(PG8_SB(0, 1), b2 + hstepB, voffB); PG8_STAGE(PG8_SA(0, 0), a2, voffA);
      PG8_WAIT_V(8); PG8_WAIT_L(0); PG8_BAR; PG8_MMA(1, 0, At, B0); PG8_MMA(1, 1, At, B1); PG8_BAR; PG8_SCHED;
      PG8_LDB(B0, 1, 0); PG8_LDB(B1, 1, 1); PG8_SCHED; PG8_LDA(At, 1, 0); PG8_STAGE(PG8_SA(0, 1), a2 + hstepA, voffA);
      PG8_WAIT_V(8); PG8_WAIT_L(0); PG8_BAR; PG8_MMA(0, 0, At, B0); PG8_MMA(0, 1, At, B1); PG8_BAR; PG8_SCHED;
      PG8_LDA(At, 1, 1); PG8_STAGE(PG8_SB(1, 0), b3, voffB); PG8_STAGE(PG8_SB(1, 1), b3 + hstepB, voffB); PG8_STAGE(PG8_SA(1, 0), a3, voffA);
      PG8_WAIT_V(8); PG8_WAIT_L(0); PG8_BAR; PG8_MMA(1, 0, At, B0); PG8_MMA(1, 1, At, B1); PG8_BAR; PG8_SCHED;
    }
    if (wr == 0) PG8_BAR;
    gemm_epilogue(g, acc, cur, wr, wc, fr, fq, lane);
    if (!has_next) break;
#pragma unroll
    for (int a = 0; a < 2; ++a)
#pragma unroll
      for (int b = 0; b < 2; ++b)
#pragma unroll
        for (int m = 0; m < 4; ++m)
#pragma unroll
          for (int n = 0; n < 2; ++n) acc[a][b][m][n] = (f32x4){0.f, 0.f, 0.f, 0.f};
    cur = nxt; cA1 = nA1; cA2 = nA2; cB = nB; aoffu = naoff; ++ui;
    if (wr == 1) PG8_BAR;
  }
  PG8_WAIT_V(0);
  PG8_BAR;
#undef PG8_SA
#undef PG8_SB
#undef PG8_STAGE
#undef PG8_LDA
#undef PG8_LDB
#undef PG8_MMA
#undef PG8_WAIT_V
#undef PG8_WAIT_L
#undef PG8_BAR
#undef PG8_SCHED
}
}

namespace att {
constexpr int D = 128, NW = 8, QBLK = 32, KVBLK = 64;
constexpr float SCALE = 0.088388347648318440f, THR = 8.f;
constexpr int LDQ = QKVD, LDK = QKVD, LDO = DM;
constexpr size_t SHM_V = KVBLK * D * 2, SHM_K = KVBLK * D * 2, SHM_ATTN = 2 * SHM_V + 2 * SHM_K + NW * 64 * 4;
#define KSWZ(row, colB) ((row) * 256 + ((colB) ^ (((row) & 7) << 4)))
#define SBAR() __builtin_amdgcn_sched_barrier(0)
__device__ __forceinline__ int crow(int r, int hi) { return (r & 3) + 8 * (r >> 2) + 4 * hi; }
__device__ __forceinline__ bf16x8 ld8(const bf16_t* p) { return *reinterpret_cast<const bf16x8*>(p); }
__device__ __forceinline__ void partialSM(f32x16& p0, f32x16& p1, float& m_reg, float& mn, float& alpha) {
  constexpr float C = SCALE * 1.4426950408889634f;
  float pmax = p0[0];
#pragma unroll
  for (int r = 1; r < 16; ++r) pmax = fmaxf(pmax, p0[r]);
#pragma unroll
  for (int r = 0; r < 16; ++r) pmax = fmaxf(pmax, p1[r]);
  { auto rr = __builtin_amdgcn_permlane32_swap(__float_as_uint(pmax), __float_as_uint(pmax), false, false);
    pmax = fmaxf(__uint_as_float(rr[0]), __uint_as_float(rr[1])); }
  if (__builtin_expect(__all(pmax - m_reg <= THR / SCALE), 1)) { mn = m_reg; alpha = 1.f; }
  else { mn = fmaxf(m_reg, pmax); alpha = __builtin_amdgcn_exp2f((m_reg - mn) * C); m_reg = mn; }
  float mnC = -mn * C;
#pragma unroll
  for (int r = 0; r < 16; ++r) p0[r] = fmaf(p0[r], C, mnC);
#pragma unroll
  for (int r = 0; r < 16; ++r) p1[r] = fmaf(p1[r], C, mnC);
#pragma unroll
  for (int r = 0; r < 16; ++r) p0[r] = __builtin_amdgcn_exp2f(p0[r]);
}
__device__ __forceinline__ void finishSM(f32x16& p0, f32x16& p1, float alpha, float& l_reg, bf16x8& pa0, bf16x8& pa1, bf16x8& pa2, bf16x8& pa3) {
#pragma unroll
  for (int r = 0; r < 16; ++r) p1[r] = __builtin_amdgcn_exp2f(p1[r]);
  float ps = 0;
#pragma unroll
  for (int r = 0; r < 16; ++r) ps += p0[r];
#pragma unroll
  for (int r = 0; r < 16; ++r) ps += p1[r];
  { auto rr = __builtin_amdgcn_permlane32_swap(__float_as_uint(ps), __float_as_uint(ps), false, false);
    ps = __uint_as_float(rr[0]) + __uint_as_float(rr[1]); }
  l_reg = l_reg * alpha + ps;
#define PK4(P, BASE, OUT) do { unsigned a0 = cvt_pk_bf16(P[BASE + 0], P[BASE + 1]), a1 = cvt_pk_bf16(P[BASE + 2], P[BASE + 3]);   \
    unsigned b0 = cvt_pk_bf16(P[BASE + 4], P[BASE + 5]), b1 = cvt_pk_bf16(P[BASE + 6], P[BASE + 7]);                              \
    auto r0 = __builtin_amdgcn_permlane32_swap(a0, b0, false, false); auto r1 = __builtin_amdgcn_permlane32_swap(a1, b1, false, false); \
    u32x4 w = {r0[0], r1[0], r0[1], r1[1]}; OUT = *reinterpret_cast<bf16x8*>(&w); } while (0)
  PK4(p0, 0, pa0); PK4(p0, 8, pa1); PK4(p1, 0, pa2); PK4(p1, 8, pa3);
#undef PK4
}
__device__ __forceinline__ void qkt(f32x16& p0, f32x16& p1, const bf16_t* Ks, const bf16x8* qr, int r32, int hi) {
  p0 = f32x16{}; p1 = f32x16{};
#pragma unroll
  for (int d0 = 0; d0 < 8; ++d0) { int cb = (d0 * 16 + hi * 8) * 2;
    bf16x8 b0 = *reinterpret_cast<const bf16x8*>((const char*)Ks + KSWZ(r32, cb));
    bf16x8 b1 = *reinterpret_cast<const bf16x8*>((const char*)Ks + KSWZ(32 + r32, cb));
    p0 = __builtin_amdgcn_mfma_f32_32x32x16_bf16(b0, qr[d0], p0, 0, 0, 0);
    p1 = __builtin_amdgcn_mfma_f32_32x32x16_bf16(b1, qr[d0], p1, 0, 0, 0); }
}
__device__ __forceinline__ int v_st(int k, int c) { const int kk = (k & ~0xC) | ((k & 4) << 1) | ((k & 8) >> 1); return ((kk >> 3) * 4 + (c >> 5)) * 512 + ((kk & 7) * 32 + (c & 31)) * 2; }
__device__ __forceinline__ int v_rd_base(int lane) { return ((lane & 3) << 3) | (((lane >> 2) & 3) << 6) | (((lane >> 4) & 1) << 5) | (((lane >> 5) & 1) << 8); }
constexpr int v_rd_off(int d0, int ks, int half) { return d0 * 512 + ks * 4096 + half * 2048; }
template <int OFF> __device__ __forceinline__ s16x4 tr_read(int vb) {
  s16x4 r; asm volatile("ds_read_b64_tr_b16 %0, %1 offset:%2" : "=&v"(r) : "v"(vb), "i"(OFF) : "memory"); return r;
}
template <int D0> __device__ __forceinline__ void pv_one(f32x16& od, int vb, bf16x8 pa0, bf16x8 pa1, bf16x8 pa2, bf16x8 pa3) {
  const s16x4 l0 = tr_read<v_rd_off(D0, 0, 0)>(vb), h0 = tr_read<v_rd_off(D0, 0, 1)>(vb), l1 = tr_read<v_rd_off(D0, 1, 0)>(vb), h1 = tr_read<v_rd_off(D0, 1, 1)>(vb);
  const s16x4 l2 = tr_read<v_rd_off(D0, 2, 0)>(vb), h2 = tr_read<v_rd_off(D0, 2, 1)>(vb), l3 = tr_read<v_rd_off(D0, 3, 0)>(vb), h3 = tr_read<v_rd_off(D0, 3, 1)>(vb);
  asm volatile("s_waitcnt lgkmcnt(0)" ::: "memory"); SBAR();
#define PK(L, H) (bf16x8){L[0], L[1], L[2], L[3], H[0], H[1], H[2], H[3]}
  od = __builtin_amdgcn_mfma_f32_32x32x16_bf16(pa0, PK(l0, h0), od, 0, 0, 0);
  od = __builtin_amdgcn_mfma_f32_32x32x16_bf16(pa1, PK(l1, h1), od, 0, 0, 0);
  od = __builtin_amdgcn_mfma_f32_32x32x16_bf16(pa2, PK(l2, h2), od, 0, 0, 0);
  od = __builtin_amdgcn_mfma_f32_32x32x16_bf16(pa3, PK(l3, h3), od, 0, 0, 0);
#undef PK
}
__device__ __forceinline__ void pv_d0(f32x16* o, int vb, bf16x8 pa0, bf16x8 pa1, bf16x8 pa2, bf16x8 pa3) {
  pv_one<0>(o[0], vb, pa0, pa1, pa2, pa3); pv_one<1>(o[1], vb, pa0, pa1, pa2, pa3); pv_one<2>(o[2], vb, pa0, pa1, pa2, pa3); pv_one<3>(o[3], vb, pa0, pa1, pa2, pa3);
}
__device__ __forceinline__ void attn_dense_body(const bf16_t* __restrict__ Qb, const bf16_t* __restrict__ Kh, const bf16_t* __restrict__ Vh,
                                                bf16_t* __restrict__ Ob, int seq, char* lds, const Ctx& cx) {
  const int tid = cx.tid_(), wid = tid >> 6, lane = tid & 63, r32 = lane & 31, hi = lane >> 5;
  bf16_t* V_lds = (bf16_t*)lds; bf16_t* K_lds = (bf16_t*)(lds + 2 * SHM_V);
  float* ws = (float*)(lds + 2 * SHM_V + 2 * SHM_K) + wid * 64; float* li_l = ws; float* al_l = ws + 32;
  float m_reg = -1e30f, l_reg = 0; f32x16 o[4] = {}; bf16x8 qr[8];
  const bf16_t* Qw = Qb + (long)(wid * QBLK + r32) * LDQ + hi * 8;
#pragma unroll
  for (int d0 = 0; d0 < 8; ++d0) qr[d0] = ld8(Qw + d0 * 16);
  const int sr = tid >> 4, sc = (tid & 15) * 8, vst0 = v_st(sr, sc), vst1 = v_st(32 + sr, sc);
  const int vb0 = (int)(uintptr_t)V_lds + v_rd_base(lane);
  struct { bf16x8 vs0, vs1, ks0, ks1; } sr_[2];
#define SLOAD(i, k0) do { sr_[i].vs0 = ld8(&Vh[(long)((k0) + sr) * LDK + sc]); sr_[i].vs1 = ld8(&Vh[(long)((k0) + 32 + sr) * LDK + sc]); \
    sr_[i].ks0 = ld8(&Kh[(long)((k0) + sr) * LDK + sc]); sr_[i].ks1 = ld8(&Kh[(long)((k0) + 32 + sr) * LDK + sc]); } while (0)
#define SWRITE(b, i) do { *(bf16x8*)((char*)V_lds + (b) * SHM_V + vst0) = sr_[i].vs0;          \
    *(bf16x8*)((char*)V_lds + (b) * SHM_V + vst1) = sr_[i].vs1; int kc = sc * 2;               \
    *(bf16x8*)((char*)K_lds + (b) * SHM_K + KSWZ(sr, kc)) = sr_[i].ks0;                       \
    *(bf16x8*)((char*)K_lds + (b) * SHM_K + KSWZ(32 + sr, kc)) = sr_[i].ks1; } while (0)
#define SWAIT() asm volatile("s_waitcnt vmcnt(4)" ::: "memory")
#define RESC(a) do { if (__any((a) < 1.f)) { if (hi == 0) al_l[r32] = (a); asm volatile("s_waitcnt lgkmcnt(0)" ::: "memory"); \
    _Pragma("unroll") for (int d = 0; d < 4; ++d) _Pragma("unroll") for (int r = 0; r < 16; ++r) o[d][r] *= al_l[crow(r, hi)]; } } while (0)
  f32x16 pA0, pA1, pB0, pB1; float mnA, mnB, alA, alB; bf16x8 pa0, pa1, pa2, pa3; const int NT = seq / KVBLK;
  constexpr int SE = 0, SO = 1;
  SLOAD(SE, 0); asm volatile("s_waitcnt vmcnt(0)" ::: "memory"); SWRITE(0, SE); __syncthreads();
  qkt(pA0, pA1, K_lds, qr, r32, hi); partialSM(pA0, pA1, m_reg, mnA, alA);
  SLOAD(SO, KVBLK); if (2 < NT) SLOAD(SE, 2 * KVBLK);
  SWAIT(); SWRITE(1, SO); __syncthreads();
  for (int j = 1; j + 1 < NT; j += 2) {
    SBAR(); qkt(pB0, pB1, (bf16_t*)((char*)K_lds + SHM_K), qr, r32, hi);
    finishSM(pA0, pA1, alA, l_reg, pa0, pa1, pa2, pa3); SBAR();
    SLOAD(SO, (j + 2) * KVBLK); SBAR();
    pv_d0(o, vb0, pa0, pa1, pa2, pa3); partialSM(pB0, pB1, m_reg, mnB, alB);
    __syncthreads(); SWAIT(); SWRITE(0, SE);
    RESC(alB); __syncthreads();
    SBAR(); qkt(pA0, pA1, K_lds, qr, r32, hi);
    finishSM(pB0, pB1, alB, l_reg, pa0, pa1, pa2, pa3); SBAR();
    SLOAD(SE, min(j + 3, NT - 1) * KVBLK); SBAR();
    pv_d0(o, vb0 + (int)SHM_V, pa0, pa1, pa2, pa3); partialSM(pA0, pA1, m_reg, mnA, alA);
    __syncthreads(); SWAIT(); SWRITE(1, SO);
    RESC(alA); __syncthreads();
  }
  SBAR(); qkt(pB0, pB1, (bf16_t*)((char*)K_lds + SHM_K), qr, r32, hi);
  finishSM(pA0, pA1, alA, l_reg, pa0, pa1, pa2, pa3); SBAR();
  pv_d0(o, vb0, pa0, pa1, pa2, pa3); partialSM(pB0, pB1, m_reg, mnB, alB);
  __syncthreads(); RESC(alB);
  finishSM(pB0, pB1, alB, l_reg, pa0, pa1, pa2, pa3); SBAR();
  pv_d0(o, vb0 + (int)SHM_V, pa0, pa1, pa2, pa3);
  if (hi == 0) li_l[r32] = l_reg; asm volatile("s_waitcnt lgkmcnt(0)" ::: "memory");
  float rli[16];
#pragma unroll
  for (int r = 0; r < 16; ++r) rli[r] = __builtin_amdgcn_rcpf(li_l[crow(r, hi)]);
  bf16_t* Ow = Ob + (long)(wid * QBLK) * LDO;
#pragma unroll
  for (int r = 0; r < 16; ++r) { int orow = crow(r, hi);
#pragma unroll
    for (int d0 = 0; d0 < 4; ++d0) Ow[(long)orow * LDO + d0 * 32 + r32] = (bf16_t)(cvt_pk_bf16(o[d0][r] * rli[r], 0.f) & 0xffffu); }
#undef SLOAD
#undef SWRITE
#undef SWAIT
#undef RESC
}
}

__device__ __forceinline__ void phase_pre(const Ctx& cx, const Params& p) {
  const size_t gt = (size_t)cx.bid * 512 + cx.tid_(), nth = (size_t)cx.G * 512;
  const size_t n1 = (size_t)2 * SEQ * DM / 4, ntot = (size_t)MTOK * DM / 4;
  f32x4* X4 = (f32x4*)p.X; u32x2* XB2 = (u32x2*)(p.ws + WS_XB);
  for (size_t i = gt; i < ntot; i += 4 * nth) {
    f32x4 v[4];
#pragma unroll
    for (int e = 0; e < 4; ++e) { const size_t ii = i + e * nth; v[e] = (ii < ntot) ? ((ii < n1) ? __builtin_nontemporal_load(&((const f32x4*)p.xp)[ii]) : __builtin_nontemporal_load(&((const f32x4*)p.xs)[ii - n1])) : (f32x4){0.f, 0.f, 0.f, 0.f}; }
#pragma unroll
    for (int e = 0; e < 4; ++e) { const size_t ii = i + e * nth; if (ii < ntot) { u32x2 w; w.x = cvt_pk_bf16(v[e][0], v[e][1]); w.y = cvt_pk_bf16(v[e][2], v[e][3]);
        const size_t tok = ii >> 9; const unsigned ch = (unsigned)(ii & 511) * 4u; XB2[((tok >> 4) * 32768 + (ch >> 4) * 256 + (tok & 15) * 16 + (ch & 15)) >> 2] = w; } }
  }
  for (size_t i = gt; i < (size_t)MTOK * 2 + 2 * DFF; i += nth) { if (i < (size_t)MTOK * 2) ((float*)(p.ws + WS_ACC))[i] = 0.f; else ((float*)(p.ws + WS_CG))[i - (size_t)MTOK * 2] = 0.f; }
  { float z0, o1; asm volatile("v_mov_b32 %0, 0" : "=v"(z0)); asm volatile("v_mov_b32 %0, 1.0" : "=v"(o1)); for (size_t i = gt; i < (size_t)MTOK; i += nth) ((f32x2*)(p.ws + WS_ONE))[i] = (f32x2){z0, o1}; }
  if (gt < 32768) {
    const int idx = (int)gt;
    const float lr = fminf(p.a_re[idx], -1e-4f), li = p.a_im[idx], dt = expf(p.log_step[idx >> 6]);
    const float er = expf(lr * dt), ang = li * dt; const float lbr = er * cosf(ang), lbi = er * sinf(ang);
    const float nr = lbr - 1.f, ni = lbi, den = lr * lr + li * li; const float cr = (nr * lr + ni * li) / den, ci = (ni * lr - nr * li) / den;
    f32x2* T = (f32x2*)(p.ws + WS_PW) + (size_t)idx * 32;
    float pr = 1.f, pi = 0.f;
#pragma unroll
    for (int d = 0; d <= 16; ++d) {
      if (d >= 1) T[15 + d] = (f32x2){pr, pi};
      if (d < 16) T[d] = (f32x2){pr * cr - pi * ci, pr * ci + pi * cr};
      const float t0 = pr * lbr - pi * lbi, t1 = pr * lbi + pi * lbr; pr = t0; pi = t1;
    }
  } else if (gt < 32768 + 2048) {
    const int e = (int)gt - 32768, pos = e >> 5, f = e & 31;
    const float inv = exp2f(-(float)f * (13.287712379549449f / 32.0f)); const float ang = (float)pos * inv;
    ((f32x2*)(p.ws + WS_ROPE))[e] = (f32x2){cosf(ang), sinf(ang)};
  }
}

__device__ __forceinline__ void cvt_job(const Ctx& cx, float* T, const float* __restrict__ src, bf16_t* __restrict__ dst, int K, int N, int ld_dst, int mode,
                                        const float* rs = nullptr, const float* rb = nullptr, float* cgo = nullptr, float* cbo = nullptr) {
  const int tid = cx.tid_(), nK = K >> 6, cnt = nK * (N >> 8);
  float* RED = T + 64 * 257 + 16;
  for (int t = cx.bid; t < cnt; t += cx.G) {
    const int k0 = (t % nK) << 6, n0 = (t / nK) << 8;
    const int r = tid >> 6, c4 = (tid & 63) * 4;
    f32x4 v[8];
#pragma unroll
    for (int i = 0; i < 8; ++i) v[i] = __builtin_nontemporal_load((const f32x4*)(src + (size_t)(k0 + r + 8 * i) * N + n0 + c4));
    if (rs) { f32x4 pg = {0.f, 0.f, 0.f, 0.f}, pb = {0.f, 0.f, 0.f, 0.f};
#pragma unroll
      for (int i = 0; i < 8; ++i) { const float gk = rs[k0 + r + 8 * i], bk = rb[k0 + r + 8 * i]; pb += v[i] * bk; v[i] *= gk; pg += v[i]; }
      float* rp = RED + r * 256 + c4; rp[0] = pg[0]; rp[1] = pg[1]; rp[2] = pg[2]; rp[3] = pg[3]; rp += 2048; rp[0] = pb[0]; rp[1] = pb[1]; rp[2] = pb[2]; rp[3] = pb[3]; }
#pragma unroll
    for (int i = 0; i < 8; ++i) { float* tp = T + (r + 8 * i) * 257 + c4; tp[0] = v[i][0]; tp[1] = v[i][1]; tp[2] = v[i][2]; tp[3] = v[i][3]; }
    __syncthreads();
    if (rs) { const int which = tid >> 8, n = tid & 255; float s = 0.f;
#pragma unroll
      for (int rr = 0; rr < 8; ++rr) s += RED[which * 2048 + rr * 256 + n];
      __hip_atomic_fetch_add((which ? cbo : cgo) + n0 + n, s, __ATOMIC_RELAXED, __HIP_MEMORY_SCOPE_AGENT); }
    const int n = tid >> 1, kh = (tid & 1) * 32;
    const int nn = n0 + n; const int row = (mode == 0) ? nn : (((nn >> 7) << 8) + (nn & 127) + (mode == 2 ? 128 : 0));
    bf16_t* dp = dst + (size_t)row * ld_dst + k0 + kh;
#pragma unroll
    for (int q = 0; q < 4; ++q) { float w[8];
#pragma unroll
      for (int jj = 0; jj < 8; ++jj) w[jj] = T[(kh + 8 * q + jj) * 257 + n];
      u32x4 o; o.x = cvt_pk_bf16(w[0], w[1]); o.y = cvt_pk_bf16(w[2], w[3]); o.z = cvt_pk_bf16(w[4], w[5]); o.w = cvt_pk_bf16(w[6], w[7]);
      *(u32x4*)(dp + 8 * q) = o; }
    __syncthreads();
  }
}

__device__ __forceinline__ void s5_prep_item(const Ctx& cx, float* L, const Params& p, int j, int g, int hf) {
  const int tid = cx.tid_();
  f32x2* Cc = (f32x2*)L;
  f32x2* Bb = Cc + 2048;
  f32x2* PWs = Bb + 2048;
  float* Kt = (float*)(PWs + 4096);
  { float cr[4], ci[4], br[4], bi[4]; f32x2 pw[8];
#pragma unroll
    for (int k = 0; k < 4; ++k) { const int e = tid + 512 * k, dir = e >> 10, r = e & 1023; const size_t base = ((size_t)(j * 2 + dir) * 128 + g) * 1024 + r;
      cr[k] = p.c_re[base]; ci[k] = p.c_im[base]; br[k] = p.b_re[base]; bi[k] = p.b_im[base]; }
#pragma unroll
    for (int k = 0; k < 8; ++k) { const int e = tid + 512 * k, dir = e >> 11, r = e & 2047; pw[k] = ((const f32x2*)(p.ws + WS_PW))[(((size_t)(j * 2 + dir) * 128 + g) * 64) * 32 + r]; }
#pragma unroll
    for (int k = 0; k < 4; ++k) { const int e = tid + 512 * k; Cc[e] = (f32x2){cr[k], ci[k]}; Bb[e] = (f32x2){br[k], bi[k]}; }
#pragma unroll
    for (int k = 0; k < 8; ++k) PWs[tid + 512 * k] = pw[k]; }
  __syncthreads();
  { const int dir = tid >> 8, d = (tid >> 4) & 15, pp = tid & 15; float acc[16];
#pragma unroll
    for (int q = 0; q < 16; ++q) acc[q] = 0.f;
    for (int n = 0; n < 64; ++n) { const f32x2 c = Cc[(dir * 16 + pp) * 64 + n], w = PWs[(dir * 64 + n) * 32 + d];
      const float Wr = c.x * w.x - c.y * w.y, Wi = c.x * w.y + c.y * w.x;
#pragma unroll
      for (int q = 0; q < 16; ++q) { const f32x2 b = Bb[(dir * 64 + n) * 16 + q]; acc[q] += Wr * b.x - Wi * b.y; } }
#pragma unroll
    for (int q = 0; q < 16; ++q) Kt[((dir * 16 + d) * 16 + pp) * 16 + q] = acc[q]; }
  __syncthreads();
  bf16_t* Mout = (bf16_t*)(p.ws + WS_MIX + 32 * MiB); bf16_t* Mst = (bf16_t*)(p.ws + WS_MIX + 16 * MiB);
  for (int it = 0; it < 16; ++it) { const int id = it * 512 + tid, row_l = id >> 6, cgp = id & 63, t = 8 * hf + (row_l >> 4), pp = row_l & 15; float v[8];
    if (cgp < 32) { const int tp = cgp >> 1, q0 = (cgp & 1) * 8;
#pragma unroll
      for (int e = 0; e < 8; ++e) { const int q = q0 + e; float x = 0.f;
        if (tp <= t) x += Kt[((0 * 16 + (t - tp)) * 16 + pp) * 16 + q];
        if (tp >= t) x += Kt[((1 * 16 + (tp - t)) * 16 + pp) * 16 + q];
        if (tp == t && pp == q) x += p.s5_d[j * DM + g * 16 + pp];
        v[e] = x; }
    } else { const int kk0 = (cgp - 32) * 8, dir = kk0 >> 7, n0 = (kk0 & 127) >> 1, slot = 15 + (dir == 0 ? t + 1 : 16 - t);
#pragma unroll
      for (int e = 0; e < 8; ++e) { const int n = n0 + (e >> 1), ri = e & 1; const f32x2 c = Cc[(dir * 16 + pp) * 64 + n], w = PWs[(dir * 64 + n) * 32 + slot];
        v[e] = ri == 0 ? (c.x * w.x - c.y * w.y) : -(c.x * w.y + c.y * w.x); } }
    u32x4 w4; w4.x = cvt_pk_bf16(v[0], v[1]); w4.y = cvt_pk_bf16(v[2], v[3]); w4.z = cvt_pk_bf16(v[4], v[5]); w4.w = cvt_pk_bf16(v[6], v[7]);
    *(u32x4*)(Mout + ((size_t)(g * 256 + t * 16 + pp)) * 512 + cgp * 8) = w4; }
  for (int it = 0; it < 8; ++it) { const int id = it * 512 + tid, row_l = id >> 5, cgp = id & 31, dir = hf, ri = row_l & 1, n = row_l >> 1, tp = cgp >> 1, q0 = (cgp & 1) * 8;
    const f32x2 w = PWs[(dir * 64 + n) * 32 + (dir == 0 ? 15 - tp : tp)]; float v[8];
#pragma unroll
    for (int e = 0; e < 8; ++e) { const f32x2 b = Bb[(dir * 64 + n) * 16 + q0 + e]; v[e] = ri == 0 ? (w.x * b.x - w.y * b.y) : (w.x * b.y + w.y * b.x); }
    u32x4 w4; w4.x = cvt_pk_bf16(v[0], v[1]); w4.y = cvt_pk_bf16(v[2], v[3]); w4.z = cvt_pk_bf16(v[4], v[5]); w4.w = cvt_pk_bf16(v[6], v[7]);
    *(u32x4*)(Mst + ((size_t)(g * 256 + dir * 128 + row_l)) * 256 + cgp * 8) = w4; }
  __syncthreads();
}

__device__ __forceinline__ void phase_prep(const Ctx& cx, const Params& p, int layer, float* L) {
  const int kind = layer % 3, j = layer / 3;
  if (kind == 0) { for (int it = cx.bid; it < 256; it += cx.G) s5_prep_item(cx, L, p, j, it >> 1, it & 1); }
  cvt_job(cx, L, p.w1 + (size_t)layer * DM * DFF, (bf16_t*)(p.ws + WS_W1T), DM, DFF, DM, 0, LAZY_SCHED ? p.ln1g + layer * DM : nullptr, p.ln1b + layer * DM, (float*)(p.ws + WS_CG), (float*)(p.ws + WS_CG) + DFF);
  cvt_job(cx, L, p.w2 + (size_t)layer * DFF * DM, (bf16_t*)(p.ws + WS_W2T), DFF, DM, DFF, 0);
  if (kind == 0) {
    cvt_job(cx, L, p.s5_wout + (size_t)j * DM * DM, (bf16_t*)(p.ws + WS_MIX), DM, DM, DM, 1);
    cvt_job(cx, L, p.s5_wgate + (size_t)j * DM * DM, (bf16_t*)(p.ws + WS_MIX), DM, DM, DM, 2);
  } else if (kind == 1) {
    for (int gi = 0; gi < 4; ++gi) cvt_job(cx, L, p.pool_w + (size_t)gi * 512 * 512, (bf16_t*)(p.ws + WS_MIX) + (size_t)gi * 512 * 512, 512, 512, 512, 0);
  } else {
    cvt_job(cx, L, p.wqkv, (bf16_t*)(p.ws + WS_MIX), DM, QKVD, DM, 0);
    cvt_job(cx, L, p.wo, (bf16_t*)(p.ws + WS_MIX + 12 * MiB), DM, DM, DM, 0);
  }
}

__device__ __forceinline__ void phase_scan(const Ctx& cx, const Params& p, int j) {
  const int lane = cx.tid_() & 63, wave = cx.tid_() >> 6;
  const bf16_t* S = (const bf16_t*)(p.ws + WS_R); bf16_t* H = (bf16_t*)(p.ws + WS_R + 320 * MiB);
  for (int item = wave * cx.G + cx.bid; item < NBATCH * 128; item += 8 * cx.G) {
    const int g = item & 127, b = item >> 7;
    const f32x2 lamF = ((const f32x2*)(p.ws + WS_PW))[(((size_t)(j * 2 + 0) * 128 + g) * 64 + lane) * 32 + 31];
    const f32x2 lamB = ((const f32x2*)(p.ws + WS_PW))[(((size_t)(j * 2 + 1) * 128 + g) * 64 + lane) * 32 + 31];
    f32x2 hF = {0.f, 0.f}, hB = {0.f, 0.f};
    const unsigned* Sb = (const unsigned*)(S + (size_t)b * 256 * 32768 + g * 256 + 2 * lane);
    unsigned* Hb = (unsigned*)(H + (size_t)b * 256 * 32768 + g * 256 + 2 * lane);
    unsigned sF[8], sB[8];
#pragma unroll
    for (int e = 0; e < 8; ++e) { sF[e] = Sb[(size_t)e * 16384]; sB[e] = Sb[(size_t)(255 - e) * 16384 + 64]; }
    for (int c0 = 0; c0 < 256; c0 += 8) {
      unsigned nF[8], nB[8]; const int c1 = (c0 + 8 < 256) ? c0 + 8 : c0;
#pragma unroll
      for (int e = 0; e < 8; ++e) { nF[e] = Sb[(size_t)(c1 + e) * 16384]; nB[e] = Sb[(size_t)(255 - c1 - e) * 16384 + 64]; }
#pragma unroll
      for (int e = 0; e < 8; ++e) { const int cF = c0 + e, cB = 255 - c0 - e;
        Hb[(size_t)cF * 16384] = cvt_pk_bf16(hF.x, hF.y); Hb[(size_t)cB * 16384 + 64] = cvt_pk_bf16(hB.x, hB.y);
        const float sfx = __uint_as_float(sF[e] << 16), sfy = __uint_as_float(sF[e] & 0xffff0000u), sbx = __uint_as_float(sB[e] << 16), sby = __uint_as_float(sB[e] & 0xffff0000u);
        const float fr_ = lamF.x * hF.x - lamF.y * hF.y + sfx, fi_ = lamF.x * hF.y + lamF.y * hF.x + sfy; hF.x = fr_; hF.y = fi_;
        const float br_ = lamB.x * hB.x - lamB.y * hB.y + sbx, bi_ = lamB.x * hB.y + lamB.y * hB.x + sby; hB.x = br_; hB.y = bi_; }
#pragma unroll
      for (int e = 0; e < 8; ++e) { sF[e] = nF[e]; sB[e] = nB[e]; }
    }
  }
}

#ifndef LN_REPS
#define LN_REPS 1
#endif
__device__ __forceinline__ void phase_ln(const Ctx& cx, const Params& p, const float* gam, const float* bet, bool final_, bool s5lay, bool dummy_in) {
 for (int rep = 0; rep < LN_REPS; ++rep) { const bool dummy = dummy_in || rep > 0; if (rep > 0) final_ = false;
  const int lane = cx.tid_() & 63, gw = cx.bid * 8 + (cx.tid_() >> 6), nw = cx.G * 8;
  if (!dummy) for (int i = cx.bid * 512 + cx.tid_(); i < 2 * DFF; i += cx.G * 512) ((float*)(p.ws + WS_CG))[i] = 0.f;
  f32x2* ST = (f32x2*)(p.ws + (dummy ? WS_R + 480 * MiB : WS_ST));
  int row = gw; f32x4 v[8], g4[8], b4[8];
#pragma unroll
  for (int k = 0; k < 8; ++k) { g4[k] = ((const f32x4*)gam)[k * 64 + lane]; b4[k] = ((const f32x4*)bet)[k * 64 + lane]; }
  { const f32x4* xr = (const f32x4*)(p.X + (size_t)min(row, MTOK - 1) * DM);
#pragma unroll
    for (int k = 0; k < 8; ++k) v[k] = __builtin_nontemporal_load(&xr[k * 64 + lane]); }
  while (row < MTOK) {
    const int nrow = row + nw; f32x4 nv[8];
    { const f32x4* xn = (const f32x4*)(p.X + (size_t)min(nrow, MTOK - 1) * DM);
#pragma unroll
      for (int k = 0; k < 8; ++k) nv[k] = __builtin_nontemporal_load(&xn[k * 64 + lane]); }
    u32x2* xb0 = (u32x2*)(p.ws + (dummy ? WS_R + 320 * MiB : WS_XB)); u32x2* xb = xb0 + (size_t)row * (DM / 4);
    f32x4* xo = dummy ? (f32x4*)(p.ws + WS_R) + (size_t)row * (DM / 4) : (f32x4*)(p.X + (size_t)row * DM);
    float s = 0.f, q = 0.f;
#pragma unroll
    for (int k = 0; k < 8; ++k) { s += (v[k][0] + v[k][1]) + (v[k][2] + v[k][3]); q += (v[k][0] * v[k][0] + v[k][1] * v[k][1]) + (v[k][2] * v[k][2] + v[k][3] * v[k][3]); }
#pragma unroll
    for (int o = 32; o >= 1; o >>= 1) { const float s2 = __int_as_float(__builtin_amdgcn_ds_bpermute((lane ^ o) << 2, __float_as_int(s))), q2 = __int_as_float(__builtin_amdgcn_ds_bpermute((lane ^ o) << 2, __float_as_int(q))); s += s2; q += q2; }
    const float mean = s * (1.0f / DM); const float rstd = rsqrtf(fmaxf(q * (1.0f / DM) - mean * mean, 0.f) + LN_EPS);
    if (lane == 0) { ST[row] = (f32x2){mean, rstd}; if (!dummy) { float z0; asm volatile("v_mov_b32 %0, 0" : "=v"(z0)); ((f32x2*)(p.ws + WS_ACC))[row] = (f32x2){z0, z0}; } }
#pragma unroll
    for (int k = 0; k < 8; ++k) {
      const f32x4 o = ((v[k] - mean) * rstd) * g4[k] + b4[k];
      if (final_) xo[k * 64 + lane] = o;
      else { u32x2 w; w.x = cvt_pk_bf16(o[0], o[1]); w.y = cvt_pk_bf16(o[2], o[3]);
        if (s5lay) { const unsigned ch = (unsigned)(k * 64 + lane) * 4u; xb0[((size_t)(row >> 4) * 32768 + (ch >> 4) * 256 + (row & 15) * 16 + (ch & 15)) >> 2] = w; }
        else xb[k * 64 + lane] = w; } }
#pragma unroll
    for (int k = 0; k < 8; ++k) v[k] = nv[k];
    row = nrow;
  }
 }
}

__device__ __forceinline__ f32x4 ldbf4(const u32x2* p) { const u32x2 u = *p; return (f32x4){__uint_as_float(u.x << 16), __uint_as_float(u.x & 0xffff0000u), __uint_as_float(u.y << 16), __uint_as_float(u.y & 0xffff0000u)}; }
__device__ __forceinline__ void phase_poolpre(const Ctx& cx, const Params& p) {
  const int tid = cx.tid_(); const int gi = tid >> 7, w2 = 1 << gi;
  u32x2* P = (u32x2*)(p.ws + WS_R);
  for (int it = cx.bid; it < NBATCH * 128; it += cx.G) {
    const int b = it >> 7, t0 = (it & 127) * 32;
    const u32x2* xb = (const u32x2*)(p.ws + WS_XB) + (size_t)b * SEQ * (DM / 4) + tid;
    f32x4 s = {0.f, 0.f, 0.f, 0.f};
    for (int k = -w2; k < w2; ++k) { const int tt = t0 + k; const float m = (tt >= 0 && tt < SEQ) ? 1.f : 0.f; const int tc = min(max(tt, 0), SEQ - 1); s += ldbf4(xb + (size_t)tc * (DM / 4)) * m; }
    for (int i0 = 0; i0 < 32; i0 += 8) {
      f32x4 c[8], ad[8], sb[8];
#pragma unroll
      for (int e = 0; e < 8; ++e) { const int t = t0 + i0 + e; c[e] = ldbf4(xb + (size_t)t * (DM / 4));
        const int ta = t + w2, ts = t - w2; const float ma = ta < SEQ ? 1.f : 0.f, ms = ts >= 0 ? 1.f : 0.f;
        ad[e] = ldbf4(xb + (size_t)min(ta, SEQ - 1) * (DM / 4)) * ma; sb[e] = ldbf4(xb + (size_t)max(ts, 0) * (DM / 4)) * ms; }
#pragma unroll
      for (int e = 0; e < 8; ++e) { const int t = t0 + i0 + e; const int lo = max(t - w2, 0), hi = min(t + w2, SEQ); const float inv = 1.0f / (float)(hi - lo);
        const f32x4 o = s * inv - c[e]; u32x2 w; w.x = cvt_pk_bf16(o[0], o[1]); w.y = cvt_pk_bf16(o[2], o[3]); P[((size_t)b * SEQ + t) * (DM / 4) + tid] = w;
        s += ad[e] - sb[e]; }
    }
  }
}

__device__ __forceinline__ void phase_rope(const Ctx& cx, const Params& p, bool dummy) {
  const int lane = cx.tid_() & 63, gw = cx.bid * 8 + (cx.tid_() >> 6), nw = cx.G * 8;
  const int hsel = lane >> 5, li = lane & 31, s = li >> 4, fp = li & 15, e0 = s * 64 + 2 * fp, e1 = e0 + 32;
  const f32x2 qa = *(const f32x2*)(p.qnorm + e0), qb = *(const f32x2*)(p.qnorm + e1), ka = *(const f32x2*)(p.knorm + e0), kb = *(const f32x2*)(p.knorm + e1);
  const f32x4* RT = (const f32x4*)(p.ws + WS_ROPE);
  bf16_t* QKV = (bf16_t*)(p.ws + WS_R);
  for (int tok = gw; tok < MTOK; tok += nw) {
    const int t = tok & (SEQ - 1); const int pos = s == 0 ? (t >> 6) : (t & 63); const f32x4 cs = RT[pos * 16 + fp];
    bf16_t* row = QKV + (size_t)tok * QKVD;
    unsigned ua[10], ub[10];
#pragma unroll
    for (int i = 0; i < 10; ++i) { const int hd = 2 * i + hsel; ua[i] = *(const unsigned*)(row + hd * 128 + e0); ub[i] = *(const unsigned*)(row + hd * 128 + e1); }
#pragma unroll
    for (int i = 0; i < 10; ++i) {
      const int hd = 2 * i + hsel; unsigned* p0 = (unsigned*)(row + hd * 128 + e0); unsigned* p1 = (unsigned*)(row + hd * 128 + e1);
      const unsigned u0 = ua[i], u1 = ub[i];
      const float x1a = __uint_as_float(u0 << 16), x1b = __uint_as_float(u0 & 0xffff0000u), x2a = __uint_as_float(u1 << 16), x2b = __uint_as_float(u1 & 0xffff0000u);
      float ss = (x1a * x1a + x1b * x1b) + (x2a * x2a + x2b * x2b);
#pragma unroll
      for (int o = 16; o >= 1; o >>= 1) ss += __int_as_float(__builtin_amdgcn_ds_bpermute((lane ^ o) << 2, __float_as_int(ss)));
      const float r = rsqrtf(ss * (1.0f / 128.0f) + RMS_EPS); const bool isq = hd < 16;
      const float y1a = x1a * r * (isq ? qa.x : ka.x), y1b = x1b * r * (isq ? qa.y : ka.y), y2a = x2a * r * (isq ? qb.x : kb.x), y2b = x2b * r * (isq ? qb.y : kb.y);
      const float o1a = y1a * cs[0] - y2a * cs[1], o2a = y2a * cs[0] + y1a * cs[1], o1b = y1b * cs[2] - y2b * cs[3], o2b = y2b * cs[2] + y1b * cs[3];
      if (!dummy || o1a == 1.2345e30f) { *p0 = cvt_pk_bf16(o1a, o1b); *p1 = cvt_pk_bf16(o2a, o2b); }
    }
  }
}

__device__ __forceinline__ void phase_attn(const Ctx& cx, const Params& p, char* lds) {
  const bf16_t* QKV = (const bf16_t*)(p.ws + WS_R); bf16_t* O = (bf16_t*)(p.ws + WS_R + 240 * MiB);
  const int G = cx.G, c = cx.bid;
  for (int r = 0;; ++r) {
    int pair, unit;
    if (G == 256) { if (r >= 10) break; const int xcd = c & 7, idx = c >> 3; pair = xcd * 5 + (r >> 1); unit = (r & 1) * 32 + idx; }
    else { const int L = r * G + c; if (L >= 2560) break; pair = L >> 6; unit = L & 63; }
    const int b = pair >> 2, kvh = pair & 3, hq = kvh * 4 + (unit >> 4), qb = unit & 15;
    const bf16_t* Qp = QKV + ((size_t)b * SEQ + qb * 256) * QKVD + hq * 128;
    const bf16_t* Kp = QKV + (size_t)b * SEQ * QKVD + 2048 + kvh * 128;
    const bf16_t* Vp = Kp + 512;
    bf16_t* Op = O + ((size_t)b * SEQ + qb * 256) * DM + hq * 128;
    att::attn_dense_body(Qp, Kp, Vp, Op, SEQ, lds, cx);
    __syncthreads();
  }
}


#define XB_TMO      128
#define XB_XCNT(j)  (256  + 64 * (j))
#define XB_XSUB(j)  (1280 + 64 * (j))
#define XB_XGEN(j)  (2304 + 64 * (j))
#define XB_TOP      3328
#define XB_TOPGEN   3392
#define XCD_BAR_WORDS 3456
#define XB_SPIN_CAP (1u << 22)
__device__ __forceinline__ unsigned xb_ld(unsigned* p)              { return __hip_atomic_load(p, __ATOMIC_RELAXED, __HIP_MEMORY_SCOPE_AGENT); }
__device__ __forceinline__ unsigned xb_add(unsigned* p, unsigned v) { return __hip_atomic_fetch_add(p, v, __ATOMIC_RELAXED, __HIP_MEMORY_SCOPE_AGENT); }
__device__ __forceinline__ unsigned xb_xcc_id() { return (unsigned)__builtin_amdgcn_s_getreg((3 << 11) | 20) & 0xFu; }
#define XB_SPIN(cond, bar) do { unsigned _sp = 0; while (cond) { __builtin_amdgcn_s_sleep(1); \
    if ((++_sp & 255u) == 0u) { if (xb_ld(&(bar)[XB_TMO])) break; if (_sp > XB_SPIN_CAP) { atomicAdd(&(bar)[XB_TMO], 1u); break; } } } } while (0)
__device__ __forceinline__ void xcd_barrier_complete(unsigned* bar, unsigned x, unsigned G, unsigned& nloc, unsigned& nx) {
  unsigned sum, cnt, mine, sp = 0u;
  for (;;) {
    sum = 0u; cnt = 0u; mine = 0u;
#pragma unroll
    for (unsigned j = 0; j < 16; ++j) { const unsigned c = xb_ld(&bar[XB_XCNT(j)]); sum += c; cnt += (c > 0u) ? 1u : 0u; mine = (j == x) ? c : mine; }
    if (sum == G) break;
    __builtin_amdgcn_s_sleep(1);
    if ((++sp & 255u) == 0u) { if (xb_ld(&bar[XB_TMO])) break; if (sp > XB_SPIN_CAP) { atomicAdd(&bar[XB_TMO], 1u); break; } }
  }
  nloc = mine > 0u ? mine : 1u; nx = cnt > 0u ? cnt : 1u;
}
__device__ __forceinline__ void xcd_barrier(const Ctx& cx, unsigned* bar, volatile LAS unsigned* st) {
  asm volatile("s_waitcnt vmcnt(0)" ::: "memory");
  __syncthreads();
  if (cx.tid_() == 0) {
    const unsigned x = xb_xcc_id();
    __builtin_amdgcn_s_waitcnt(0);
    unsigned nloc = st[0], nx = st[1];
    if (nloc == 0u) { xcd_barrier_complete(bar, x, (unsigned)cx.G, nloc, nx); st[0] = nloc; st[1] = nx; }
    const unsigned old = xb_add(&bar[XB_XSUB(x)], 1u);
    const unsigned gen = old / nloc;
    if (old + 1u == (gen + 1u) * nloc) {
      __builtin_amdgcn_fence(__ATOMIC_RELEASE, "agent");
      asm volatile("s_waitcnt vmcnt(0)" ::: "memory");
      const unsigned og = xb_add(&bar[XB_TOP], 1u);
      const unsigned tg = og / nx;
      if (og + 1u == (tg + 1u) * nx) xb_add(&bar[XB_TOPGEN], 1u);
      else XB_SPIN(xb_ld(&bar[XB_TOPGEN]) == tg, bar);
      __builtin_amdgcn_fence(__ATOMIC_ACQUIRE, "agent");
      xb_add(&bar[XB_XGEN(x)], 1u);
      asm volatile("s_waitcnt vmcnt(0)" ::: "memory");
    } else {
      XB_SPIN(xb_ld(&bar[XB_XGEN(x)]) == gen, bar);
      __builtin_amdgcn_fence(__ATOMIC_ACQUIRE, "agent");
      asm volatile("s_waitcnt vmcnt(0)" ::: "memory");
    }
  }
  __syncthreads();
}

enum { T_PRE = 0, T_PREP, T_S5G1, T_SCAN, T_S5G2, T_GLU, T_LN1, T_UP, T_DOWN, T_LN2, T_POOLPRE, T_POOLG, T_QKV, T_ROPE, T_ATT, T_WO };

constexpr int NSTEPS = LAZY_SCHED ? 31 : 32;
#ifndef PROBE_MASK
#define PROBE_MASK 0
#endif


__device__ __forceinline__ void run_step(const Ctx& cx, const Params& p, int type, int layer, unsigned char* lds, bool dummy) {
  using namespace pg8;
  unsigned char* ws = p.ws;
  const int j = layer / 3;
  bool is_gemm = false; pg8::GemmDesc g;
  g.A = nullptr; g.A2 = nullptr; g.Bt = nullptr; g.rowStrideA = DM * 2; g.ldbBytes = DM * 2; g.pnStrideA = 0; g.pnShift = 0; g.chunked = 0; g.ksplit = 1 << 20; g.nt = 32; g.nM = MTOK / 256; g.nN = 8;
  g.mode = 0; g.out = nullptr; g.ldc = DM; g.lnsel = 0; g.flags = 0; g.layer = layer; g.wgm = WGM_OTHER;
  switch (type) {
    case T_PRE: phase_pre(cx, p); break;
    case T_PREP: phase_prep(cx, p, layer, (float*)lds); break;
    case T_S5G1: is_gemm = true; g.A = (const char*)(ws + WS_XB); g.A2 = g.A; g.Bt = (const char*)(ws + WS_MIX + 16 * MiB); g.rowStrideA = 65536; g.ldbBytes = 512; g.pnStrideA = 512;
      g.nt = 4; g.nM = 10; g.nN = 128; g.mode = 0; g.out = ws + WS_R; g.ldc = 32768; break;
    case T_SCAN: phase_scan(cx, p, j); break;
    case T_S5G2: is_gemm = true; g.A = (const char*)(ws + WS_XB); g.A2 = (const char*)(ws + WS_R + 320 * MiB); g.Bt = (const char*)(ws + WS_MIX + 32 * MiB); g.rowStrideA = 65536; g.ldbBytes = 1024; g.pnStrideA = 512;
      g.ksplit = 4; g.nt = 8; g.nM = 10; g.nN = 128; g.mode = 2; g.out = ws + WS_R + 480 * MiB; g.ldc = 32768; break;
    case T_GLU: is_gemm = true; g.A = (const char*)(ws + WS_R + 480 * MiB); g.A2 = g.A; g.Bt = (const char*)(ws + WS_MIX); g.chunked = 1; g.nN = 16; g.mode = 5; g.out = p.X; if (layer > 0) { g.flags = F_LN_STATS | (EMIT_ON ? F_EMIT : 0); g.lnsel = 2; } else g.flags = F_XIN | (EMIT_ON ? F_EMIT : 0); break;
    case T_LN1: phase_ln(cx, p, p.ln1g + layer * DM, p.ln1b + layer * DM, false, false, dummy); break;
    case T_UP: is_gemm = true; g.A = (const char*)(ws + WS_XB); g.A2 = g.A; g.Bt = (const char*)(ws + WS_W1T); g.nN = 32; g.mode = 1; g.out = ws + WS_R; g.ldc = DFF; g.wgm = WGM_UP; g.flags = LAZY_SCHED ? (F_LN_ACC | F_FOLD) : 0; break;
    case T_DOWN: is_gemm = true; g.A = (const char*)(ws + WS_R); g.A2 = g.A; g.Bt = (const char*)(ws + WS_W2T); g.rowStrideA = DFF * 2; g.ldbBytes = DFF * 2; g.nt = 128; g.mode = 3; g.out = p.X; g.wgm = WGM_DOWN; g.flags = LAZY_SCHED ? F_LN_ACC : F_LN_STATS; g.lnsel = 1; break;
    case T_LN2: phase_ln(cx, p, p.ln2g + layer * DM, p.ln2b + layer * DM, layer == 3, layer == 2, dummy);
      if (!LAZY_SCHED && layer < 3) { __syncthreads(); phase_prep(cx, p, layer + 1, (float*)lds); } break;
    case T_POOLPRE: phase_poolpre(cx, p); break;
    case T_POOLG: is_gemm = true; g.A = (const char*)(ws + WS_R); g.A2 = g.A; g.Bt = (const char*)(ws + WS_MIX); g.ldbBytes = 1024; g.pnStrideA = 1024; g.pnShift = 1; g.nt = 8; g.mode = 4; g.out = p.X; g.flags = F_CSCALE | F_LN_STATS | (EMIT_ON ? F_EMIT : 0); g.lnsel = 2; break;
    case T_QKV: is_gemm = true; g.A = (const char*)(ws + WS_XB); g.A2 = g.A; g.Bt = (const char*)(ws + WS_MIX); g.nN = 12; g.mode = 0; g.out = ws + WS_R; g.ldc = QKVD; break;
    case T_ROPE: phase_rope(cx, p, dummy); break;
    case T_ATT: phase_attn(cx, p, (char*)lds); break;
    case T_WO: is_gemm = true; g.A = (const char*)(ws + WS_R + 240 * MiB); g.A2 = g.A; g.Bt = (const char*)(ws + WS_MIX + 12 * MiB); g.mode = 3; g.out = p.X; g.flags = F_LN_STATS | (EMIT_ON ? F_EMIT : 0); g.lnsel = 2; break;
    default: break;
  }
  if (is_gemm) { if (dummy && g.mode >= 3 && g.mode <= 5) g.mode = 7; pg8::gemm_phase(cx, (LAS unsigned char*)lds, g); }
}


__device__ __forceinline__ void step_info(int s, int& type, int& layer) {
  if (s == 0) { type = T_PRE; layer = 0; return; }
  int r;
#if LAZY_SCHED
  if (s < 9) { layer = 0; r = s - 1; } else if (s < 15) { layer = 1; r = s - 9; } else if (s < 23) { layer = 2; r = s - 15; } else { layer = 3; r = s - 23; }
#else
  if (s < 10) { layer = 0; r = s - 1; } else if (s < 16) { layer = 1; r = s - 10 + 1; } else if (s < 24) { layer = 2; r = s - 16 + 1; } else { layer = 3; r = s - 24 + 1; }
#endif
  const int kind = layer % 3;
  if (r == 0) { type = T_PREP; return; }
  const int nmix = kind == 1 ? 2 : 4;
  if (r <= nmix) {
    const int m = r - 1;
    if (kind == 0) type = (m == 0) ? T_S5G1 : (m == 1) ? T_SCAN : (m == 2) ? T_S5G2 : T_GLU;
    else if (kind == 1) type = (m == 0) ? T_POOLPRE : T_POOLG;
    else type = (m == 0) ? T_QKV : (m == 1) ? T_ROPE : (m == 2) ? T_ATT : T_WO;
    return;
  }
  const int q = r - nmix - 1;
#if LAZY_SCHED
  type = (q == 0) ? T_UP : (q == 1) ? T_DOWN : T_LN2;
#else
  type = (q == 0) ? T_LN1 : (q == 1) ? T_UP : (q == 2) ? T_DOWN : T_LN2;
#endif
}
__global__ void __launch_bounds__(512) fwd_megakernel(Params p_unused) {
  extern __shared__ __attribute__((aligned(16))) unsigned char lds[];
  cg::grid_group grid = cg::this_grid();
  const int wave0 = __builtin_amdgcn_readfirstlane((int)threadIdx.x >> 6);
  { volatile LAS unsigned* st0 = (volatile LAS unsigned*)((LAS unsigned char*)lds + 128 * 1024);
    if (threadIdx.x < 4) st0[threadIdx.x] = 0u;
    __syncthreads();
    KargP pq = (KargP)__builtin_amdgcn_kernarg_segment_ptr();
    if (threadIdx.x == 0) (void)xb_add(&((unsigned*)(pq->ws + WS_BAR))[XB_XCNT(xb_xcc_id())], 1u); }
  for (int s = 0; s < NSTEPS; ++s) {
    int type, layer; step_info(s, type, layer);
    KargP pp = (KargP)__builtin_amdgcn_kernarg_segment_ptr();
    asm volatile("" : "+s"(pp));
    Ctx cx; { int b_ = (int)blockIdx.x, g_ = (int)gridDim.x; asm volatile("" : "+s"(b_)); asm volatile("" : "+s"(g_)); cx.wave0 = wave0; cx.bid = b_; cx.G = g_; }
#if defined(__HIP_DEVICE_COMPILE__)
    const Params p = *pp;
#else
    const Params p = p_unused;
#endif
    run_step(cx, p, type, layer, lds, false);
    if (s + 1 < NSTEPS) {
      if (s == 0) grid.sync();
      else { xcd_barrier(cx, (unsigned*)(p.ws + WS_BAR), (volatile LAS unsigned*)((LAS unsigned char*)lds + 128 * 1024)); }
    }
  }
}
extern "C" void kernel_launch(void* const* d_in, const int* in_sizes, int n_in, void* d_out, int out_size, void* d_ws, size_t ws_size,
                              hipStream_t stream) {
  static int grid_blocks = 0;
  if (!grid_blocks) {
    int dev = 0, cus = 0, per_cu = 0;
    (void)hipGetDevice(&dev);
    (void)hipDeviceGetAttribute(&cus, hipDeviceAttributeMultiprocessorCount, dev);
    (void)hipFuncSetAttribute((const void*)fwd_megakernel, hipFuncAttributeMaxDynamicSharedMemorySize, LDS_BYTES);
    (void)hipOccupancyMaxActiveBlocksPerMultiprocessor(&per_cu, (const void*)fwd_megakernel, 512, LDS_BYTES);
    if (per_cu != 1) per_cu = 1;
    grid_blocks = cus * per_cu;
    if (ws_size < WS_END) fprintf(stderr, "kernel_launch: workspace too small: %zu < %zu\n", ws_size, (size_t)WS_END);
  }
  Params p{};
  p.xp = (const float*)d_in[0]; p.xs = (const float*)d_in[1];
  p.a_re = (const float*)d_in[2]; p.a_im = (const float*)d_in[3]; p.log_step = (const float*)d_in[4];
  p.b_re = (const float*)d_in[5]; p.b_im = (const float*)d_in[6]; p.c_re = (const float*)d_in[7]; p.c_im = (const float*)d_in[8];
  p.s5_d = (const float*)d_in[9]; p.s5_wout = (const float*)d_in[10]; p.s5_wgate = (const float*)d_in[11];
  p.pool_w = (const float*)d_in[12]; p.pool_scale = (const float*)d_in[13];
  p.wqkv = (const float*)d_in[14]; p.qnorm = (const float*)d_in[15]; p.knorm = (const float*)d_in[16]; p.wo = (const float*)d_in[17];
  p.ln1g = (const float*)d_in[18]; p.ln1b = (const float*)d_in[19]; p.ln2g = (const float*)d_in[20]; p.ln2b = (const float*)d_in[21];
  p.w1 = (const float*)d_in[22]; p.w2 = (const float*)d_in[23];
  p.X = (float*)d_out; p.ws = (unsigned char*)d_ws;
  (void)hipMemsetAsync((char*)d_ws + WS_BAR, 0, XCD_BAR_WORDS * 4, stream);
  void* args[] = {&p};
  hipError_t e = hipLaunchCooperativeKernel((const void*)fwd_megakernel, dim3(grid_blocks), dim3(512), args, LDS_BYTES, stream);
  if (e != hipSuccess) fprintf(stderr, "cooperative launch failed: %s (grid %d)\n", hipGetErrorString(e), grid_blocks);
}
```
